# Optimizing an MI355X kernel written in HIP

```python
import jax, jax.numpy as jnp
from jax import lax
import numpy as np

D_MODEL = 1024
BATCH = 2
SEQ = 8192
DEPTH = 2

CTX_LEN = 256
GRID_W = 64

SGU_HEADS = 4
SGU_HEAD_DIM = 64
SGU_W = SGU_HEADS * SGU_HEAD_DIM
CHUNK = 128
FNET_GROUPS = 4
FNET_GROUP_DIM = 64
FNET_W = FNET_GROUPS * FNET_GROUP_DIM
MLA_HEADS = 4
QK_NOPE_DIM = 128
QK_ROPE_DIM = 64
QK_DIM = QK_NOPE_DIM + QK_ROPE_DIM
V_DIM = 128
Q_LORA = 256
KV_LORA = 128
MLA_W = MLA_HEADS * V_DIM
Q_BLOCK = 128
ROPE_THETA = 10000.0
OFF_U = 0
OFF_V = OFF_U + SGU_W
OFF_F = OFF_V + SGU_W
OFF_Q = OFF_F + FNET_W
OFF_KV = OFF_Q + Q_LORA
OFF_KR = OFF_KV + KV_LORA
IN_W = OFF_KR + QK_ROPE_DIM
MIX_W = SGU_W + FNET_W + MLA_W
N_EXPERTS = 16
EC_FACTOR = 2
D_EXPERT = 512
EPS = 1e-6

kernel_name = "hybrid_dit_sgu_fnet_mla_ecmoe"


def rms_norm(x):
    xf = x.astype(jnp.float32)
    return (xf * lax.rsqrt(jnp.mean(xf * xf, axis=-1, keepdims=True) + EPS)).astype(x.dtype)


def ada_modulation(cond, w_ada, b_ada):
    m = (jax.nn.silu(cond) @ w_ada + b_ada)[:, None, :]
    return jnp.split(m, 6, axis=-1)


def modulate(x, shift, scale):
    return rms_norm(x) * (1 + scale) + shift


def rope_1d(x, pos):
    half = x.shape[-1] // 2
    freqs = ROPE_THETA ** (-jnp.arange(half, dtype=jnp.float32) / half)
    ang = pos.astype(jnp.float32)[:, None] * freqs
    cos = jnp.cos(ang)[:, None, :]
    sin = jnp.sin(ang)[:, None, :]
    xf = x.astype(jnp.float32)
    x1, x2 = xf[..., :half], xf[..., half:]
    return jnp.concatenate([x1 * cos - x2 * sin, x1 * sin + x2 * cos], axis=-1).astype(x.dtype)


def rope_2d(x, pos_row, pos_col):
    half = x.shape[-1] // 2
    return jnp.concatenate([rope_1d(x[..., :half], pos_row), rope_1d(x[..., half:], pos_col)], axis=-1)


def with_rope(t, pos_row, pos_col):
    return jnp.concatenate([t[..., :QK_NOPE_DIM], rope_2d(t[..., QK_NOPE_DIM:], pos_row, pos_col)], axis=-1)


def chunk_mlp(pu, pv, sgu_norm, w_sgu, b_sgu):
    b, n, _ = pu.shape
    u = jax.nn.gelu(pu)
    v = rms_norm(jax.nn.gelu(pv)) * sgu_norm
    v = v.reshape(b, n // CHUNK, CHUNK, SGU_HEADS, SGU_HEAD_DIM)
    z = jnp.einsum('hpq,bcqhd->bcphd', w_sgu, v) + b_sgu.T[:, :, None]
    return u * z.reshape(b, n, SGU_W)


def fourier_mix(pf):
    b, n, _ = pf.shape
    f = pf.reshape(b, n, FNET_GROUPS, FNET_GROUP_DIM).astype(jnp.float32)
    y = jnp.fft.fft2(f, axes=(1, 3), norm="ortho").real
    return y.reshape(b, n, FNET_W).astype(pf.dtype)


def mla_queries(pq, q_lora_norm, w_uq, q_norm):
    b, n, _ = pq.shape
    cq = rms_norm(pq) * q_lora_norm
    q = (cq @ w_uq).reshape(b, n, MLA_HEADS, QK_DIM)
    return rms_norm(q) * q_norm


def mla_keys_values(pkv, pkr, kv_lora_norm, w_ukv, k_norm):
    b, n, _ = pkv.shape
    ckv = rms_norm(pkv) * kv_lora_norm
    kv = (ckv @ w_ukv).reshape(b, n, MLA_HEADS, QK_NOPE_DIM + V_DIM)
    k_nope, v = kv[..., :QK_NOPE_DIM], kv[..., QK_NOPE_DIM:]
    k_rope = jnp.broadcast_to(pkr[:, :, None, :], (b, n, MLA_HEADS, QK_ROPE_DIM))
    k = rms_norm(jnp.concatenate([k_nope, k_rope], axis=-1)) * k_norm
    return k, v


def block_attention(q, k, v):
    b, n, h, _ = q.shape
    scale = QK_DIM ** -0.5
    qb = jnp.moveaxis(q.reshape(b, n // Q_BLOCK, Q_BLOCK, h, QK_DIM), 1, 0)

    def one_block(qblk):
        s = jnp.einsum('bqhd,bkhd->bhqk', qblk, k).astype(jnp.float32) * scale
        p = jax.nn.softmax(s, axis=-1).astype(v.dtype)
        return jnp.einsum('bhqk,bkhv->bqhv', p, v)

    o = lax.map(one_block, qb)
    return jnp.moveaxis(o, 0, 1).reshape(b, n, h * V_DIM)


def local_head_groups(p, sgu_norm, w_sgu, b_sgu, q_lora_norm, w_uq, q_norm):
    ya = chunk_mlp(p[..., OFF_U:OFF_V], p[..., OFF_V:OFF_F], sgu_norm, w_sgu, b_sgu)
    yb = fourier_mix(p[..., OFF_F:OFF_Q])
    q = mla_queries(p[..., OFF_Q:OFF_KV], q_lora_norm, w_uq, q_norm)
    return ya, yb, q


def expert_choice_moe(h, w_router, w_gate, w_up, w_down):
    b, n, d = h.shape
    cap = EC_FACTOR * n // N_EXPERTS
    aff = jax.nn.softmax(jnp.einsum('bnd,de->bne', h, w_router).astype(jnp.float32), axis=-1)
    g, idx = lax.top_k(jnp.swapaxes(aff, 1, 2), cap)
    xs = jax.vmap(lambda hb, ib: hb[ib])(h, idx)
    hid = jax.nn.silu(jnp.einsum('becd,edf->becf', xs, w_gate)) * jnp.einsum('becd,edf->becf', xs, w_up)
    y = jnp.einsum('becf,efd->becd', hid, w_down) * g[..., None].astype(h.dtype)
    return jax.vmap(lambda yb, ib: jnp.zeros((n, d), h.dtype).at[ib.reshape(-1)].add(yb.reshape(-1, d)))(y, idx)


def setup_inputs(seed: int = 0) -> dict:
    key = jax.random.key(seed)
    ks = jax.random.split(key, 22)

    def nrm(k, shape, scale):
        return jax.random.normal(k, shape, jnp.float32) * scale

    return {
        "x": nrm(ks[0], (BATCH, SEQ, D_MODEL), 1.0),
        "c": nrm(ks[1], (BATCH, D_MODEL), 1.0),
        "ctx": nrm(ks[2], (BATCH, CTX_LEN, D_MODEL), 1.0),
        "c_ctx": nrm(ks[3], (D_MODEL,), 1.0),
        "w_ada": nrm(ks[4], (DEPTH, D_MODEL, 6 * D_MODEL), 0.5 * D_MODEL ** -0.5),
        "b_ada": nrm(ks[5], (DEPTH, 6 * D_MODEL), 0.01),
        "w_in": nrm(ks[6], (DEPTH, D_MODEL, IN_W), D_MODEL ** -0.5),
        "sgu_norm": 1.0 + nrm(ks[7], (DEPTH, SGU_W), 0.01),
        "w_sgu": nrm(ks[8], (DEPTH, SGU_HEADS, CHUNK, CHUNK), CHUNK ** -0.5),
        "b_sgu": 1.0 + nrm(ks[9], (DEPTH, SGU_HEADS, CHUNK), 0.01),
        "q_lora_norm": 1.0 + nrm(ks[10], (DEPTH, Q_LORA), 0.01),
        "w_uq": nrm(ks[11], (DEPTH, Q_LORA, MLA_HEADS * QK_DIM), Q_LORA ** -0.5),
        "kv_lora_norm": 1.0 + nrm(ks[12], (DEPTH, KV_LORA), 0.01),
        "w_ukv": nrm(ks[13], (DEPTH, KV_LORA, MLA_HEADS * (QK_NOPE_DIM + V_DIM)), KV_LORA ** -0.5),
        "q_norm": 1.0 + nrm(ks[14], (DEPTH, QK_DIM), 0.01),
        "k_norm": 1.0 + nrm(ks[15], (DEPTH, QK_DIM), 0.01),
        "w_out": nrm(ks[16], (DEPTH, MIX_W, D_MODEL), MIX_W ** -0.5),
        "w_router": nrm(ks[17], (DEPTH, D_MODEL, N_EXPERTS), D_MODEL ** -0.5),
        "w_gate": nrm(ks[18], (DEPTH, N_EXPERTS, D_MODEL, D_EXPERT), D_MODEL ** -0.5),
        "w_up": nrm(ks[19], (DEPTH, N_EXPERTS, D_MODEL, D_EXPERT), D_MODEL ** -0.5),
        "w_down": nrm(ks[20], (DEPTH, N_EXPERTS, D_EXPERT, D_MODEL), D_EXPERT ** -0.5),
    }


def reference(x, c, ctx, c_ctx, w_ada, b_ada, w_in, sgu_norm, w_sgu, b_sgu, q_lora_norm, w_uq,
              kv_lora_norm, w_ukv, q_norm, k_norm, w_out, w_router, w_gate, w_up, w_down):
    n = x.shape[1]
    rows = n // GRID_W
    pos_row = jnp.repeat(jnp.arange(rows, dtype=jnp.int32), GRID_W)
    pos_col = jnp.tile(jnp.arange(GRID_W, dtype=jnp.int32), rows)
    xc = ctx
    for l in range(DEPTH):
        last = l == DEPTH - 1
        sh1, sc1, g1, sh2, sc2, g2 = ada_modulation(c, w_ada[l], b_ada[l])
        csh1, csc1, cg1, csh2, csc2, cg2 = ada_modulation(c_ctx[None], w_ada[l], b_ada[l])

        hx = modulate(x, sh1, sc1)
        hc = modulate(xc, csh1, csc1)
        col0 = OFF_KV if last else 0
        pc = hc @ w_in[l][:, col0:]
        k_ctx, v_ctx = mla_keys_values(pc[..., OFF_KV - col0:OFF_KR - col0], pc[..., OFF_KR - col0:],
                                       kv_lora_norm[l], w_ukv[l], k_norm[l])

        px = hx @ w_in[l]
        ya, yb, q = local_head_groups(px, sgu_norm[l], w_sgu[l], b_sgu[l], q_lora_norm[l], w_uq[l], q_norm[l])
        k, v = mla_keys_values(px[..., OFF_KV:OFF_KR], px[..., OFF_KR:], kv_lora_norm[l], w_ukv[l], k_norm[l])
        q = with_rope(q, pos_row, pos_col)
        k = with_rope(k, pos_row, pos_col)
        yc = block_attention(q, jnp.concatenate([k_ctx, k], axis=1), jnp.concatenate([v_ctx, v], axis=1))
        x = x + g1 * (jnp.concatenate([ya, yb, yc], axis=-1) @ w_out[l])

        if not last:
            ya_c, yb_c, q_c = local_head_groups(pc, sgu_norm[l], w_sgu[l], b_sgu[l], q_lora_norm[l], w_uq[l], q_norm[l])
            yc_c = block_attention(q_c, k_ctx, v_ctx)
            xc = xc + cg1 * (jnp.concatenate([ya_c, yb_c, yc_c], axis=-1) @ w_out[l])

        x = x + g2 * expert_choice_moe(modulate(x, sh2, sc2), w_router[l], w_gate[l], w_up[l], w_down[l])
        if not last:
            xc = xc + cg2 * expert_choice_moe(modulate(xc, csh2, csc2), w_router[l], w_gate[l], w_up[l], w_down[l])
    return x
```

```cpp
#include <hip/hip_runtime.h>
#include <hip/hip_cooperative_groups.h>
#include <stdint.h>
#include <stdio.h>
namespace cg = cooperative_groups;

typedef unsigned short u16;
typedef __attribute__((ext_vector_type(8))) short bf16x8;
typedef __attribute__((ext_vector_type(4))) float f32x4;
typedef unsigned __attribute__((ext_vector_type(4))) u32x4;
typedef unsigned __attribute__((ext_vector_type(2))) u32x2;

constexpr int DM = 1024;
constexpr int SEQ = 8192, CTX = 256;
constexpr int T_LAT = 2 * SEQ, T_CTX = 2 * CTX, TT = T_LAT + T_CTX;
constexpr int NPOS = SEQ + CTX;
constexpr int SMEM_BYTES = 71680;

struct Params {
  const float *x, *c, *ctx, *c_ctx, *w_ada, *b_ada, *w_in, *sgu_norm, *w_sgu, *b_sgu, *q_lora_norm, *w_uq,
      *kv_lora_norm, *w_ukv, *q_norm, *k_norm, *w_out, *w_router, *w_gate, *w_up, *w_down;
  float* out;
  unsigned* bar;
  float* mada;
  u16 *WinT, *WuqT, *WukvT, *WoutT, *WguT, *WdT, *Wsgu, *M1, *M2, *Mc;
  float* XC;
  u16 *H, *PX, *YM, *GD, *GDc, *PF, *QR, *KN, *Vt, *Qall, *Kb, *HID;
  float *AFFT, *GATE, *WR2, *CE;
  int *IDXG, *INV;
  u16* YB;
};

typedef float f32x2_t __attribute__((ext_vector_type(2)));
typedef __bf16 bf16x2_t __attribute__((ext_vector_type(2)));
__device__ __forceinline__ unsigned pack2(float a, float b) {
  f32x2_t v = {a, b};
  bf16x2_t r = __builtin_convertvector(v, bf16x2_t);
  return __builtin_bit_cast(unsigned, r);
}
__device__ __forceinline__ u16 f2bf(float f) { return (u16)(pack2(f, 0.f) & 0xffffu); }
__device__ __forceinline__ float bf2f(u16 b) { return __uint_as_float(((unsigned)b) << 16); }
__device__ __forceinline__ float wave_sum(float v) {
#pragma unroll
  for (int o = 32; o; o >>= 1) v += __shfl_xor(v, o);
  return v;
}
__device__ __forceinline__ int tid_() { int t = threadIdx.x; asm volatile("" : "+v"(t)); return t; }
__device__ __forceinline__ const struct Params* launder_(const struct Params* q) { asm volatile("" : "+s"(q)); return q; }
__device__ __forceinline__ int bid_() { int b = blockIdx.x; asm volatile("" : "+s"(b)); return b; }
__device__ __forceinline__ float gelu_tanh(float x) {
  float y = 0.7978845608028654f * (x + 0.044715f * x * x * x);
  return x / (1.f + __expf(-2.f * y));
}
__device__ __forceinline__ float silu_f(float x) { return x / (1.f + __expf(-x)); }

#define XB_TMO 128
#define XB_XCNT(j) (256 + 64 * (j))
#define XB_XSUB(j) (1280 + 64 * (j))
#define XB_XGEN(j) (2304 + 64 * (j))
#define XB_TOP 3328
#define XB_TOPGEN 3392
#define XCD_BAR_WORDS 3456
#define XB_SPIN_CAP (1u << 22)
#define LAS __attribute__((address_space(3)))

__device__ __forceinline__ unsigned xb_ld(unsigned* p) { return __hip_atomic_load(p, __ATOMIC_RELAXED, __HIP_MEMORY_SCOPE_AGENT); }
__device__ __forceinline__ unsigned xb_add(unsigned* p, unsigned v) { return __hip_atomic_fetch_add(p, v, __ATOMIC_RELAXED, __HIP_MEMORY_SCOPE_AGENT); }
__device__ __forceinline__ unsigned xb_xcc_id() { return (unsigned)__builtin_amdgcn_s_getreg((3 << 11) | 20) & 0xFu; }
#define XB_SPIN(cond, bar)                                            \
  do {                                                                \
    unsigned _sp = 0;                                                 \
    while (cond) {                                                    \
      __builtin_amdgcn_s_sleep(1);                                    \
      if ((++_sp & 255u) == 0u) {                                     \
        if (xb_ld(&(bar)[XB_TMO])) break;                             \
        if (_sp > XB_SPIN_CAP) { atomicAdd(&(bar)[XB_TMO], 1u); break; } \
      }                                                               \
    }                                                                 \
  } while (0)

struct XcdBarrier {
  unsigned* bar;
  unsigned x;
  volatile LAS unsigned* st;
};
__device__ __forceinline__ XcdBarrier xcd_barrier_post(unsigned* bar, volatile LAS unsigned* st) {
  XcdBarrier b;
  b.bar = bar;
  b.x = xb_xcc_id();
  b.st = st;
  if (threadIdx.x == 0) (void)xb_add(&bar[XB_XCNT(b.x)], 1u);
  return b;
}
__device__ __forceinline__ void xcd_barrier_complete(unsigned* bar, unsigned x, unsigned& nloc, unsigned& nx) {
  const unsigned G = gridDim.x * gridDim.y * gridDim.z;
  unsigned sum, cnt, mine, sp = 0u;
  for (;;) {
    sum = 0u; cnt = 0u; mine = 0u;
#pragma unroll
    for (unsigned j = 0; j < 16; ++j) {
      const unsigned c = xb_ld(&bar[XB_XCNT(j)]);
      sum += c; cnt += (c > 0u) ? 1u : 0u; mine = (j == x) ? c : mine;
    }
    if (sum == G) break;
    __builtin_amdgcn_s_sleep(1);
    if ((++sp & 255u) == 0u) {
      if (xb_ld(&bar[XB_TMO])) break;
      if (sp > XB_SPIN_CAP) { atomicAdd(&bar[XB_TMO], 1u); break; }
    }
  }
  nloc = mine > 0u ? mine : 1u;
  nx = cnt > 0u ? cnt : 1u;
}
__device__ __forceinline__ void xcd_barrier(const XcdBarrier& b) {
  asm volatile("s_waitcnt vmcnt(0)" ::: "memory");
  __syncthreads();
  if (threadIdx.x == 0) {
    unsigned* bar = b.bar;
    __builtin_amdgcn_s_waitcnt(0);
    unsigned nloc = b.st[0], nx = b.st[1];
    if (nloc == 0u) { xcd_barrier_complete(bar, b.x, nloc, nx); b.st[0] = nloc; b.st[1] = nx; }
    const unsigned old = xb_add(&bar[XB_XSUB(b.x)], 1u);
    const unsigned gen = old / nloc;
    if (old + 1u == (gen + 1u) * nloc) {
      __builtin_amdgcn_fence(__ATOMIC_RELEASE, "agent");
      asm volatile("s_waitcnt vmcnt(0)" ::: "memory");
      const unsigned og = xb_add(&bar[XB_TOP], 1u);
      const unsigned tg = og / nx;
      if (og + 1u == (tg + 1u) * nx) xb_add(&bar[XB_TOPGEN], 1u);
      else XB_SPIN(xb_ld(&bar[XB_TOPGEN]) == tg, bar);
      __builtin_amdgcn_fence(__ATOMIC_ACQUIRE, "agent");
      xb_add(&bar[XB_XGEN(b.x)], 1u);
      asm volatile("s_waitcnt vmcnt(0)" ::: "memory");
    } else {
      XB_SPIN(xb_ld(&bar[XB_XGEN(b.x)]) == gen, bar);
      __builtin_amdgcn_fence(__ATOMIC_ACQUIRE, "agent");
      asm volatile("s_waitcnt vmcnt(0)" ::: "memory");
    }
  }
  __syncthreads();
}

#define XCD_FOR(u, T)                                                                                         \
  for (int _x = bid_() & 7, _gb = gridDim.x >> 3, _hi = (int)(((long)(_x + 1) * (T)) >> 3),                    \
           u = (int)(((long)_x * (T)) >> 3) + (bid_() >> 3);                                                  \
       u < _hi; u += _gb)

template <int NT, bool BKN, bool MASK = false, bool ROWSS = false, class Epi>
__device__ __forceinline__ void gemm_tile(const u16* __restrict__ A, int lda, const int* __restrict__ arows, int mvalid,
                                          const u16* __restrict__ B, int ldb, int K, unsigned char* smem, Epi epi,
                                          const float* ascale = nullptr) {
  constexpr int BN = NT * 32;
  constexpr int CPR = BN / 8;
  u16* S0 = (u16*)smem;
  const int t = tid_(), lane = t & 63, wid = t >> 6, wr = wid >> 1, wc = wid & 1, l16 = lane & 15, quad = lane >> 4;
  const u16* ap[4];
  const u16* bp[NT];
  unsigned amask = 0u;
#pragma unroll
  for (int i = 0; i < 4; ++i) {
    const int row = (t >> 3) + 32 * i;
    const bool v = MASK ? (row < mvalid) : true;
    amask |= v ? (1u << i) : 0u;
    int r = v ? row : 0;
    if (arows) r = arows[r];
    ap[i] = A + (size_t)r * lda + (t & 7) * 8;
  }
#pragma unroll
  for (int i = 0; i < NT; ++i) {
    if (!BKN) bp[i] = B + (size_t)((t >> 3) + 32 * i) * ldb + (t & 7) * 8;
    else { const int c = t + 256 * i; bp[i] = B + (size_t)(c / CPR) * ldb + (c % CPR) * 8; }
  }
  const size_t bstep = BKN ? (size_t)64 * ldb : (size_t)64;
  int nmi = 4;
  if (MASK) { nmi = (mvalid - wr * 64 + 15) >> 4; nmi = nmi < 0 ? 0 : (nmi > 4 ? 4 : nmi); nmi = __builtin_amdgcn_readfirstlane(nmi); }
  u32x4 ra0[4], rb0[NT], ra1[4], rb1[NT];
#define GEMM_LOAD(RA, RB, kt_)                                                                      \
  {                                                                                                 \
    _Pragma("unroll") for (int i = 0; i < 4; ++i) {                                                 \
      RA[i] = *(const u32x4*)(ap[i] + (size_t)(kt_) * 64);                                          \
      if (MASK && !((amask >> i) & 1u)) RA[i] = (u32x4){0u, 0u, 0u, 0u};                            \
    }                                                                                               \
    _Pragma("unroll") for (int i = 0; i < NT; ++i) RB[i] = *(const u32x4*)(bp[i] + (size_t)(kt_) * bstep); \
  }
#define GEMM_STORE(RA, RB, st_)                                                                     \
  {                                                                                                 \
    u16* As_ = S0 + (st_) * 16384;                                                                  \
    u16* Bs_ = As_ + 8192;                                                                          \
    if (ROWSS) {                                                                                    \
      _Pragma("unroll") for (int i = 0; i < 4; ++i) {                                               \
        const u32x4 w_ = RA[i];                                                                     \
        const float a0 = __uint_as_float(w_.x << 16), a1 = __uint_as_float(w_.x & 0xffff0000u);     \
        const float a2 = __uint_as_float(w_.y << 16), a3 = __uint_as_float(w_.y & 0xffff0000u);     \
        const float a4 = __uint_as_float(w_.z << 16), a5 = __uint_as_float(w_.z & 0xffff0000u);     \
        const float a6 = __uint_as_float(w_.w << 16), a7 = __uint_as_float(w_.w & 0xffff0000u);     \
        ss_[i] += (a0 * a0 + a1 * a1) + (a2 * a2 + a3 * a3) + (a4 * a4 + a5 * a5) + (a6 * a6 + a7 * a7); \
      }                                                                                             \
    }                                                                                               \
    if (ascale) {                                                                                   \
      const float* sc_ = ascale + stk_ * 64 + (t & 7) * 8;                                          \
      const float4 s0_ = *(const float4*)(sc_), s1_ = *(const float4*)(sc_ + 4);                    \
      _Pragma("unroll") for (int i = 0; i < 4; ++i) {                                               \
        u32x4 w_ = RA[i];                                                                           \
        w_.x = pack2(__uint_as_float(w_.x << 16) * s0_.x, __uint_as_float(w_.x & 0xffff0000u) * s0_.y); \
        w_.y = pack2(__uint_as_float(w_.y << 16) * s0_.z, __uint_as_float(w_.y & 0xffff0000u) * s0_.w); \
        w_.z = pack2(__uint_as_float(w_.z << 16) * s1_.x, __uint_as_float(w_.z & 0xffff0000u) * s1_.y); \
        w_.w = pack2(__uint_as_float(w_.w << 16) * s1_.z, __uint_as_float(w_.w & 0xffff0000u) * s1_.w); \
        RA[i] = w_;                                                                                 \
      }                                                                                             \
    }                                                                                               \
    ++stk_;                                                                                         \
    _Pragma("unroll") for (int i = 0; i < 4; ++i) {                                                 \
      const int row = (t >> 3) + 32 * i;                                                            \
      *(u32x4*)(As_ + row * 64 + (((t & 7) ^ ((row >> 1) & 7)) << 3)) = RA[i];                      \
    }                                                                                               \
    if (!BKN) {                                                                                     \
      _Pragma("unroll") for (int i = 0; i < NT; ++i) {                                              \
        const int row = (t >> 3) + 32 * i;                                                          \
        *(u32x4*)(Bs_ + row * 64 + (((t & 7) ^ ((row >> 1) & 7)) << 3)) = RB[i];                    \
      }                                                                                             \
    } else {                                                                                        \
      _Pragma("unroll") for (int i = 0; i < NT; ++i) {                                              \
        const int c = t + 256 * i;                                                                  \
        const int k = c / CPR, n8 = (c % CPR) * 8;                                                  \
        const u32x4 w = RB[i];                                                                      \
        const unsigned e[8] = {w.x & 0xffffu, w.x >> 16, w.y & 0xffffu, w.y >> 16, w.z & 0xffffu, w.z >> 16, w.w & 0xffffu, w.w >> 16}; \
        _Pragma("unroll") for (int j = 0; j < 8; ++j) {                                             \
          const int n = n8 + j;                                                                     \
          Bs_[n * 64 + ((((k >> 3) ^ ((n >> 1) & 7))) << 3) + (k & 7)] = (u16)e[j];                 \
        }                                                                                           \
      }                                                                                             \
    }                                                                                               \
  }
#define GEMM_COMPUTE(st_)                                                                           \
  {                                                                                                 \
    const u16* As_ = S0 + (st_) * 16384;                                                            \
    const u16* Bs_ = As_ + 8192;                                                                    \
    _Pragma("unroll") for (int ks = 0; ks < 2; ++ks) {                                              \
      bf16x8 af[4], bfr[NT];                                                                        \
      _Pragma("unroll") for (int mi = 0; mi < 4; ++mi) {                                            \
        const int row = wr * 64 + mi * 16 + l16;                                                    \
        af[mi] = *(const bf16x8*)(As_ + row * 64 + (((ks * 4 + quad) ^ ((row >> 1) & 7)) << 3));    \
      }                                                                                             \
      _Pragma("unroll") for (int ni = 0; ni < NT; ++ni) {                                           \
        const int row = wc * (BN / 2) + ni * 16 + l16;                                              \
        bfr[ni] = *(const bf16x8*)(Bs_ + row * 64 + (((ks * 4 + quad) ^ ((row >> 1) & 7)) << 3));   \
      }                                                                                             \
      _Pragma("unroll") for (int mi = 0; mi < 4; ++mi)                                              \
        if (!MASK || mi < nmi)                                                                      \
        _Pragma("unroll") for (int ni = 0; ni < NT; ++ni) acc[mi][ni] = __builtin_amdgcn_mfma_f32_16x16x32_bf16(af[mi], bfr[ni], acc[mi][ni], 0, 0, 0); \
    }                                                                                               \
  }
  float ss_[4] = {0.f, 0.f, 0.f, 0.f};
  int stk_ = 0;
  f32x4 acc[4][NT];
#pragma unroll
  for (int i = 0; i < 4; ++i)
#pragma unroll
    for (int j = 0; j < NT; ++j) acc[i][j] = (f32x4){0.f, 0.f, 0.f, 0.f};
  const int nk = K >> 6;
  const int nkm1 = nk - 1;
  __syncthreads();
  GEMM_LOAD(ra0, rb0, 0);
  GEMM_LOAD(ra1, rb1, 1);
  GEMM_STORE(ra0, rb0, 0);
  GEMM_LOAD(ra0, rb0, (2 < nkm1 ? 2 : nkm1));
  __syncthreads();
  for (int kt = 0; kt < nk - 2; kt += 2) {
    GEMM_COMPUTE(0);
    GEMM_STORE(ra1, rb1, 1);
    GEMM_LOAD(ra1, rb1, kt + 3);
    __syncthreads();
    GEMM_COMPUTE(1);
    GEMM_STORE(ra0, rb0, 0);
    GEMM_LOAD(ra0, rb0, (kt + 4 < nkm1 ? kt + 4 : nkm1));
    __syncthreads();
  }
  GEMM_COMPUTE(0);
  GEMM_STORE(ra1, rb1, 1);
  __syncthreads();
  GEMM_COMPUTE(1);
#undef GEMM_LOAD
#undef GEMM_STORE
#undef GEMM_COMPUTE
  if (ROWSS) {
    float* rs = (float*)(smem + 65536);
#pragma unroll
    for (int i = 0; i < 4; ++i) {
      float s = ss_[i];
      s += __shfl_xor(s, 1); s += __shfl_xor(s, 2); s += __shfl_xor(s, 4);
      if ((t & 7) == 0) rs[(t >> 3) + 32 * i] = rsqrtf(s / (float)K + 1e-6f);
    }
    __syncthreads();
  }
  epi(acc, wr * 64 + quad * 4, wc * (BN / 2) + l16);
}

template <int NT, class VF, class RP>
__device__ __forceinline__ void epi_staged_bf16(f32x4 (&acc)[4][NT], int r0, int c0, unsigned char* smem, VF vf, RP rowptr) {
  constexpr int BN = NT * 32, PITCH = BN + 8, CPR = BN / 8;
  u16* Ts = (u16*)smem;
  const int t = tid_();
  __syncthreads();
#pragma unroll
  for (int mi = 0; mi < 4; ++mi)
#pragma unroll
    for (int ni = 0; ni < NT; ++ni)
#pragma unroll
      for (int j = 0; j < 4; ++j) {
        const int r = r0 + mi * 16 + j, c = c0 + ni * 16;
        Ts[r * PITCH + c] = f2bf(vf(r, c, acc[mi][ni][j]));
      }
  __syncthreads();
#pragma unroll
  for (int i = 0; i < CPR / 2; ++i) {
    const int c = t + 256 * i, row = c / CPR, ch = c % CPR;
    u16* d = rowptr(row);
    if (d) *(u32x4*)(d + ch * 8) = *(const u32x4*)(Ts + row * PITCH + ch * 8);
  }
}

template <class RP>
__device__ __forceinline__ void epi_staged_bf16_T(f32x4 (&acc)[4][4], int r0, int c0, unsigned char* smem, RP colptr) {
  constexpr int PITCH = 136;
  u16* Ts = (u16*)smem;
  const int t = tid_();
  __syncthreads();
#pragma unroll
  for (int mi = 0; mi < 4; ++mi)
#pragma unroll
    for (int ni = 0; ni < 4; ++ni) {
      u32x2 pk;
      pk.x = pack2(acc[mi][ni][0], acc[mi][ni][1]);
      pk.y = pack2(acc[mi][ni][2], acc[mi][ni][3]);
      *(u32x2*)(Ts + (c0 + ni * 16) * PITCH + r0 + mi * 16) = pk;
    }
  __syncthreads();
#pragma unroll
  for (int i = 0; i < 8; ++i) {
    const int c = t + 256 * i, col = c >> 4, ch = c & 15;
    *(u32x4*)(colptr(col) + ch * 8) = *(const u32x4*)(Ts + col * PITCH + ch * 8);
  }
}

__device__ __forceinline__ void epi_staged_residual(f32x4 (&acc)[4][4], int r0, int c0, unsigned char* smem, const float* __restrict__ g,
                                                    const float* __restrict__ xs, float* __restrict__ xd) {
  constexpr int PITCH = 132;
  float* Ts = (float*)smem;
  const int t = tid_();
  const int wr = r0 >> 6;
#pragma unroll
  for (int pass = 0; pass < 2; ++pass) {
    __syncthreads();
    if (wr == pass) {
#pragma unroll
      for (int mi = 0; mi < 4; ++mi)
#pragma unroll
        for (int ni = 0; ni < 4; ++ni)
#pragma unroll
          for (int j = 0; j < 4; ++j) Ts[((r0 & 63) + mi * 16 + j) * PITCH + c0 + ni * 16] = acc[mi][ni][j];
    }
    __syncthreads();
#pragma unroll
    for (int i = 0; i < 8; ++i) {
      const int c = t + 256 * i, row = c >> 5, ch = c & 31;
      const float4 a = *(const float4*)(Ts + row * PITCH + ch * 4);
      const float4 gg = *(const float4*)(g + ch * 4);
      const size_t o = (size_t)(pass * 64 + row) * DM + ch * 4;
      float4 x = *(const float4*)(xs + o);
      x.x += gg.x * a.x; x.y += gg.y * a.y; x.z += gg.z * a.z; x.w += gg.w * a.w;
      *(float4*)(xd + o) = x;
    }
  }
}

__device__ __forceinline__ void ada_item(const Params& p, int it, unsigned char* smem) {
  float* sc = (float*)smem;
  float* red = sc + 3072;
  const int t = tid_(), lane = t & 63, wid = t >> 6;
  const int l = it / 96, jc = it % 96;
#pragma unroll
  for (int i = 0; i < 12; ++i) {
    const int idx = t + 256 * i, r = idx >> 10, k = idx & 1023;
    const float cv = r < 2 ? p.c[r * 1024 + k] : p.c_ctx[k];
    sc[idx] = silu_f(cv);
  }
  __syncthreads();
  const float* w = p.w_ada + (size_t)l * 1024 * 6144 + jc * 64 + lane;
  float a0 = 0.f, a1 = 0.f, a2 = 0.f;
  const int kb = wid * 256;
#pragma unroll 8
  for (int k = 0; k < 256; ++k) {
    const float wv = w[(size_t)(kb + k) * 6144];
    a0 += sc[kb + k] * wv;
    a1 += sc[1024 + kb + k] * wv;
    a2 += sc[2048 + kb + k] * wv;
  }
  red[(wid * 3 + 0) * 64 + lane] = a0;
  red[(wid * 3 + 1) * 64 + lane] = a1;
  red[(wid * 3 + 2) * 64 + lane] = a2;
  __syncthreads();
  if (t < 192) {
    const int r = t >> 6, ln = t & 63;
    float s = 0.f;
#pragma unroll
    for (int w4 = 0; w4 < 4; ++w4) s += red[(w4 * 3 + r) * 64 + ln];
    s += p.b_ada[l * 6144 + jc * 64 + ln];
    p.mada[(l * 3 + r) * 6144 + jc * 64 + ln] = s;
  }
  asm volatile("s_waitcnt vmcnt(0)" ::: "memory");
  __syncthreads();
  if (t == 0) {
    __builtin_amdgcn_fence(__ATOMIC_RELEASE, "agent");
    asm volatile("s_waitcnt vmcnt(0)" ::: "memory");
    (void)xb_add(&p.bar[64], 1u);
  }
}

__device__ __forceinline__ void fold_item(const Params& p, int it, unsigned char* smem) {
  float* tile = (float*)smem;
  float* ct = tile + 64 * 65;
  const int t = tid_();
  const int l = it >> 6, rem = it & 63, g = rem >> 4, k0 = (rem & 15) * 64;
#pragma unroll
  for (int i = 0; i < 16; ++i) {
    const int kk = i * 4 + (t >> 6), d = t & 63;
    tile[kk * 65 + d] = p.w_in[(size_t)(l * 1024 + k0 + kk) * 1216 + 512 + g * 64 + d];
  }
  if (t < 64) ct[t] = cospif((float)t / 32.f);
  __syncthreads();
  const int k = t & 63, jg = t >> 6;
  u16* dst = p.WinT + (size_t)l * 1536 * 1024;
  for (int jj = 0; jj < 16; ++jj) {
    const int j = jg + 4 * jj;
    float sr = 0.f, si = 0.f;
#pragma unroll 8
    for (int d = 0; d < 64; ++d) {
      const float v = tile[k * 65 + d];
      const int m = (j * d) & 63;
      sr += v * ct[m];
      si += v * ct[(m - 16) & 63];
    }
    dst[(size_t)(512 + g * 64 + j) * 1024 + k0 + k] = f2bf(sr);
    dst[(size_t)(768 + g * 64 + j) * 1024 + k0 + k] = f2bf(-si);
  }
  __syncthreads();
}

__device__ __forceinline__ void convT_tile(const float* __restrict__ src, int lds, int k0, int c0, u16* __restrict__ dst, int Kd,
                                           int rbase, int mode, int which, unsigned char* smem, const float* __restrict__ kscale = nullptr) {
  float* tile = (float*)smem;
  const int t = tid_();
  float4 v4[4];
#pragma unroll
  for (int i = 0; i < 4; ++i) v4[i] = *(const float4*)(src + (size_t)(k0 + i * 16 + (t >> 4)) * lds + c0 + (t & 15) * 4);
#pragma unroll
  for (int i = 0; i < 4; ++i) {
    const int kk = i * 16 + (t >> 4), cc = (t & 15) * 4;
    const float sc = kscale ? kscale[k0 + kk] : 1.f;
    tile[kk * 65 + cc + 0] = v4[i].x * sc; tile[kk * 65 + cc + 1] = v4[i].y * sc;
    tile[kk * 65 + cc + 2] = v4[i].z * sc; tile[kk * 65 + cc + 3] = v4[i].w * sc;
  }
  __syncthreads();
#pragma unroll
  for (int i = 0; i < 16; ++i) {
    const int cc = i * 4 + (t >> 6), kk = t & 63;
    int row;
    if (mode == 0) row = rbase + cc;
    else { const int f = c0 + cc; row = (((f >> 4) * 2 + which) << 4) + (f & 15); }
    dst[(size_t)row * Kd + k0 + kk] = f2bf(tile[kk * 65 + cc]);
  }
  __syncthreads();
}

__device__ __forceinline__ void conv_item(const Params& p, int it, unsigned char* smem) {
  const int l = it / 6720;
  int r = it % 6720;
  if (r < 240) {
    const int ct = r >> 4, kt = r & 15;
    const int c0 = (ct < 8 ? ct : ct + 4) * 64;
    const int n0 = c0 + (c0 >= 768 ? 256 : 0);
    convT_tile(p.w_in + (size_t)l * 1024 * 1216, 1216, kt * 64, c0, p.WinT + (size_t)l * 1536 * 1024, 1024, n0, 0, 0, smem);
    return;
  }
  r -= 240;
  if (r < 48) {
    const int ct = r >> 2, kt = r & 3;
    convT_tile(p.w_uq + (size_t)l * 256 * 768, 768, kt * 64, ct * 64, p.WuqT + (size_t)l * 768 * 256, 256, ct * 64, 0, 0, smem, p.q_lora_norm + l * 256);
    return;
  }
  r -= 48;
  if (r < 32) {
    const int ct = r >> 1, kt = r & 1;
    convT_tile(p.w_ukv + (size_t)l * 128 * 1024, 1024, kt * 64, ct * 64, p.WukvT + (size_t)l * 1024 * 128, 128, ct * 64, 0, 0, smem, p.kv_lora_norm + l * 128);
    return;
  }
  r -= 32;
  if (r < 256) {
    const int ct = r >> 4, kt = r & 15;
    convT_tile(p.w_out + (size_t)l * 1024 * 1024, 1024, kt * 64, ct * 64, p.WoutT + (size_t)l * 1024 * 1024, 1024, ct * 64, 0, 0, smem);
    return;
  }
  r -= 256;
  if (r < 4096) {
    const int which = r >> 11, r2 = r & 2047, e = r2 >> 7, r3 = r2 & 127, ct = r3 >> 4, kt = r3 & 15;
    const float* src = (which ? p.w_up : p.w_gate) + (size_t)(l * 16 + e) * 1024 * 512;
    convT_tile(src, 512, kt * 64, ct * 64, p.WguT + (size_t)(l * 16 + e) * 1024 * 1024, 1024, 0, 1, which, smem);
    return;
  }
  r -= 4096;
  {
    const int e = r >> 7, r3 = r & 127, ct = r3 >> 3, kt = r3 & 7;
    convT_tile(p.w_down + (size_t)(l * 16 + e) * 512 * 1024, 1024, kt * 64, ct * 64, p.WdT + (size_t)(l * 16 + e) * 1024 * 512, 512, ct * 64, 0, 0, smem);
  }
}

__device__ __forceinline__ void elem_item(const Params& p, int it) {
  const int t = tid_();
  if (it < 128) {
#pragma unroll
    for (int i = 0; i < 4; ++i) { const int idx = it * 1024 + i * 256 + t; p.Wsgu[idx] = f2bf(p.w_sgu[idx]); }
    return;
  }
  it -= 128;
  if (it < 2048) {
#pragma unroll
    for (int i = 0; i < 4; ++i) {
      const int idx = it * 1024 + i * 256 + t;
      const int n1 = idx >> 14, m = (idx >> 7) & 127, kk = idx & 127;
      const int rip = m >> 6, k2 = m & 63, ri = kk >> 6, n2 = kk & 63;
      const int n = n1 + 128 * n2;
      const int ph = (k2 * n) & 8191;
      const float xx = (float)ph / 4096.f;
      const float cs = cospif(xx), sn = sinpif(xx);
      const float v = rip == 0 ? (ri == 0 ? cs : sn) : (ri == 0 ? -sn : cs);
      p.M1[idx] = f2bf(v);
    }
    return;
  }
  it -= 2048;
  if (it < 32) {
#pragma unroll
    for (int i = 0; i < 4; ++i) {
      const int idx = it * 1024 + i * 256 + t;
      const int k1 = idx >> 8, kk = idx & 255, ri = kk >> 7, n1 = kk & 127;
      const int ph = (k1 * n1) & 127;
      const float xx = (float)ph / 64.f;
      p.M2[idx] = f2bf(ri ? sinpif(xx) : cospif(xx));
    }
    return;
  }
  it -= 32;
  {
#pragma unroll
    for (int i = 0; i < 4; ++i) {
      const int idx = it * 1024 + i * 256 + t;
      const int k = idx >> 9, kk = idx & 511, ri = kk >> 8, n = kk & 255;
      const int ph = (k * n) & 255;
      const float xx = (float)ph / 128.f;
      p.Mc[idx] = f2bf(ri ? sinpif(xx) : cospif(xx));
    }
  }
}

__device__ __forceinline__ void phase_prep(const Params& p, unsigned char* smem) {
  const int G = gridDim.x;
  int t = bid_();
  for (; t < 192; t += G) ada_item(p, t, smem);
  t -= 192;
  for (; t < 128; t += G) fold_item(p, t, smem);
  t -= 128;
  for (; t < 13440; t += G) conv_item(p, t, smem);
  t -= 13440;
  for (; t < 2336; t += G) elem_item(p, t);
}

__device__ __forceinline__ int row_cond(int row) { return row < T_LAT ? (row >> 13) : 2; }
__device__ __forceinline__ int row_batch(int row) { return row < T_LAT ? (row >> 13) : ((row - T_LAT) >> 8); }
__device__ __forceinline__ int row_pos(int row) { return row < T_LAT ? (CTX + (row & (SEQ - 1))) : ((row - T_LAT) & (CTX - 1)); }

template <int R>
__device__ __forceinline__ void phase_modulate(const Params& p, int l, const float* xlat, const float* xctx, int nrows, int chunk, int bskip) {
  const int t = tid_(), lane = t & 63, wid = t >> 6;
  const int bb = bid_() - bskip;
  if (bb < 0) return;
  const int gw = bb * 4 + wid, nw = ((int)gridDim.x - bskip) * 4;
  for (int row0 = gw * R; row0 < nrows; row0 += nw * R) {
    const float* xr = row0 < T_LAT ? xlat + (size_t)row0 * DM : xctx + (size_t)(row0 - T_LAT) * DM;
    const float* sh = p.mada + (size_t)(l * 3 + row_cond(row0)) * 6144 + chunk * 1024;
    const float* sc = sh + 1024;
    float4 v[R][4];
#pragma unroll
    for (int r = 0; r < R; ++r)
#pragma unroll
      for (int i = 0; i < 4; ++i) v[r][i] = *(const float4*)(xr + (size_t)r * DM + i * 256 + lane * 4);
    float rstd[R];
#pragma unroll
    for (int r = 0; r < R; ++r) {
      float ss = 0.f;
#pragma unroll
      for (int i = 0; i < 4; ++i) ss += v[r][i].x * v[r][i].x + v[r][i].y * v[r][i].y + v[r][i].z * v[r][i].z + v[r][i].w * v[r][i].w;
      ss = wave_sum(ss);
      rstd[r] = rsqrtf(ss * (1.f / 1024.f) + 1e-6f);
    }
#pragma unroll
    for (int i = 0; i < 4; ++i) {
      const int col = i * 256 + lane * 4;
      const float4 s4 = *(const float4*)(sc + col);
      const float4 h4 = *(const float4*)(sh + col);
#pragma unroll
      for (int r = 0; r < R; ++r) {
        u32x2 pk;
        pk.x = pack2(v[r][i].x * rstd[r] * (1.f + s4.x) + h4.x, v[r][i].y * rstd[r] * (1.f + s4.y) + h4.y);
        pk.y = pack2(v[r][i].z * rstd[r] * (1.f + s4.z) + h4.z, v[r][i].w * rstd[r] * (1.f + s4.w) + h4.w);
        *(u32x2*)(p.H + (size_t)(row0 + r) * DM + col) = pk;
      }
    }
  }
}

__device__ __forceinline__ void phase_router_prep(const Params& p) {
  const int t = tid_(), lane = t & 63, wid = t >> 6;
  for (int i = bid_() * 256 + t; i < 2 * 3 * 16384; i += gridDim.x * 256) {
    const int lc = i >> 14, k = (i >> 4) & 1023, e = i & 15, l = lc / 3;
    p.WR2[i] = (1.f + p.mada[(size_t)lc * 6144 + 4 * 1024 + k]) * p.w_router[(size_t)l * 16384 + k * 16 + e];
  }
  for (int o = bid_() * 4 + wid; o < 96; o += gridDim.x * 4) {
    const int lc = o >> 4, e = o & 15, l = lc / 3;
    float s = 0.f;
    for (int k = lane; k < 1024; k += 64) s += p.mada[(size_t)lc * 6144 + 3 * 1024 + k] * p.w_router[(size_t)l * 16384 + k * 16 + e];
    s = wave_sum(s);
    if (lane == 0) p.CE[o] = s;
  }
}

__device__ __forceinline__ void phase_router(const Params& p, int l, const float* xlat, const float* xctx, int nrows) {
  const int t = tid_(), lane = t & 63, wid = t >> 6, l16 = lane & 15, quad = lane >> 4;
  const int gw = bid_() * 4 + wid, nw = gridDim.x * 4;
  const int ntile = nrows >> 4;
  for (int tile = gw; tile < ntile; tile += nw) {
    const int row0 = tile * 16;
    const int cond = row_cond(row0);
    const float* xr = (row0 < T_LAT ? xlat + (size_t)(row0 + l16) * DM : xctx + (size_t)(row0 - T_LAT + l16) * DM) + quad * 4;
    const float* wp = p.WR2 + (size_t)(l * 3 + cond) * 16384 + quad * 64 + l16;
    f32x4 acc = (f32x4){0.f, 0.f, 0.f, 0.f};
    float ss = 0.f;
#pragma unroll 4
    for (int s = 0; s < 64; ++s) {
      const float4 a = *(const float4*)(xr + s * 16);
      const float b0 = wp[s * 256], b1 = wp[s * 256 + 16], b2 = wp[s * 256 + 32], b3 = wp[s * 256 + 48];
      ss += a.x * a.x + a.y * a.y + a.z * a.z + a.w * a.w;
      acc = __builtin_amdgcn_mfma_f32_16x16x4f32(a.x, b0, acc, 0, 0, 0);
      acc = __builtin_amdgcn_mfma_f32_16x16x4f32(a.y, b1, acc, 0, 0, 0);
      acc = __builtin_amdgcn_mfma_f32_16x16x4f32(a.z, b2, acc, 0, 0, 0);
      acc = __builtin_amdgcn_mfma_f32_16x16x4f32(a.w, b3, acc, 0, 0, 0);
    }
    ss += __shfl_xor(ss, 16);
    ss += __shfl_xor(ss, 32);
    const float rstd = rsqrtf(ss * (1.f / 1024.f) + 1e-6f);
    const float ce = p.CE[(l * 3 + cond) * 16 + l16];
#pragma unroll
    for (int j = 0; j < 4; ++j) {
      const int tk = quad * 4 + j;
      const float r = __shfl(rstd, tk);
      const float lg = acc[j] * r + ce;
      float mx = lg;
#pragma unroll
      for (int o = 8; o; o >>= 1) mx = fmaxf(mx, __shfl_xor(mx, o));
      const float ex = __expf(lg - mx);
      float sm = ex;
#pragma unroll
      for (int o = 8; o; o >>= 1) sm += __shfl_xor(sm, o);
      const float aff = ex / sm;
      const int row = row0 + tk;
      if (row < T_LAT) p.AFFT[(size_t)((row >> 13) * 16 + l16) * SEQ + (row & (SEQ - 1))] = aff;
      else { const int rc = row - T_LAT; p.AFFT[(size_t)32 * SEQ + ((rc >> 8) * 16 + l16) * CTX + (rc & 255)] = aff; }
    }
  }
}

__device__ __forceinline__ void phase_in_gemm(const Params& p, int l, unsigned char* smem) {
  const u16* W = p.WinT + (size_t)l * 1536 * 1024;
  XCD_FOR(t, 132 * 11) {
    const int mt = t / 11, nt = t % 11;
    const int row_base = mt * 128;
    auto epi = [&](f32x4(&acc)[4][4], int r0, int c0) {
      const bool act = nt < 4;
      auto vf = [&](int, int, float v) { return act ? gelu_tanh(v) : v; };
      auto rp = [&](int r) -> u16* {
        const int row = row_base + r;
        if (nt < 4) return p.PX + (size_t)row * 1024 + nt * 128;
        if (nt >= 8) return p.PX + (size_t)row * 1024 + 512 + (nt - 8) * 128;
        const int ri = (nt - 4) >> 1, jx = ((nt - 4) & 1) * 128;
        if (row < T_LAT) return p.GD + ((size_t)((row >> 13) * 2 + ri) * SEQ + (row & (SEQ - 1))) * 256 + jx;
        const int rc = row - T_LAT;
        return p.GDc + ((size_t)((rc >> 8) * 2 + ri) * CTX + (rc & 255)) * 256 + jx;
      };
      epi_staged_bf16<4>(acc, r0, c0, smem, vf, rp);
    };
    gemm_tile<4, false>(p.H + (size_t)row_base * 1024, 1024, nullptr, 128, W + (size_t)nt * 128 * 1024, 1024, 1024, smem, epi);
  }
  XCD_FOR(t, 132) {
    const int row_base = t * 128;
    auto epi = [&](f32x4(&acc)[4][2], int r0, int c0) {
      auto vf = [&](int, int, float v) { return v; };
      auto rp = [&](int r) -> u16* { return p.PX + (size_t)(row_base + r) * 1024 + 896; };
      epi_staged_bf16<2>(acc, r0, c0, smem, vf, rp);
    };
    gemm_tile<2, false>(p.H + (size_t)row_base * 1024, 1024, nullptr, 128, W + (size_t)11 * 128 * 1024, 1024, 1024, smem, epi);
  }
}

__device__ __forceinline__ void phase_rownorm(const Params& p, int l) {
  constexpr int R = 4;
  const int t = tid_(), lane = t & 63, wid = t >> 6;
  const int gw = bid_() * 4 + wid, nw = gridDim.x * 4;
  const float* nv = p.sgu_norm + l * 256 + lane * 4;
  const float* nq = p.q_lora_norm + l * 256 + lane * 4;
  const float* nk = p.kv_lora_norm + l * 128 + lane * 2;
  for (int row0 = gw * R; row0 < TT; row0 += nw * R) {
    u16* px = p.PX + (size_t)row0 * 1024;
    u32x2 rv[R], rq[R];
    unsigned rk[R];
#pragma unroll
    for (int r = 0; r < R; ++r) {
      rv[r] = *(const u32x2*)(px + r * 1024 + 256 + lane * 4);
      rq[r] = *(const u32x2*)(px + r * 1024 + 512 + lane * 4);
      rk[r] = *(const unsigned*)(px + r * 1024 + 768 + lane * 2);
    }
#pragma unroll
    for (int r = 0; r < R; ++r) {
      {
        const float a = bf2f((u16)(rv[r].x & 0xffff)), b = bf2f((u16)(rv[r].x >> 16)), c = bf2f((u16)(rv[r].y & 0xffff)), d = bf2f((u16)(rv[r].y >> 16));
        const float rstd = rsqrtf(wave_sum(a * a + b * b + c * c + d * d) * (1.f / 256.f) + 1e-6f);
        u32x2 o;
        o.x = pack2(a * rstd * nv[0], b * rstd * nv[1]);
        o.y = pack2(c * rstd * nv[2], d * rstd * nv[3]);
        *(u32x2*)(px + r * 1024 + 256 + lane * 4) = o;
      }
      {
        const float a = bf2f((u16)(rq[r].x & 0xffff)), b = bf2f((u16)(rq[r].x >> 16)), c = bf2f((u16)(rq[r].y & 0xffff)), d = bf2f((u16)(rq[r].y >> 16));
        const float rstd = rsqrtf(wave_sum(a * a + b * b + c * c + d * d) * (1.f / 256.f) + 1e-6f);
        u32x2 o;
        o.x = pack2(a * rstd * nq[0], b * rstd * nq[1]);
        o.y = pack2(c * rstd * nq[2], d * rstd * nq[3]);
        *(u32x2*)(px + r * 1024 + 512 + lane * 4) = o;
      }
      {
        const float a = bf2f((u16)(rk[r] & 0xffff)), b = bf2f((u16)(rk[r] >> 16));
        const float rstd = rsqrtf(wave_sum(a * a + b * b) * (1.f / 128.f) + 1e-6f);
        *(unsigned*)(px + r * 1024 + 768 + lane * 2) = pack2(a * rstd * nk[0], b * rstd * nk[1]);
      }
    }
  }
}

__device__ __forceinline__ void phase_mix_a(const Params& p, int l, bool last, unsigned char* smem) {
  {
    const u16* W = p.WuqT + (size_t)l * 768 * 256;
    XCD_FOR(t, 132 * 6) {
      const int mt = t / 6, nt = t % 6, row_base = mt * 128;
      auto epi = [&](f32x4(&acc)[4][4], int r0, int c0) {
        const float* rs = (const float*)(smem + 65536);
        auto vf = [&](int r, int, float v) { return v * rs[r]; };
        auto rp = [&](int r) -> u16* { return p.QR + (size_t)(row_base + r) * 768 + nt * 128; };
        epi_staged_bf16<4>(acc, r0, c0, smem, vf, rp);
      };
      gemm_tile<4, false, false, true>(p.PX + (size_t)row_base * 1024 + 512, 1024, nullptr, 128, W + (size_t)nt * 128 * 256, 256, 256, smem, epi);
    }
  }
  {
    const u16* W = p.WukvT + (size_t)l * 1024 * 128;
    XCD_FOR(t, 132 * 8) {
      const int mt = t >> 3, nt = t & 7, row_base = mt * 128, h = nt >> 1;
      const int b = row_batch(row_base), pos_base = row_pos(row_base);
      auto epi = [&](f32x4(&acc)[4][4], int r0, int c0) {
#pragma unroll
        for (int mi = 0; mi < 4; ++mi)
#pragma unroll
          for (int ni = 0; ni < 4; ++ni) {
            const int col = c0 + ni * 16;
            if ((nt & 1) == 0) {
            } else {
              u32x2 pk;
              pk.x = pack2(acc[mi][ni][0], acc[mi][ni][1]);
              pk.y = pack2(acc[mi][ni][2], acc[mi][ni][3]);
              *(u32x2*)(p.Vt + ((size_t)(b * 4 + h) * 128 + col) * NPOS + pos_base + r0 + mi * 16) = pk;
            }
          }
      };
      auto epi2 = [&](f32x4(&acc)[4][4], int r0, int c0) {
        const float* rs = (const float*)(smem + 65536);
        if ((nt & 1) == 0) {
          auto vf = [&](int r, int, float v) { return v * rs[r]; };
          auto rp = [&](int r) -> u16* { return p.KN + (size_t)(row_base + r) * 512 + h * 128; };
          epi_staged_bf16<4>(acc, r0, c0, smem, vf, rp);
        } else {
#pragma unroll
          for (int mi = 0; mi < 4; ++mi)
#pragma unroll
            for (int j = 0; j < 4; ++j) {
              const float sc = rs[r0 + mi * 16 + j];
#pragma unroll
              for (int ni = 0; ni < 4; ++ni) acc[mi][ni][j] *= sc;
            }
          auto cp = [&](int c) -> u16* { return p.Vt + ((size_t)(b * 4 + h) * 128 + c) * NPOS + pos_base; };
          epi_staged_bf16_T(acc, r0, c0, smem, cp);
        }
      };
      gemm_tile<4, false, false, true>(p.PX + (size_t)row_base * 1024 + 768, 1024, nullptr, 128, W + (size_t)nt * 128 * 128, 128, 128, smem, epi2);
    }
  }
  {
    const int nch = last ? 128 : 132;
    XCD_FOR(t, nch * 4) {
      const int ch = t >> 2, h = t & 3, row_base = ch * 128;
      const float* bs = p.b_sgu + (l * 4 + h) * 128;
      const float* sgn = p.sgu_norm + l * 256 + h * 64;
      float* rsv = (float*)(smem + 65536 + 512);
      {
        const int t3 = tid_(), q = t3 >> 1, half = t3 & 1;
        const u16* vp = p.PX + (size_t)(row_base + q) * 1024 + 256 + half * 128;
        float s = 0.f;
#pragma unroll
        for (int i = 0; i < 16; ++i) {
          const u32x4 w = *(const u32x4*)(vp + i * 8);
          const float a0 = __uint_as_float(w.x << 16), a1 = __uint_as_float(w.x & 0xffff0000u), a2 = __uint_as_float(w.y << 16), a3 = __uint_as_float(w.y & 0xffff0000u);
          const float a4 = __uint_as_float(w.z << 16), a5 = __uint_as_float(w.z & 0xffff0000u), a6 = __uint_as_float(w.w << 16), a7 = __uint_as_float(w.w & 0xffff0000u);
          s += (a0 * a0 + a1 * a1) + (a2 * a2 + a3 * a3) + (a4 * a4 + a5 * a5) + (a6 * a6 + a7 * a7);
        }
        s += __shfl_xor(s, 1);
        __syncthreads();
        if (half == 0) rsv[q] = rsqrtf(s * (1.f / 256.f) + 1e-6f);
      }
      auto epi = [&](f32x4(&acc)[4][2], int r0, int c0) {
        float* Ts = (float*)smem;
        const int t2 = tid_();
        __syncthreads();
#pragma unroll
        for (int mi = 0; mi < 4; ++mi)
#pragma unroll
          for (int ni = 0; ni < 2; ++ni)
#pragma unroll
            for (int j = 0; j < 4; ++j) {
              const int pr = r0 + mi * 16 + j;
              Ts[pr * 68 + c0 + ni * 16] = acc[mi][ni][j] * sgn[c0 + ni * 16] + bs[pr];
            }
        __syncthreads();
#pragma unroll
        for (int i = 0; i < 4; ++i) {
          const int c = t2 + 256 * i, pr = c >> 3, ch = c & 7;
          const size_t o = (size_t)(row_base + pr) * 1024 + h * 64 + ch * 8;
          const u32x4 u = *(const u32x4*)(p.PX + o);
          const float4 z0 = *(const float4*)(Ts + pr * 68 + ch * 8), z1 = *(const float4*)(Ts + pr * 68 + ch * 8 + 4);
          u32x4 r;
          r.x = pack2(bf2f((u16)(u.x & 0xffffu)) * z0.x, bf2f((u16)(u.x >> 16)) * z0.y);
          r.y = pack2(bf2f((u16)(u.y & 0xffffu)) * z0.z, bf2f((u16)(u.y >> 16)) * z0.w);
          r.z = pack2(bf2f((u16)(u.z & 0xffffu)) * z1.x, bf2f((u16)(u.z >> 16)) * z1.y);
          r.w = pack2(bf2f((u16)(u.w & 0xffffu)) * z1.z, bf2f((u16)(u.w >> 16)) * z1.w);
          *(u32x4*)(p.YM + o) = r;
        }
      };
      gemm_tile<2, true>(p.Wsgu + (size_t)(l * 4 + h) * 16384, 128, nullptr, 128, p.PX + (size_t)row_base * 1024 + 256 + h * 64, 1024, 128, smem, epi, rsv);
    }
  }
  {
    XCD_FOR(t, 512) {
      const int nh = t & 1, n1 = (t >> 1) & 127, b = t >> 8;
      auto epi = [&](f32x4(&acc)[4][4], int r0, int c0) {
        auto vf = [&](int, int, float v) { return v; };
        auto rp = [&](int m) -> u16* { const int rip = m >> 6, k2 = m & 63; return p.PF + ((size_t)((b * 64 + k2) * 2 + rip) * 128 + n1) * 256 + nh * 128; };
        epi_staged_bf16<4>(acc, r0, c0, smem, vf, rp);
      };
      gemm_tile<4, true>(p.M1 + (size_t)n1 * 16384, 128, nullptr, 128, p.GD + (size_t)b * 2 * SEQ * 256 + (size_t)n1 * 256 + nh * 128, 128 * 256, 128, smem, epi);
    }
  }
  if (!last) {
    for (int t = bid_(); t < 8; t += gridDim.x) {
      const int nh = t & 1, mt = (t >> 1) & 1, b = t >> 2;
      auto epi = [&](f32x4(&acc)[4][4], int r0, int c0) {
#pragma unroll
        for (int mi = 0; mi < 4; ++mi)
#pragma unroll
          for (int ni = 0; ni < 4; ++ni)
#pragma unroll
            for (int j = 0; j < 4; ++j) {
              const int k = mt * 128 + r0 + mi * 16 + j;
              p.YM[(size_t)(T_LAT + b * CTX + k) * 1024 + 256 + nh * 128 + c0 + ni * 16] = f2bf(acc[mi][ni][j] * (1.f / 128.f));
            }
      };
      gemm_tile<4, true>(p.Mc + (size_t)mt * 128 * 512, 512, nullptr, 128, p.GDc + (size_t)b * 2 * CTX * 256 + nh * 128, 256, 512, smem, epi);
    }
  }
}

__device__ __forceinline__ void phase_mix_b(const Params& p, int l, bool last, unsigned char* smem) {
  XCD_FOR(t, 512) {
    const int nq = t & 3, k2 = (t >> 2) & 63, b = t >> 8;
    auto epi = [&](f32x4(&acc)[4][2], int r0, int c0) {
      auto vf = [&](int, int, float v) { return v * 0.001381067932004976f; };
      auto rp = [&](int k1) -> u16* { return p.YM + (size_t)(b * SEQ + 64 * k1 + k2) * 1024 + 256 + nq * 64; };
      epi_staged_bf16<2>(acc, r0, c0, smem, vf, rp);
    };
    gemm_tile<2, true>(p.M2, 256, nullptr, 128, p.PF + (size_t)(b * 64 + k2) * 2 * 128 * 256 + nq * 64, 256, 256, smem, epi);
  }
  const int tt = tid_(), lane = tt & 63, wid = tt >> 6;
  const int gw = bid_() * 4 + wid, nw = gridDim.x * 4;
  const float QSCALE = 0.07216878364870322f * 1.4426950408889634f;
  for (int row = gw; row < TT; row += nw) {
    const bool lat = row < T_LAT;
    const int b = row_batch(row), pos = row_pos(row);
    float cs = 1.f, sn = 0.f;
    if (lat) {
      const int n = row & (SEQ - 1);
      const int r = lane, sub = r & 31, i = sub & 15;
      const float ps = (r < 32) ? (float)(n >> 6) : (float)(n & 63);
      const float fr = __builtin_amdgcn_exp2f(-(float)i * 0.83048202372184058696f);
      const float ang = ps * fr;
      sn = __sinf(ang);
      cs = __cosf(ang);
    }
    const bool hi = ((lane & 31) >= 16);
    if (lat || !last) {
#pragma unroll
      for (int h = 0; h < 4; ++h) {
        const u16* q = p.QR + (size_t)row * 768 + h * 192;
        float v0 = bf2f(q[lane]), v1 = bf2f(q[lane + 64]), v2 = bf2f(q[lane + 128]);
        const float ss = wave_sum(v0 * v0 + v1 * v1 + v2 * v2);
        const float rstd = rsqrtf(ss * (1.f / 192.f) + 1e-6f);
        const float* qn = p.q_norm + l * 192;
        v0 *= rstd * qn[lane]; v1 *= rstd * qn[lane + 64]; v2 *= rstd * qn[lane + 128];
        if (lat) {
          const float xp = __shfl_xor(v2, 16);
          v2 = hi ? (xp * sn + v2 * cs) : (v2 * cs - xp * sn);
        }
        u16* o = p.Qall + ((size_t)(b * 4 + h) * NPOS + pos) * 192;
        o[lane] = f2bf(v0 * QSCALE); o[lane + 64] = f2bf(v1 * QSCALE); o[lane + 128] = f2bf(v2 * QSCALE);
      }
    }
    {
      const float kr = bf2f(p.PX[(size_t)row * 1024 + 896 + lane]);
#pragma unroll
      for (int h = 0; h < 4; ++h) {
        const u16* kk = p.KN + (size_t)row * 512 + h * 128;
        float v0 = bf2f(kk[lane]), v1 = bf2f(kk[lane + 64]), v2 = kr;
        const float ss = wave_sum(v0 * v0 + v1 * v1 + v2 * v2);
        const float rstd = rsqrtf(ss * (1.f / 192.f) + 1e-6f);
        const float* kn = p.k_norm + l * 192;
        v0 *= rstd * kn[lane]; v1 *= rstd * kn[lane + 64]; v2 *= rstd * kn[lane + 128];
        if (lat) {
          const float xp = __shfl_xor(v2, 16);
          v2 = hi ? (xp * sn + v2 * cs) : (v2 * cs - xp * sn);
        }
        u16* o = p.Kb + ((size_t)(b * 4 + h) * NPOS + pos) * 192;
        o[lane] = f2bf(v0); o[lane + 64] = f2bf(v1); o[lane + 128] = f2bf(v2);
      }
    }
  }
}

__device__ __forceinline__ void attn_item(const Params& p, int b, int h, int qt, unsigned char* smem) {
  constexpr int STAGE = 32 * 208 + 128 * 40;
  u16* sbase = (u16*)smem;
  const int t = tid_(), lane = t & 63, wid = t >> 6, l16 = lane & 15, quad = lane >> 4;
  const int nkeys = (qt < 2) ? CTX : NPOS;
  const int ntile = nkeys >> 5;
  const u16* Qp = p.Qall + ((size_t)(b * 4 + h) * NPOS + qt * 128 + wid * 32) * 192;
  const u16* kp = p.Kb + (size_t)(b * 4 + h) * NPOS * 192 + t * 8;
  const u16* vp = p.Vt + (size_t)(b * 4 + h) * 128 * NPOS + (size_t)(t >> 2) * NPOS + (t & 3) * 8;
  const u16* qlane = Qp + (size_t)l16 * 192 + quad * 8;
  bf16x8 bq[2][6];
#pragma unroll
  for (int qi = 0; qi < 2; ++qi)
#pragma unroll
    for (int ks = 0; ks < 6; ++ks) bq[qi][ks] = *(const bf16x8*)(qlane + qi * 16 * 192 + ks * 32);
  f32x4 o[8][2];
#pragma unroll
  for (int vt = 0; vt < 8; ++vt)
#pragma unroll
    for (int qi = 0; qi < 2; ++qi) o[vt][qi] = (f32x4){0.f, 0.f, 0.f, 0.f};
  float mrun0 = -1e30f, mrun1 = -1e30f, lrun0 = 0.f, lrun1 = 0.f;
  u32x4 rk[3], rv[2];
  f32x4 sA[2][2], sB[2][2];
#define ATT_LOAD(kt_)                                                                                   \
  {                                                                                                     \
    _Pragma("unroll") for (int i = 0; i < 3; ++i) rk[i] = *(const u32x4*)(kp + (size_t)(kt_) * 6144 + i * 2048); \
    _Pragma("unroll") for (int i = 0; i < 2; ++i) rv[i] = *(const u32x4*)(vp + (size_t)(64 * i) * NPOS + (kt_) * 32); \
  }
#define ATT_STORE(st_)                                                                                  \
  {                                                                                                     \
    u16* kd = sbase + (st_) * STAGE;                                                                    \
    _Pragma("unroll") for (int i = 0; i < 3; ++i) {                                                     \
      const int c = t + 256 * i;                                                                        \
      *(u32x4*)(kd + (c / 24) * 208 + (c % 24) * 8) = rk[i];                                            \
    }                                                                                                   \
    _Pragma("unroll") for (int i = 0; i < 2; ++i) *(u32x4*)(kd + 6656 + ((t >> 2) + 64 * i) * 40 + (t & 3) * 8) = rv[i]; \
  }
#define ATT_S(SX, kst_)                                                                                 \
  {                                                                                                     \
    const u16* Ks = sbase + (kst_) * STAGE;                                                             \
    _Pragma("unroll") for (int a = 0; a < 2; ++a)                                                       \
      _Pragma("unroll") for (int qi = 0; qi < 2; ++qi) SX[a][qi] = (f32x4){0.f, 0.f, 0.f, 0.f};         \
    _Pragma("unroll") for (int ks = 0; ks < 6; ++ks) {                                                  \
      _Pragma("unroll") for (int a = 0; a < 2; ++a) {                                                   \
        const bf16x8 kf = *(const bf16x8*)(Ks + (a * 16 + l16) * 208 + ks * 32 + quad * 8);             \
        _Pragma("unroll") for (int qi = 0; qi < 2; ++qi) SX[a][qi] = __builtin_amdgcn_mfma_f32_16x16x32_bf16(kf, bq[qi][ks], SX[a][qi], 0, 0, 0); \
      }                                                                                                 \
    }                                                                                                   \
  }
#define ATT_VLOAD(vst_, hv_)                                                                            \
  {                                                                                                     \
    const u16* Vs = sbase + (vst_) * STAGE + 6656;                                                      \
    _Pragma("unroll") for (int vt = 0; vt < 4; ++vt) {                                                  \
      const u16* vb = Vs + (((hv_) * 4 + vt) * 16 + l16) * 40 + quad * 4;                               \
      const u32x2 va = *(const u32x2*)(vb);                                                             \
      const u32x2 vc = *(const u32x2*)(vb + 16);                                                        \
      const u32x4 vw = {va.x, va.y, vc.x, vc.y};                                                        \
      vfr[vt] = (bf16x8)vw;                                                                             \
    }                                                                                                   \
  }
#define ATT_DECIDE(SX)                                                                                  \
  {                                                                                                     \
    _Pragma("unroll") for (int qi = 0; qi < 2; ++qi) {                                                  \
      float mx = fmaxf(fmaxf(fmaxf(SX[0][qi][0], SX[0][qi][1]), fmaxf(SX[0][qi][2], SX[0][qi][3])),     \
                       fmaxf(fmaxf(SX[1][qi][0], SX[1][qi][1]), fmaxf(SX[1][qi][2], SX[1][qi][3])));    \
      auto r16 = __builtin_amdgcn_permlane16_swap(__float_as_uint(mx), __float_as_uint(mx), false, false); \
      mx = fmaxf(__uint_as_float(r16[0]), __uint_as_float(r16[1]));                                     \
      auto r32 = __builtin_amdgcn_permlane32_swap(__float_as_uint(mx), __float_as_uint(mx), false, false); \
      mx = fmaxf(__uint_as_float(r32[0]), __uint_as_float(r32[1]));                                     \
      const float mold = qi ? mrun1 : mrun0;                                                            \
      if (__any(mx > mold + 8.f)) {                                                                     \
        const float mnew = fmaxf(mold, mx);                                                             \
        const float alpha = __builtin_amdgcn_exp2f(mold - mnew);                                        \
        if (qi) { lrun1 *= alpha; mrun1 = mnew; } else { lrun0 *= alpha; mrun0 = mnew; }                \
        _Pragma("unroll") for (int vt = 0; vt < 8; ++vt) {                                              \
          o[vt][qi][0] *= alpha; o[vt][qi][1] *= alpha; o[vt][qi][2] *= alpha; o[vt][qi][3] *= alpha;   \
        }                                                                                               \
      }                                                                                                 \
    }                                                                                                   \
  }
#define ATT_FINISH(SX, vst_)                                                                            \
  {                                                                                                     \
    bf16x8 pb[2];                                                                                       \
    _Pragma("unroll") for (int qi = 0; qi < 2; ++qi) {                                                  \
      const float mcur = qi ? mrun1 : mrun0;                                                            \
      float psum = 0.f;                                                                                 \
      _Pragma("unroll") for (int a = 0; a < 2; ++a)                                                     \
        _Pragma("unroll") for (int j = 0; j < 4; ++j) {                                                 \
          const float pe = __builtin_amdgcn_exp2f(SX[a][qi][j] - mcur);                                 \
          SX[a][qi][j] = pe;                                                                            \
          psum += pe;                                                                                   \
        }                                                                                               \
      if (qi) lrun1 += psum; else lrun0 += psum;                                                        \
      u32x4 pk;                                                                                         \
      pk.x = pack2(SX[0][qi][0], SX[0][qi][1]);                                                         \
      pk.y = pack2(SX[0][qi][2], SX[0][qi][3]);                                                         \
      pk.z = pack2(SX[1][qi][0], SX[1][qi][1]);                                                         \
      pk.w = pack2(SX[1][qi][2], SX[1][qi][3]);                                                         \
      pb[qi] = (bf16x8)pk;                                                                              \
    }                                                                                                   \
    _Pragma("unroll") for (int vt = 0; vt < 4; ++vt)                                                    \
      _Pragma("unroll") for (int qi = 0; qi < 2; ++qi) o[vt][qi] = __builtin_amdgcn_mfma_f32_16x16x32_bf16(vfr[vt], pb[qi], o[vt][qi], 0, 0, 0); \
    ATT_VLOAD(vst_, 1);                                                                                 \
    _Pragma("unroll") for (int vt = 0; vt < 4; ++vt)                                                    \
      _Pragma("unroll") for (int qi = 0; qi < 2; ++qi) o[4 + vt][qi] = __builtin_amdgcn_mfma_f32_16x16x32_bf16(vfr[vt], pb[qi], o[4 + vt][qi], 0, 0, 0); \
  }
#define ATT_STEP(SNEW, SOLD, tt_)                                                                       \
  {                                                                                                     \
    const int tn_ = ((tt_) + 1 < ntile) ? (tt_) + 1 : ntile - 1;                                        \
    ATT_LOAD(tn_);                                                                                      \
    bf16x8 vfr[4];                                                                                      \
    ATT_VLOAD(((tt_) - 1) % 3, 0);                                                                      \
    ATT_DECIDE(SOLD);                                                                                   \
    ATT_S(SNEW, (tt_) % 3);                                                                             \
    ATT_FINISH(SOLD, ((tt_) - 1) % 3);                                                                  \
    ATT_STORE(((tt_) + 1) % 3);                                                                         \
    __syncthreads();                                                                                    \
  }
  __syncthreads();
  ATT_LOAD(0);
  ATT_STORE(0);
  ATT_LOAD(1);
  __syncthreads();
  ATT_S(sA, 0);
  ATT_STORE(1);
  __syncthreads();
  for (int tt = 1; tt < ntile - 1; tt += 2) {
    ATT_STEP(sB, sA, tt);
    ATT_STEP(sA, sB, tt + 1);
  }
  ATT_STEP(sB, sA, ntile - 1);
  {
    bf16x8 vfr[4];
    ATT_VLOAD((ntile - 1) % 3, 0);
    ATT_DECIDE(sB);
    ATT_FINISH(sB, (ntile - 1) % 3);
  }
  __syncthreads();
#undef ATT_LOAD
#undef ATT_STORE
#undef ATT_S
#undef ATT_VLOAD
#undef ATT_DECIDE
#undef ATT_FINISH
#undef ATT_STEP
#pragma unroll
  for (int qi = 0; qi < 2; ++qi) {
    float ls = qi ? lrun1 : lrun0;
    ls += __shfl_xor(ls, 16);
    ls += __shfl_xor(ls, 32);
    const float inv = 1.f / ls;
    const int pos = qt * 128 + wid * 32 + qi * 16 + l16;
    const int row = (pos < CTX) ? (T_LAT + b * CTX + pos) : (b * SEQ + pos - CTX);
    u16* orow = p.YM + (size_t)row * 1024 + 512 + h * 128 + quad * 4;
#pragma unroll
    for (int vt = 0; vt < 8; ++vt) {
      u32x2 pk;
      pk.x = pack2(o[vt][qi][0] * inv, o[vt][qi][1] * inv);
      pk.y = pack2(o[vt][qi][2] * inv, o[vt][qi][3] * inv);
      *(u32x2*)(orow + vt * 16) = pk;
    }
  }
}

__device__ __forceinline__ void phase_attn(const Params& p, bool last, unsigned char* smem) {
  const int x = bid_() & 7, j = bid_() >> 3, gb = gridDim.x >> 3;
  for (int q = j; q < 64; q += gb) attn_item(p, x >> 2, x & 3, 2 + q, smem);
  if (!last)
    for (int q = j; q < 2; q += gb) attn_item(p, x >> 2, x & 3, q, smem);
}

__device__ __forceinline__ void phase_out_gemm(const Params& p, int l, bool last, const float* slat, const float* sctx, float* dlat, float* dctx, unsigned char* smem) {
  const u16* W = p.WoutT + (size_t)l * 1024 * 1024;
  XCD_FOR(t, 128 * 8) {
    const int mt = t >> 3, nt = t & 7, row_base = mt * 128;
    const float* g1 = p.mada + (size_t)(l * 3 + (row_base >> 13)) * 6144 + 2 * 1024 + nt * 128;
    const float* xs = slat + (size_t)row_base * DM;
    float* xd = dlat + (size_t)row_base * DM;
    auto epi = [&](f32x4(&acc)[4][4], int r0, int c0) { epi_staged_residual(acc, r0, c0, smem, g1, xs + nt * 128, xd + nt * 128); };
    gemm_tile<4, false>(p.YM + (size_t)row_base * 1024, 1024, nullptr, 128, W + (size_t)nt * 128 * 1024, 1024, 1024, smem, epi);
  }
  if (!last) {
    XCD_FOR(t, 4 * 32) {
      const int mt = t >> 5, nt = t & 31, row_base = mt * 128;
      const float* g1 = p.mada + (size_t)(l * 3 + 2) * 6144 + 2 * 1024 + nt * 32;
      const float* xs = sctx + (size_t)row_base * DM;
      float* xd = dctx + (size_t)row_base * DM;
      auto epi = [&](f32x4(&acc)[4][1], int r0, int c0) {
#pragma unroll
        for (int mi = 0; mi < 4; ++mi) {
          const float g = g1[c0];
#pragma unroll
          for (int j = 0; j < 4; ++j) {
            const size_t o = (size_t)(r0 + mi * 16 + j) * DM + nt * 32 + c0;
            xd[o] = xs[o] + g * acc[mi][0][j];
          }
        }
      };
      gemm_tile<1, false>(p.YM + (size_t)(T_LAT + row_base) * 1024, 1024, nullptr, 128, W + (size_t)nt * 32 * 1024, 1024, 1024, smem, epi);
    }
  }
}

__device__ __forceinline__ unsigned block_incl_scan(unsigned x, unsigned* wsum, int lane, int wid, unsigned& total) {
  unsigned v = x;
#pragma unroll
  for (int off = 1; off < 64; off <<= 1) {
    const unsigned n = __shfl_up(v, off);
    if (lane >= off) v += n;
  }
  __syncthreads();
  if (lane == 63) wsum[wid] = v;
  __syncthreads();
  const unsigned w0 = wsum[0], w1 = wsum[1], w2 = wsum[2], w3 = wsum[3];
  total = w0 + w1 + w2 + w3;
  const unsigned base = (wid > 0 ? w0 : 0u) + (wid > 1 ? w1 : 0u) + (wid > 2 ? w2 : 0u);
  return base + v;
}

__device__ __forceinline__ void phase_topk(const Params& p, bool last, unsigned char* smem) {
  unsigned* key = (unsigned*)smem;
  unsigned* hist = key + 8192;
  unsigned* wsum = hist + 256;
  unsigned* sh = wsum + 4;
  const int t = tid_(), lane = t & 63, wid = t >> 6;
  const int ninst = last ? 32 : 64;
  for (int inst = bid_(); inst < ninst; inst += gridDim.x) {
    const bool lat = inst < 32;
    const int n = lat ? SEQ : CTX, cap = lat ? 1024 : 32;
    const float* src = lat ? p.AFFT + (size_t)inst * SEQ : p.AFFT + (size_t)32 * SEQ + (inst - 32) * CTX;
    const int rowbase = lat ? (inst >> 4) * SEQ : T_LAT + ((inst - 32) >> 4) * CTX;
    for (int i = t; i < n; i += 256) key[i] = __float_as_uint(src[i]);
    unsigned prefix = 0u, mask = 0u, remaining = (unsigned)cap;
    for (int shift = 24; shift >= 0; shift -= 8) {
      hist[t] = 0u;
      __syncthreads();
      for (int i = t; i < n; i += 256) {
        const unsigned k = key[i];
        if ((k & mask) == prefix) atomicAdd(&hist[(k >> shift) & 255u], 1u);
      }
      __syncthreads();
      const unsigned hc = hist[t];
      unsigned total;
      const unsigned incl = block_incl_scan(hc, wsum, lane, wid, total);
      const unsigned suf = total - incl + hc;
      const unsigned sufn = total - incl;
      if (suf >= remaining && sufn < remaining) { sh[0] = prefix | ((unsigned)t << shift); sh[1] = remaining - sufn; }
      __syncthreads();
      prefix = sh[0];
      remaining = sh[1];
      mask |= (255u << shift);
      __syncthreads();
    }
    const int per = n >> 8;
    unsigned cgt = 0u, ceq = 0u;
    for (int i = 0; i < per; ++i) {
      const unsigned k = key[t * per + i];
      cgt += (k > prefix) ? 1u : 0u;
      ceq += (k == prefix) ? 1u : 0u;
    }
    unsigned ngt, neq;
    unsigned og = block_incl_scan(cgt, wsum, lane, wid, ngt) - cgt;
    unsigned oe = block_incl_scan(ceq, wsum, lane, wid, neq) - ceq;
    int* idx = p.IDXG + (size_t)inst * 1024;
    float* gt = p.GATE + (size_t)inst * 1024;
    int* inv = p.INV + (size_t)rowbase * 16 + (inst & 15);
    for (int i = 0; i < per; ++i) {
      const int e = t * per + i;
      const unsigned k = key[e];
      int slot = -1;
      if (k > prefix) {
        slot = (int)og; ++og;
      } else if (k == prefix) {
        if (oe < remaining) slot = (int)(ngt + oe);
        ++oe;
      }
      if (slot >= 0) { idx[slot] = rowbase + e; gt[slot] = __uint_as_float(k); }
      inv[(size_t)e * 16] = slot;
    }
    __syncthreads();
  }
}

__device__ __forceinline__ void phase_moe_up(const Params& p, int l, bool last, unsigned char* smem) {
  const int npass = last ? 1 : 2;
  for (int pass = 0; pass < npass; ++pass)
  XCD_FOR(t, ((pass == npass - 1) ? 2048 : 256)) {
    int inst, mt, nt, mvalid, hid_row;
    if (pass == npass - 1) { const int e_ = t >> 7, b_ = (t >> 6) & 1; inst = b_ * 16 + e_; mt = (t >> 3) & 7; nt = t & 7; mvalid = 128; hid_row = inst * 1024 + mt * 128; }
    else { const int e_ = t >> 4, b_ = (t >> 3) & 1; inst = 32 + b_ * 16 + e_; mt = 0; nt = t & 7; mvalid = 32; hid_row = 32768 + (inst - 32) * 128; }
    const int e = inst & 15;
    const u16* W = p.WguT + (size_t)(l * 16 + e) * 1024 * 1024 + (size_t)nt * 128 * 1024;
    auto epi = [&](f32x4(&acc)[4][4], int r0, int c0) {
      u16* Ts = (u16*)smem;
      const int t2 = tid_();
      __syncthreads();
#pragma unroll
      for (int mi = 0; mi < 4; ++mi)
#pragma unroll
        for (int n2 = 0; n2 < 2; ++n2)
#pragma unroll
          for (int j = 0; j < 4; ++j) {
            const int m = r0 + mi * 16 + j;
            const int fl = (c0 >> 6) * 32 + n2 * 16 + (c0 & 15);
            Ts[m * 72 + fl] = f2bf(silu_f(acc[mi][2 * n2][j]) * acc[mi][2 * n2 + 1][j]);
          }
      __syncthreads();
#pragma unroll
      for (int i = 0; i < 4; ++i) {
        const int c = t2 + 256 * i, row = c >> 3, ch = c & 7;
        if (row < mvalid) *(u32x4*)(p.HID + (size_t)(hid_row + row) * 512 + nt * 64 + ch * 8) = *(const u32x4*)(Ts + row * 72 + ch * 8);
      }
    };
    if (mvalid == 128) gemm_tile<4, false, false>(p.H, 1024, p.IDXG + (size_t)inst * 1024 + mt * 128, 128, W, 1024, 1024, smem, epi);
    else gemm_tile<4, false, true>(p.H, 1024, p.IDXG + (size_t)inst * 1024 + mt * 128, mvalid, W, 1024, 1024, smem, epi);
  }
}

__device__ __forceinline__ void phase_moe_down(const Params& p, int l, bool last, unsigned char* smem) {
  const int npass = last ? 1 : 2;
  for (int pass = 0; pass < npass; ++pass)
  XCD_FOR(t, ((pass == npass - 1) ? 2048 : 256)) {
    int inst, mt, nt, mvalid, hid_row;
    if (pass == npass - 1) { const int e_ = t >> 7, b_ = (t >> 6) & 1; inst = b_ * 16 + e_; mt = (t >> 3) & 7; nt = t & 7; mvalid = 128; hid_row = inst * 1024 + mt * 128; }
    else { const int e_ = t >> 4, b_ = (t >> 3) & 1; inst = 32 + b_ * 16 + e_; mt = 0; nt = t & 7; mvalid = 32; hid_row = 32768 + (inst - 32) * 128; }
    const int e = inst & 15;
    const float* gate = p.GATE + (size_t)inst * 1024 + mt * 128;
    const u16* W = p.WdT + (size_t)(l * 16 + e) * 1024 * 512 + (size_t)nt * 128 * 512;
    u16* yb = p.YB + (size_t)hid_row * 1024 + nt * 128;
    auto epi = [&](f32x4(&acc)[4][4], int r0, int c0) {
      auto vf = [&](int r, int, float v) { return (r < mvalid ? gate[r] : 0.f) * v; };
      auto rp = [&](int r) -> u16* { return r < mvalid ? yb + (size_t)r * 1024 : nullptr; };
      epi_staged_bf16<4>(acc, r0, c0, smem, vf, rp);
    };
    if (mvalid == 128) gemm_tile<4, false, false>(p.HID + (size_t)hid_row * 512, 512, nullptr, 128, W, 512, 512, smem, epi);
    else gemm_tile<4, false, true>(p.HID + (size_t)hid_row * 512, 512, nullptr, mvalid, W, 512, 512, smem, epi);
  }
}

template <bool COMBINE, bool MOD>
__device__ __forceinline__ void phase_combine_modulate(const Params& p, int lprev, int lnext, const float* xlat, const float* xctx,
                                                       float* olat, float* octx, int nrows) {
  constexpr int R = 2;
  const int t = tid_(), lane = t & 63, wid = t >> 6;
  const int gw = bid_() * 4 + wid, nw = gridDim.x * 4;
  for (int row0 = gw * R; row0 < nrows; row0 += nw * R) {
    const bool lat = row0 < T_LAT;
    const float* xr = lat ? xlat + (size_t)row0 * DM : xctx + (size_t)(row0 - T_LAT) * DM;
    const int cond = row_cond(row0);
    float4 v[R][4];
#pragma unroll
    for (int r = 0; r < R; ++r)
#pragma unroll
      for (int i = 0; i < 4; ++i) v[r][i] = *(const float4*)(xr + (size_t)r * DM + i * 256 + lane * 4);
    if (COMBINE) {
      const int b = row_batch(row0);
      const int myinv = p.INV[(size_t)row0 * 16 + (lane & 31)];
      const float* g2 = p.mada + (size_t)(lprev * 3 + cond) * 6144 + 5 * 1024;
      float* orow = lat ? olat + (size_t)row0 * DM : octx + (size_t)(row0 - T_LAT) * DM;
#pragma unroll
      for (int r = 0; r < R; ++r) {
        float4 s[4];
#pragma unroll
        for (int i = 0; i < 4; ++i) s[i] = make_float4(0.f, 0.f, 0.f, 0.f);
        unsigned mask = (unsigned)((__ballot(myinv >= 0) >> (16 * r)) & 0xFFFFull);
        while (mask) {
          const int e0 = __builtin_ctz(mask);
          mask &= mask - 1;
          const bool two = mask != 0u;
          const int e1 = two ? __builtin_ctz(mask) : e0;
          mask &= mask - 1;
          const int s0 = __shfl(myinv, 16 * r + e0), s1 = __shfl(myinv, 16 * r + e1);
          const size_t y0 = lat ? (size_t)(b * 16 + e0) * 1024 + s0 : (size_t)32768 + (size_t)(b * 16 + e0) * 128 + s0;
          const size_t y1 = lat ? (size_t)(b * 16 + e1) * 1024 + s1 : (size_t)32768 + (size_t)(b * 16 + e1) * 128 + s1;
          u32x2 a0[4], a1[4];
#pragma unroll
          for (int i = 0; i < 4; ++i) { a0[i] = *(const u32x2*)(p.YB + y0 * 1024 + lane * 4 + i * 256); a1[i] = *(const u32x2*)(p.YB + y1 * 1024 + lane * 4 + i * 256); }
          const float w1 = two ? 1.f : 0.f;
#pragma unroll
          for (int i = 0; i < 4; ++i) {
            s[i].x += bf2f((u16)(a0[i].x & 0xffffu)); s[i].y += bf2f((u16)(a0[i].x >> 16));
            s[i].z += bf2f((u16)(a0[i].y & 0xffffu)); s[i].w += bf2f((u16)(a0[i].y >> 16));
            s[i].x += w1 * bf2f((u16)(a1[i].x & 0xffffu)); s[i].y += w1 * bf2f((u16)(a1[i].x >> 16));
            s[i].z += w1 * bf2f((u16)(a1[i].y & 0xffffu)); s[i].w += w1 * bf2f((u16)(a1[i].y >> 16));
          }
        }
#pragma unroll
        for (int i = 0; i < 4; ++i) {
          const int col = i * 256 + lane * 4;
          const float4 g4 = *(const float4*)(g2 + col);
          v[r][i].x += g4.x * s[i].x; v[r][i].y += g4.y * s[i].y; v[r][i].z += g4.z * s[i].z; v[r][i].w += g4.w * s[i].w;
          *(float4*)(orow + (size_t)r * DM + col) = v[r][i];
        }
      }
    }
    if (MOD) {
      const float* sh = p.mada + (size_t)(lnext * 3 + cond) * 6144;
      const float* sc = sh + 1024;
      float rstd[R];
#pragma unroll
      for (int r = 0; r < R; ++r) {
        float ss = 0.f;
#pragma unroll
        for (int i = 0; i < 4; ++i) ss += v[r][i].x * v[r][i].x + v[r][i].y * v[r][i].y + v[r][i].z * v[r][i].z + v[r][i].w * v[r][i].w;
        rstd[r] = rsqrtf(wave_sum(ss) * (1.f / 1024.f) + 1e-6f);
      }
#pragma unroll
      for (int i = 0; i < 4; ++i) {
        const int col = i * 256 + lane * 4;
        const float4 s4 = *(const float4*)(sc + col);
        const float4 h4 = *(const float4*)(sh + col);
#pragma unroll
        for (int r = 0; r < R; ++r) {
          u32x2 pk;
          pk.x = pack2(v[r][i].x * rstd[r] * (1.f + s4.x) + h4.x, v[r][i].y * rstd[r] * (1.f + s4.y) + h4.y);
          pk.y = pack2(v[r][i].z * rstd[r] * (1.f + s4.z) + h4.z, v[r][i].w * rstd[r] * (1.f + s4.w) + h4.w);
          *(u32x2*)(p.H + (size_t)(row0 + r) * DM + col) = pk;
        }
      }
    }
  }
}

__global__ void __launch_bounds__(256, 2) fwd_megakernel(Params p_unused) {
  const Params& p = *(const Params*)__builtin_amdgcn_kernarg_segment_ptr();
  __shared__ __attribute__((aligned(16))) unsigned char smem[SMEM_BYTES];
  __shared__ uint4 xb_words;
  cg::grid_group grid = cg::this_grid();
  if (threadIdx.x == 0) xb_words = make_uint4(0u, 0u, 0u, 0u);
  __syncthreads();
  XcdBarrier xb = xcd_barrier_post(p.bar, (volatile LAS unsigned*)&xb_words);

#define LP (*launder_(&p))
  phase_prep(LP, smem);
  if (xb_ld(&p.bar[XB_TMO]) == 0xFFFFFFFFu) grid.sync();
  if (threadIdx.x == 0) {
    XB_SPIN(xb_ld(&p.bar[64]) < 192u, p.bar);
    __builtin_amdgcn_fence(__ATOMIC_ACQUIRE, "agent");
    asm volatile("s_waitcnt vmcnt(0)" ::: "memory");
  }
  __syncthreads();

  for (int l = 0; l < 2; ++l) {
    const bool last = (l == 1);
    if (!last) { phase_router_prep(LP); phase_combine_modulate<false, true>(LP, 0, 0, p.x, p.ctx, nullptr, nullptr, TT); }
    else phase_combine_modulate<true, true>(LP, 0, 1, p.out, p.XC, p.out, p.XC, TT);
    xcd_barrier(xb);
    phase_in_gemm(LP, l, smem);
    xcd_barrier(xb);
    phase_mix_a(LP, l, last, smem);
    xcd_barrier(xb);
    phase_mix_b(LP, l, last, smem);
    xcd_barrier(xb);
    phase_attn(LP, last, smem);
    xcd_barrier(xb);
    phase_out_gemm(LP, l, last, last ? p.out : p.x, last ? p.XC : p.ctx, p.out, p.XC, smem);
    xcd_barrier(xb);
    phase_router(LP, l, p.out, p.XC, last ? T_LAT : TT);
    xcd_barrier(xb);
    phase_topk(LP, last, smem);
    phase_modulate<4>(LP, l, p.out, p.XC, last ? T_LAT : TT, 3, last ? 32 : 64);
    xcd_barrier(xb);
    phase_moe_up(LP, l, last, smem);
    xcd_barrier(xb);
    phase_moe_down(LP, l, last, smem);
    xcd_barrier(xb);
  }
  phase_combine_modulate<true, false>(LP, 1, 1, p.out, p.XC, p.out, p.XC, T_LAT);
#undef LP
}

extern "C" void kernel_launch(void* const* d_in, const int* in_sizes, int n_in, void* d_out, int out_size, void* d_ws,
                              size_t ws_size, hipStream_t stream) {
  static int grid_blocks = 0;
  if (!grid_blocks) {
    int dev = 0, cus = 0, per_cu = 0;
    hipGetDevice(&dev);
    hipDeviceGetAttribute(&cus, hipDeviceAttributeMultiprocessorCount, dev);
    hipOccupancyMaxActiveBlocksPerMultiprocessor(&per_cu, fwd_megakernel, 256, 0);
    if (per_cu > 2) per_cu = 2;
    if (per_cu < 1) per_cu = 1;
    grid_blocks = (cus * per_cu) & ~7;
    if (grid_blocks < 8) grid_blocks = 8;
  }
  Params p{};
  const float* const* in = (const float* const*)d_in;
  p.x = in[0]; p.c = in[1]; p.ctx = in[2]; p.c_ctx = in[3]; p.w_ada = in[4]; p.b_ada = in[5]; p.w_in = in[6];
  p.sgu_norm = in[7]; p.w_sgu = in[8]; p.b_sgu = in[9]; p.q_lora_norm = in[10]; p.w_uq = in[11]; p.kv_lora_norm = in[12];
  p.w_ukv = in[13]; p.q_norm = in[14]; p.k_norm = in[15]; p.w_out = in[16]; p.w_router = in[17]; p.w_gate = in[18];
  p.w_up = in[19]; p.w_down = in[20];
  p.out = (float*)d_out;
  unsigned char* base = (unsigned char*)d_ws;
  size_t off = 0;
  auto alloc = [&](size_t bytes) { void* r = base + off; off += (bytes + 255) & ~(size_t)255; return r; };
  p.bar = (unsigned*)alloc(16384);
  p.mada = (float*)alloc((size_t)2 * 3 * 6144 * 4);
  p.WinT = (u16*)alloc((size_t)2 * 1536 * 1024 * 2);
  p.WuqT = (u16*)alloc((size_t)2 * 768 * 256 * 2);
  p.WukvT = (u16*)alloc((size_t)2 * 1024 * 128 * 2);
  p.WoutT = (u16*)alloc((size_t)2 * 1024 * 1024 * 2);
  p.WguT = (u16*)alloc((size_t)2 * 16 * 1024 * 1024 * 2);
  p.WdT = (u16*)alloc((size_t)2 * 16 * 1024 * 512 * 2);
  p.Wsgu = (u16*)alloc((size_t)2 * 4 * 128 * 128 * 2);
  p.M1 = (u16*)alloc((size_t)128 * 128 * 128 * 2);
  p.M2 = (u16*)alloc((size_t)128 * 256 * 2);
  p.Mc = (u16*)alloc((size_t)256 * 512 * 2);
  p.XC = (float*)alloc((size_t)T_CTX * DM * 4);
  p.AFFT = (float*)alloc((size_t)(32 * SEQ + 32 * CTX) * 4);
  p.GATE = (float*)alloc((size_t)64 * 1024 * 4);
  p.IDXG = (int*)alloc((size_t)64 * 1024 * 4);
  p.INV = (int*)alloc((size_t)TT * 16 * 4);
  p.WR2 = (float*)alloc((size_t)2 * 3 * 16384 * 4);
  p.CE = (float*)alloc((size_t)96 * 4);
  p.GDc = (u16*)alloc((size_t)2 * 2 * CTX * 256 * 2);
  unsigned char* RH = (unsigned char*)alloc((size_t)TT * 1024 * 2);
  p.H = (u16*)RH;
  p.PF = (u16*)RH;
  p.KN = (u16*)(RH + (size_t)2 * 64 * 2 * 128 * 256 * 2);
  p.PX = (u16*)alloc((size_t)TT * 1024 * 2);
  p.YM = (u16*)alloc((size_t)TT * 1024 * 2);
  unsigned char* RA = (unsigned char*)alloc((size_t)2 * 4 * NPOS * 192 * 2);
  unsigned char* RB = (unsigned char*)alloc((size_t)2 * 4 * NPOS * 192 * 2);
  p.GD = (u16*)RA;
  p.Qall = (u16*)RA;
  p.Kb = (u16*)RB;
  p.QR = (u16*)alloc((size_t)TT * 768 * 2);
  p.HID = p.QR;
  p.YB = p.PX;
  p.Vt = (u16*)alloc((size_t)2 * 4 * 128 * NPOS * 2);
  if (off > ws_size) fprintf(stderr, "workspace too small: need %zu have %zu\n", off, ws_size);

  hipMemsetAsync(p.bar, 0, 16384, stream);
  void* args[] = {&p};
  hipError_t e = hipLaunchCooperativeKernel((void*)fwd_megakernel, dim3(grid_blocks), dim3(256), args, 0, stream);
  if (e != hipSuccess) fprintf(stderr, "cooperative launch failed: %s (grid %d)\n", hipGetErrorString(e), grid_blocks);
}
```

```cpp
#include <hip/hip_runtime.h>
#include <hip/hip_cooperative_groups.h>
#include <stdint.h>
#include <stdio.h>
namespace cg = cooperative_groups;

typedef unsigned short u16;
typedef __attribute__((ext_vector_type(8))) short bf16x8;
typedef __attribute__((ext_vector_type(4))) float f32x4;
typedef unsigned __attribute__((ext_vector_type(4))) u32x4;
typedef unsigned __attribute__((ext_vector_type(2))) u32x2;

constexpr int DM = 1024;
constexpr int SEQ = 8192, CTX = 256;
constexpr int T_LAT = 2 * SEQ, T_CTX = 2 * CTX, TT = T_LAT + T_CTX;
constexpr int NPOS = SEQ + CTX;
constexpr int SMEM_BYTES = 71680;

struct Params {
  const float *x, *c, *ctx, *c_ctx, *w_ada, *b_ada, *w_in, *sgu_norm, *w_sgu, *b_sgu, *q_lora_norm, *w_uq,
      *kv_lora_norm, *w_ukv, *q_norm, *k_norm, *w_out, *w_router, *w_gate, *w_up, *w_down;
  float* out;
  unsigned* bar;
  float* mada;
  u16 *WinT, *WuqT, *WukvT, *WoutT, *WguT, *WdT, *Wsgu, *M1, *M2, *Mc;
  float* XC;
  u16 *H, *PX, *YM, *GD, *GDc, *PF, *QR, *KN, *Vt, *Qall, *Kb, *HID;
  float *AFFT, *GATE, *WR2, *CE;
  int *IDXG, *INV;
  u16* YB;
};

typedef float f32x2_t __attribute__((ext_vector_type(2)));
typedef __bf16 bf16x2_t __attribute__((ext_vector_type(2)));
__device__ __forceinline__ unsigned pack2(float a, float b) {
  f32x2_t v = {a, b};
  bf16x2_t r = __builtin_convertvector(v, bf16x2_t);
  return __builtin_bit_cast(unsigned, r);
}
__device__ __forceinline__ u16 f2bf(float f) { return (u16)(pack2(f, 0.f) & 0xffffu); }
__device__ __forceinline__ float bf2f(u16 b) { return __uint_as_float(((unsigned)b) << 16); }
__device__ __forceinline__ float wave_sum(float v) {
#pragma unroll
  for (int o = 32; o; o >>= 1) v += __shfl_xor(v, o);
  return v;
}
__device__ __forceinline__ int tid_() { int t = threadIdx.x; asm volatile("" : "+v"(t)); return t; }
__device__ __forceinline__ const struct Params* launder_(const struct Params* q) { asm volatile("" : "+s"(q)); return q; }
__device__ __forceinline__ int bid_() { int b = blockIdx.x; asm volatile("" : "+s"(b)); return b; }
__device__ __forceinline__ float gelu_tanh(float x) {
  float y = 0.7978845608028654f * (x + 0.044715f * x * x * x);
  return x / (1.f + __expf(-2.f * y));
}
__device__ __forceinline__ float silu_f(float x) { return x / (1.f + __expf(-x)); }

#define XB_TMO 128
#define XB_XCNT(j) (256 + 64 * (j))
#define XB_XSUB(j) (1280 + 64 * (j))
#define XB_XGEN(j) (2304 + 64 * (j))
#define XB_TOP 3328
#define XB_TOPGEN 3392
#define XCD_BAR_WORDS 3456
#define XB_SPIN_CAP (1u << 22)
#define LAS __attribute__((address_space(3)))

__device__ __forceinline__ unsigned xb_ld(unsigned* p) { return __hip_atomic_load(p, __ATOMIC_RELAXED, __HIP_MEMORY_SCOPE_AGENT); }
__device__ __forceinline__ unsigned xb_add(unsigned* p, unsigned v) { return __hip_atomic_fetch_add(p, v, __ATOMIC_RELAXED, __HIP_MEMORY_SCOPE_AGENT); }
__device__ __forceinline__ unsigned xb_xcc_id() { return (unsigned)__builtin_amdgcn_s_getreg((3 << 11) | 20) & 0xFu; }
#define XB_SPIN(cond, bar)                                            \
  do {                                                                \
    unsigned _sp = 0;                                                 \
    while (cond) {                                                    \
      __builtin_amdgcn_s_sleep(1);                                    \
      if ((++_sp & 255u) == 0u) {                                     \
        if (xb_ld(&(bar)[XB_TMO])) break;                             \
        if (_sp > XB_SPIN_CAP) { atomicAdd(&(bar)[XB_TMO], 1u); break; } \
      }                                                               \
    }                                                                 \
  } while (0)

struct XcdBarrier {
  unsigned* bar;
  unsigned x;
  volatile LAS unsigned* st;
};
__device__ __forceinline__ XcdBarrier xcd_barrier_post(unsigned* bar, volatile LAS unsigned* st) {
  XcdBarrier b;
  b.bar = bar;
  b.x = xb_xcc_id();
  b.st = st;
  if (threadIdx.x == 0) (void)xb_add(&bar[XB_XCNT(b.x)], 1u);
  return b;
}
__device__ __forceinline__ void xcd_barrier_complete(unsigned* bar, unsigned x, unsigned& nloc, unsigned& nx) {
  const unsigned G = gridDim.x * gridDim.y * gridDim.z;
  unsigned sum, cnt, mine, sp = 0u;
  for (;;) {
    sum = 0u; cnt = 0u; mine = 0u;
#pragma unroll
    for (unsigned j = 0; j < 16; ++j) {
      const unsigned c = xb_ld(&bar[XB_XCNT(j)]);
      sum += c; cnt += (c > 0u) ? 1u : 0u; mine = (j == x) ? c : mine;
    }
    if (sum == G) break;
    __builtin_amdgcn_s_sleep(1);
    if ((++sp & 255u) == 0u) {
      if (xb_ld(&bar[XB_TMO])) break;
      if (sp > XB_SPIN_CAP) { atomicAdd(&bar[XB_TMO], 1u); break; }
    }
  }
  nloc = mine > 0u ? mine : 1u;
  nx = cnt > 0u ? cnt : 1u;
}
__device__ __forceinline__ void xcd_barrier(const XcdBarrier& b) {
  asm volatile("s_waitcnt vmcnt(0)" ::: "memory");
  __syncthreads();
  if (threadIdx.x == 0) {
    unsigned* bar = b.bar;
    __builtin_amdgcn_s_waitcnt(0);
    unsigned nloc = b.st[0], nx = b.st[1];
    if (nloc == 0u) { xcd_barrier_complete(bar, b.x, nloc, nx); b.st[0] = nloc; b.st[1] = nx; }
    const unsigned old = xb_add(&bar[XB_XSUB(b.x)], 1u);
    const unsigned gen = old / nloc;
    if (old + 1u == (gen + 1u) * nloc) {
      __builtin_amdgcn_fence(__ATOMIC_RELEASE, "agent");
      asm volatile("s_waitcnt vmcnt(0)" ::: "memory");
      const unsigned og = xb_add(&bar[XB_TOP], 1u);
      const unsigned tg = og / nx;
      if (og + 1u == (tg + 1u) * nx) xb_add(&bar[XB_TOPGEN], 1u);
      else XB_SPIN(xb_ld(&bar[XB_TOPGEN]) == tg, bar);
      __builtin_amdgcn_fence(__ATOMIC_ACQUIRE, "agent");
      xb_add(&bar[XB_XGEN(b.x)], 1u);
      asm volatile("s_waitcnt vmcnt(0)" ::: "memory");
    } else {
      XB_SPIN(xb_ld(&bar[XB_XGEN(b.x)]) == gen, bar);
      __builtin_amdgcn_fence(__ATOMIC_ACQUIRE, "agent");
      asm volatile("s_waitcnt vmcnt(0)" ::: "memory");
    }
  }
  __syncthreads();
}

#define XCD_FOR(u, T)                                                                                         \
  for (int _x = bid_() & 7, _gb = gridDim.x >> 3, _hi = (int)(((long)(_x + 1) * (T)) >> 3),                    \
           u = (int)(((long)_x * (T)) >> 3) + (bid_() >> 3);                                                  \
       u < _hi; u += _gb)

template <int NT, bool BKN, bool MASK = false, bool ROWSS = false, class Epi>
__device__ __forceinline__ void gemm_tile(const u16* __restrict__ A, int lda, const int* __restrict__ arows, int mvalid,
                                          const u16* __restrict__ B, int ldb, int K, unsigned char* smem, Epi epi,
                                          const float* ascale = nullptr) {
  constexpr int BN = NT * 32;
  constexpr int CPR = BN / 8;
  u16* S0 = (u16*)smem;
  const int t = tid_(), lane = t & 63, wid = t >> 6, wr = wid >> 1, wc = wid & 1, l16 = lane & 15, quad = lane >> 4;
  const u16* ap[4];
  const u16* bp[NT];
  unsigned amask = 0u;
#pragma unroll
  for (int i = 0; i < 4; ++i) {
    const int row = (t >> 3) + 32 * i;
    const bool v = MASK ? (row < mvalid) : true;
    amask |= v ? (1u << i) : 0u;
    int r = v ? row : 0;
    if (arows) r = arows[r];
    ap[i] = A + (size_t)r * lda + (t & 7) * 8;
  }
#pragma unroll
  for (int i = 0; i < NT; ++i) {
    if (!BKN) bp[i] = B + (size_t)((t >> 3) + 32 * i) * ldb + (t & 7) * 8;
    else { const int c = t + 256 * i; bp[i] = B + (size_t)(c / CPR) * ldb + (c % CPR) * 8; }
  }
  const size_t bstep = BKN ? (size_t)64 * ldb : (size_t)64;
  int nmi = 4;
  if (MASK) { nmi = (mvalid - wr * 64 + 15) >> 4; nmi = nmi < 0 ? 0 : (nmi > 4 ? 4 : nmi); nmi = __builtin_amdgcn_readfirstlane(nmi); }
  u32x4 ra0[4], rb0[NT], ra1[4], rb1[NT];
#define GEMM_LOAD(RA, RB, kt_)                                                                      \
  {                                                                                                 \
    _Pragma("unroll") for (int i = 0; i < 4; ++i) {                                                 \
      RA[i] = *(const u32x4*)(ap[i] + (size_t)(kt_) * 64);                                          \
      if (MASK && !((amask >> i) & 1u)) RA[i] = (u32x4){0u, 0u, 0u, 0u};                            \
    }                                                                                               \
    _Pragma("unroll") for (int i = 0; i < NT; ++i) RB[i] = *(const u32x4*)(bp[i] + (size_t)(kt_) * bstep); \
  }
#define GEMM_STORE(RA, RB, st_)                                                                     \
  {                                                                                                 \
    u16* As_ = S0 + (st_) * 16384;                                                                  \
    u16* Bs_ = As_ + 8192;                                                                          \
    if (ROWSS) {                                                                                    \
      _Pragma("unroll") for (int i = 0; i < 4; ++i) {                                               \
        const u32x4 w_ = RA[i];                                                                     \
        const float a0 = __uint_as_float(w_.x << 16), a1 = __uint_as_float(w_.x & 0xffff0000u);     \
        const float a2 = __uint_as_float(w_.y << 16), a3 = __uint_as_float(w_.y & 0xffff0000u);     \
        const float a4 = __uint_as_float(w_.z << 16), a5 = __uint_as_float(w_.z & 0xffff0000u);     \
        const float a6 = __uint_as_float(w_.w << 16), a7 = __uint_as_float(w_.w & 0xffff0000u);     \
        ss_[i] += (a0 * a0 + a1 * a1) + (a2 * a2 + a3 * a3) + (a4 * a4 + a5 * a5) + (a6 * a6 + a7 * a7); \
      }                                                                                             \
    }                                                                                               \
    if (ascale) {                                                                                   \
      const float* sc_ = ascale + stk_ * 64 + (t & 7) * 8;                                          \
      const float4 s0_ = *(const float4*)(sc_), s1_ = *(const float4*)(sc_ + 4);                    \
      _Pragma("unroll") for (int i = 0; i < 4; ++i) {                                               \
        u32x4 w_ = RA[i];                                                                           \
        w_.x = pack2(__uint_as_float(w_.x << 16) * s0_.x, __uint_as_float(w_.x & 0xffff0000u) * s0_.y); \
        w_.y = pack2(__uint_as_float(w_.y << 16) * s0_.z, __uint_as_float(w_.y & 0xffff0000u) * s0_.w); \
        w_.z = pack2(__uint_as_float(w_.z << 16) * s1_.x, __uint_as_float(w_.z & 0xffff0000u) * s1_.y); \
        w_.w = pack2(__uint_as_float(w_.w << 16) * s1_.z, __uint_as_float(w_.w & 0xffff0000u) * s1_.w); \
        RA[i] = w_;                                                                                 \
      }                                                                                             \
    }                                                                                               \
    ++stk_;                                                                                         \
    _Pragma("unroll") for (int i = 0; i < 4; ++i) {                                                 \
      const int row = (t >> 3) + 32 * i;                                                            \
      *(u32x4*)(As_ + row * 64 + (((t & 7) ^ ((row >> 1) & 7)) << 3)) = RA[i];                      \
    }                                                                                               \
    if (!BKN) {                                                                                     \
      _Pragma("unroll") for (int i = 0; i < NT; ++i) {                                              \
        const int row = (t >> 3) + 32 * i;                                                          \
        *(u32x4*)(Bs_ + row * 64 + (((t & 7) ^ ((row >> 1) & 7)) << 3)) = RB[i];                    \
      }                                                                                             \
    } else {                                                                                        \
      _Pragma("unroll") for (int i = 0; i < NT; ++i) {                                              \
        const int c = t + 256 * i;                                                                  \
        const int k = c / CPR, n8 = (c % CPR) * 8;                                                  \
        const u32x4 w = RB[i];                                                                      \
        const unsigned e[8] = {w.x & 0xffffu, w.x >> 16, w.y & 0xffffu, w.y >> 16, w.z & 0xffffu, w.z >> 16, w.w & 0xffffu, w.w >> 16}; \
        _Pragma("unroll") for (int j = 0; j < 8; ++j) {                                             \
          const int n = n8 + j;                                                                     \
          Bs_[n * 64 + ((((k >> 3) ^ ((n >> 1) & 7))) << 3) + (k & 7)] = (u16)e[j];                 \
        }                                                                                           \
      }                                                                                             \
    }                                                                                               \
  }
#define GEMM_COMPUTE(st_)                                                                           \
  {                                                                                                 \
    const u16* As_ = S0 + (st_) * 16384;                                                            \
    const u16* Bs_ = As_ + 8192;                                                                    \
    _Pragma("unroll") for (int ks = 0; ks < 2; ++ks) {                                              \
      bf16x8 af[4], bfr[NT];                                                                        \
      _Pragma("unroll") for (int mi = 0; mi < 4; ++mi) {                                            \
        const int row = wr * 64 + mi * 16 + l16;                                                    \
        af[mi] = *(const bf16x8*)(As_ + row * 64 + (((ks * 4 + quad) ^ ((row >> 1) & 7)) << 3));    \
      }                                                                                             \
      _Pragma("unroll") for (int ni = 0; ni < NT; ++ni) {                                           \
        const int row = wc * (BN / 2) + ni * 16 + l16;                                              \
        bfr[ni] = *(const bf16x8*)(Bs_ + row * 64 + (((ks * 4 + quad) ^ ((row >> 1) & 7)) << 3));   \
      }                                                                                             \
      _Pragma("unroll") for (int mi = 0; mi < 4; ++mi)                                              \
        if (!MASK || mi < nmi)                                                                      \
        _Pragma("unroll") for (int ni = 0; ni < NT; ++ni) acc[mi][ni] = __builtin_amdgcn_mfma_f32_16x16x32_bf16(af[mi], bfr[ni], acc[mi][ni], 0, 0, 0); \
    }                                                                                               \
  }
  float ss_[4] = {0.f, 0.f, 0.f, 0.f};
  int stk_ = 0;
  f32x4 acc[4][NT];
#pragma unroll
  for (int i = 0; i < 4; ++i)
#pragma unroll
    for (int j = 0; j < NT; ++j) acc[i][j] = (f32x4){0.f, 0.f, 0.f, 0.f};
  const int nk = K >> 6;
  const int nkm1 = nk - 1;
  __syncthreads();
  GEMM_LOAD(ra0, rb0, 0);
  GEMM_LOAD(ra1, rb1, 1);
  GEMM_STORE(ra0, rb0, 0);
  GEMM_LOAD(ra0, rb0, (2 < nkm1 ? 2 : nkm1));
  __syncthreads();
  for (int kt = 0; kt < nk - 2; kt += 2) {
    GEMM_COMPUTE(0);
    GEMM_STORE(ra1, rb1, 1);
    GEMM_LOAD(ra1, rb1, kt + 3);
    __syncthreads();
    GEMM_COMPUTE(1);
    GEMM_STORE(ra0, rb0, 0);
    GEMM_LOAD(ra0, rb0, (kt + 4 < nkm1 ? kt + 4 : nkm1));
    __syncthreads();
  }
  GEMM_COMPUTE(0);
  GEMM_STORE(ra1, rb1, 1);
  __syncthreads();
  GEMM_COMPUTE(1);
#undef GEMM_LOAD
#undef GEMM_STORE
#undef GEMM_COMPUTE
  if (ROWSS) {
    float* rs = (float*)(smem + 65536);
#pragma unroll
    for (int i = 0; i < 4; ++i) {
      float s = ss_[i];
      s += __shfl_xor(s, 1); s += __shfl_xor(s, 2); s += __shfl_xor(s, 4);
      if ((t & 7) == 0) rs[(t >> 3) + 32 * i] = rsqrtf(s / (float)K + 1e-6f);
    }
    __syncthreads();
  }
  epi(acc, wr * 64 + quad * 4, wc * (BN / 2) + l16);
}

template <int NT, class VF, class RP>
__device__ __forceinline__ void epi_staged_bf16(f32x4 (&acc)[4][NT], int r0, int c0, unsigned char* smem, VF vf, RP rowptr) {
  constexpr int BN = NT * 32, PITCH = BN + 8, CPR = BN / 8;
  u16* Ts = (u16*)smem;
  const int t = tid_();
  __syncthreads();
#pragma unroll
  for (int mi = 0; mi < 4; ++mi)
#pragma unroll
    for (int ni = 0; ni < NT; ++ni)
#pragma unroll
      for (int j = 0; j < 4; ++j) {
        const int r = r0 + mi * 16 + j, c = c0 + ni * 16;
        Ts[r * PITCH + c] = f2bf(vf(r, c, acc[mi][ni][j]));
      }
  __syncthreads();
#pragma unroll
  for (int i = 0; i < CPR / 2; ++i) {
    const int c = t + 256 * i, row = c / CPR, ch = c % CPR;
    u16* d = rowptr(row);
    if (d) *(u32x4*)(d + ch * 8) = *(const u32x4*)(Ts + row * PITCH + ch * 8);
  }
}

template <class RP>
__device__ __forceinline__ void epi_staged_bf16_T(f32x4 (&acc)[4][4], int r0, int c0, unsigned char* smem, RP colptr) {
  constexpr int PITCH = 136;
  u16* Ts = (u16*)smem;
  const int t = tid_();
  __syncthreads();
#pragma unroll
  for (int mi = 0; mi < 4; ++mi)
#pragma unroll
    for (int ni = 0; ni < 4; ++ni) {
      u32x2 pk;
      pk.x = pack2(acc[mi][ni][0], acc[mi][ni][1]);
      pk.y = pack2(acc[mi][ni][2], acc[mi][ni][3]);
      *(u32x2*)(Ts + (c0 + ni * 16) * PITCH + r0 + mi * 16) = pk;
    }
  __syncthreads();
#pragma unroll
  for (int i = 0; i < 8; ++i) {
    const int c = t + 256 * i, col = c >> 4, ch = c & 15;
    *(u32x4*)(colptr(col) + ch * 8) = *(const u32x4*)(Ts + col * PITCH + ch * 8);
  }
}

__device__ __forceinline__ void epi_staged_residual(f32x4 (&acc)[4][4], int r0, int c0, unsigned char* smem, const float* __restrict__ g,
                                                    const float* __restrict__ xs, float* __restrict__ xd) {
  constexpr int PITCH = 132;
  float* Ts = (float*)smem;
  const int t = tid_();
  const int wr = r0 >> 6;
#pragma unroll
  for (int pass = 0; pass < 2; ++pass) {
    __syncthreads();
    if (wr == pass) {
#pragma unroll
      for (int mi = 0; mi < 4; ++mi)
#pragma unroll
        for (int ni = 0; ni < 4; ++ni)
#pragma unroll
          for (int j = 0; j < 4; ++j) Ts[((r0 & 63) + mi * 16 + j) * PITCH + c0 + ni * 16] = acc[mi][ni][j];
    }
    __syncthreads();
#pragma unroll
    for (int i = 0; i < 8; ++i) {
      const int c = t + 256 * i, row = c >> 5, ch = c & 31;
      const float4 a = *(const float4*)(Ts + row * PITCH + ch * 4);
      const float4 gg = *(const float4*)(g + ch * 4);
      const size_t o = (size_t)(pass * 64 + row) * DM + ch * 4;
      float4 x = *(const float4*)(xs + o);
      x.x += gg.x * a.x; x.y += gg.y * a.y; x.z += gg.z * a.z; x.w += gg.w * a.w;
      *(float4*)(xd + o) = x;
    }
  }
}

__device__ __forceinline__ void ada_item(const Params& p, int it, unsigned char* smem) {
  float* sc = (float*)smem;
  float* red = sc + 3072;
  const int t = tid_(), lane = t & 63, wid = t >> 6;
  const int l = it / 96, jc = it % 96;
#pragma unroll
  for (int i = 0; i < 12; ++i) {
    const int idx = t + 256 * i, r = idx >> 10, k = idx & 1023;
    const float cv = r < 2 ? p.c[r * 1024 + k] : p.c_ctx[k];
    sc[idx] = silu_f(cv);
  }
  __syncthreads();
  const float* w = p.w_ada + (size_t)l * 1024 * 6144 + jc * 64 + lane;
  float a0 = 0.f, a1 = 0.f, a2 = 0.f;
  const int kb = wid * 256;
#pragma unroll 8
  for (int k = 0; k < 256; ++k) {
    const float wv = w[(size_t)(kb + k) * 6144];
    a0 += sc[kb + k] * wv;
    a1 += sc[1024 + kb + k] * wv;
    a2 += sc[2048 + kb + k] * wv;
  }
  red[(wid * 3 + 0) * 64 + lane] = a0;
  red[(wid * 3 + 1) * 64 + lane] = a1;
  red[(wid * 3 + 2) * 64 + lane] = a2;
  __syncthreads();
  if (t < 192) {
    const int r = t >> 6, ln = t & 63;
    float s = 0.f;
#pragma unroll
    for (int w4 = 0; w4 < 4; ++w4) s += red[(w4 * 3 + r) * 64 + ln];
    s += p.b_ada[l * 6144 + jc * 64 + ln];
    p.mada[(l * 3 + r) * 6144 + jc * 64 + ln] = s;
  }
  asm volatile("s_waitcnt vmcnt(0)" ::: "memory");
  __syncthreads();
  if (t == 0) {
    __builtin_amdgcn_fence(__ATOMIC_RELEASE, "agent");
    asm volatile("s_waitcnt vmcnt(0)" ::: "memory");
    (void)xb_add(&p.bar[64], 1u);
  }
}

__device__ __forceinline__ void fold_item(const Params& p, int it, unsigned char* smem) {
  float* tile = (float*)smem;
  float* ct = tile + 64 * 65;
  const int t = tid_();
  const int l = it >> 6, rem = it & 63, g = rem >> 4, k0 = (rem & 15) * 64;
#pragma unroll
  for (int i = 0; i < 16; ++i) {
    const int kk = i * 4 + (t >> 6), d = t & 63;
    tile[kk * 65 + d] = p.w_in[(size_t)(l * 1024 + k0 + kk) * 1216 + 512 + g * 64 + d];
  }
  if (t < 64) ct[t] = cospif((float)t / 32.f);
  __syncthreads();
  const int k = t & 63, jg = t >> 6;
  u16* dst = p.WinT + (size_t)l * 1536 * 1024;
  for (int jj = 0; jj < 16; ++jj) {
    const int j = jg + 4 * jj;
    float sr = 0.f, si = 0.f;
#pragma unroll 8
    for (int d = 0; d < 64; ++d) {
      const float v = tile[k * 65 + d];
      const int m = (j * d) & 63;
      sr += v * ct[m];
      si += v * ct[(m - 16) & 63];
    }
    dst[(size_t)(512 + g * 64 + j) * 1024 + k0 + k] = f2bf(sr);
    dst[(size_t)(768 + g * 64 + j) * 1024 + k0 + k] = f2bf(-si);
  }
  __syncthreads();
}

__device__ __forceinline__ void convT_tile(const float* __restrict__ src, int lds, int k0, int c0, u16* __restrict__ dst, int Kd,
                                           int rbase, int mode, int which, unsigned char* smem, const float* __restrict__ kscale = nullptr) {
  float* tile = (float*)smem;
  const int t = tid_();
  float4 v4[4];
#pragma unroll
  for (int i = 0; i < 4; ++i) v4[i] = *(const float4*)(src + (size_t)(k0 + i * 16 + (t >> 4)) * lds + c0 + (t & 15) * 4);
#pragma unroll
  for (int i = 0; i < 4; ++i) {
    const int kk = i * 16 + (t >> 4), cc = (t & 15) * 4;
    const float sc = kscale ? kscale[k0 + kk] : 1.f;
    tile[kk * 65 + cc + 0] = v4[i].x * sc; tile[kk * 65 + cc + 1] = v4[i].y * sc;
    tile[kk * 65 + cc + 2] = v4[i].z * sc; tile[kk * 65 + cc + 3] = v4[i].w * sc;
  }
  __syncthreads();
#pragma unroll
  for (int i = 0; i < 16; ++i) {
    const int cc = i * 4 + (t >> 6), kk = t & 63;
    int row;
    if (mode == 0) row = rbase + cc;
    else { const int f = c0 + cc; row = (((f >> 4) * 2 + which) << 4) + (f & 15); }
    dst[(size_t)row * Kd + k0 + kk] = f2bf(tile[kk * 65 + cc]);
  }
  __syncthreads();
}

__device__ __forceinline__ void conv_item(const Params& p, int it, unsigned char* smem) {
  const int l = it / 6720;
  int r = it % 6720;
  if (r < 240) {
    const int ct = r >> 4, kt = r & 15;
    const int c0 = (ct < 8 ? ct : ct + 4) * 64;
    const int n0 = c0 + (c0 >= 768 ? 256 : 0);
    convT_tile(p.w_in + (size_t)l * 1024 * 1216, 1216, kt * 64, c0, p.WinT + (size_t)l * 1536 * 1024, 1024, n0, 0, 0, smem);
    return;
  }
  r -= 240;
  if (r < 48) {
    const int ct = r >> 2, kt = r & 3;
    convT_tile(p.w_uq + (size_t)l * 256 * 768, 768, kt * 64, ct * 64, p.WuqT + (size_t)l * 768 * 256, 256, ct * 64, 0, 0, smem, p.q_lora_norm + l * 256);
    return;
  }
  r -= 48;
  if (r < 32) {
    const int ct = r >> 1, kt = r & 1;
    convT_tile(p.w_ukv + (size_t)l * 128 * 1024, 1024, kt * 64, ct * 64, p.WukvT + (size_t)l * 1024 * 128, 128, ct * 64, 0, 0, smem, p.kv_lora_norm + l * 128);
    return;
  }
  r -= 32;
  if (r < 256) {
    const int ct = r >> 4, kt = r & 15;
    convT_tile(p.w_out + (size_t)l * 1024 * 1024, 1024, kt * 64, ct * 64, p.WoutT + (size_t)l * 1024 * 1024, 1024, ct * 64, 0, 0, smem);
    return;
  }
  r -= 256;
  if (r < 4096) {
    const int which = r >> 11, r2 = r & 2047, e = r2 >> 7, r3 = r2 & 127, ct = r3 >> 4, kt = r3 & 15;
    const float* src = (which ? p.w_up : p.w_gate) + (size_t)(l * 16 + e) * 1024 * 512;
    convT_tile(src, 512, kt * 64, ct * 64, p.WguT + (size_t)(l * 16 + e) * 1024 * 1024, 1024, 0, 1, which, smem);
    return;
  }
  r -= 4096;
  {
    const int e = r >> 7, r3 = r & 127, ct = r3 >> 3, kt = r3 & 7;
    convT_tile(p.w_down + (size_t)(l * 16 + e) * 512 * 1024, 1024, kt * 64, ct * 64, p.WdT + (size_t)(l * 16 + e) * 1024 * 512, 512, ct * 64, 0, 0, smem);
  }
}

__device__ __forceinline__ void elem_item(const Params& p, int it) {
  const int t = tid_();
  if (it < 128) {
#pragma unroll
    for (int i = 0; i < 4; ++i) { const int idx = it * 1024 + i * 256 + t; p.Wsgu[idx] = f2bf(p.w_sgu[idx]); }
    return;
  }
  it -= 128;
  if (it < 2048) {
#pragma unroll
    for (int i = 0; i < 4; ++i) {
      const int idx = it * 1024 + i * 256 + t;
      const int n1 = idx >> 14, m = (idx >> 7) & 127, kk = idx & 127;
      const int rip = m >> 6, k2 = m & 63, ri = kk >> 6, n2 = kk & 63;
      const int n = n1 + 128 * n2;
      const int ph = (k2 * n) & 8191;
      const float xx = (float)ph / 4096.f;
      const float cs = cospif(xx), sn = sinpif(xx);
      const float v = rip == 0 ? (ri == 0 ? cs : sn) : (ri == 0 ? -sn : cs);
      p.M1[idx] = f2bf(v);
    }
    return;
  }
  it -= 2048;
  if (it < 32) {
#pragma unroll
    for (int i = 0; i < 4; ++i) {
      const int idx = it * 1024 + i * 256 + t;
      const int k1 = idx >> 8, kk = idx & 255, ri = kk >> 7, n1 = kk & 127;
      const int ph = (k1 * n1) & 127;
      const float xx = (float)ph / 64.f;
      p.M2[idx] = f2bf(ri ? sinpif(xx) : cospif(xx));
    }
    return;
  }
  it -= 32;
  {
#pragma unroll
    for (int i = 0; i < 4; ++i) {
      const int idx = it * 1024 + i * 256 + t;
      const int k = idx >> 9, kk = idx & 511, ri = kk >> 8, n = kk & 255;
      const int ph = (k * n) & 255;
      const float xx = (float)ph / 128.f;
      p.Mc[idx] = f2bf(ri ? sinpif(xx) : cospif(xx));
    }
  }
}

__device__ __forceinline__ void phase_prep(const Params& p, unsigned char* smem) {
  const int G = gridDim.x;
  int t = bid_();
  for (; t < 192; t += G) ada_item(p, t, smem);
  t -= 192;
  for (; t < 128; t += G) fold_item(p, t, smem);
  t -= 128;
  for (; t < 13440; t += G) conv_item(p, t, smem);
  t -= 13440;
  for (; t < 2336; t += G) elem_item(p, t);
}

__device__ __forceinline__ int row_cond(int row) { return row < T_LAT ? (row >> 13) : 2; }
__device__ __forceinline__ int row_batch(int row) { return row < T_LAT ? (row >> 13) : ((row - T_LAT) >> 8); }
__device__ __forceinline__ int row_pos(int row) { return row < T_LAT ? (CTX + (row & (SEQ - 1))) : ((row - T_LAT) & (CTX - 1)); }

template <int R>
__device__ __forceinline__ void phase_modulate(const Params& p, int l, const float* xlat, const float* xctx, int nrows, int chunk, int bskip) {
  const int t = tid_(), lane = t & 63, wid = t >> 6;
  const int bb = bid_() - bskip;
  if (bb < 0) return;
  const int gw = bb * 4 + wid, nw = ((int)gridDim.x - bskip) * 4;
  for (int row0 = gw * R; row0 < nrows; row0 += nw * R) {
    const float* xr = row0 < T_LAT ? xlat + (size_t)row0 * DM : xctx + (size_t)(row0 - T_LAT) * DM;
    const float* sh = p.mada + (size_t)(l * 3 + row_cond(row0)) * 6144 + chunk * 1024;
    const float* sc = sh + 1024;
    float4 v[R][4];
#pragma unroll
    for (int r = 0; r < R; ++r)
#pragma unroll
      for (int i = 0; i < 4; ++i) v[r][i] = *(const float4*)(xr + (size_t)r * DM + i * 256 + lane * 4);
    float rstd[R];
#pragma unroll
    for (int r = 0; r < R; ++r) {
      float ss = 0.f;
#pragma unroll
      for (int i = 0; i < 4; ++i) ss += v[r][i].x * v[r][i].x + v[r][i].y * v[r][i].y + v[r][i].z * v[r][i].z + v[r][i].w * v[r][i].w;
      ss = wave_sum(ss);
      rstd[r] = rsqrtf(ss * (1.f / 1024.f) + 1e-6f);
    }
#pragma unroll
    for (int i = 0; i < 4; ++i) {
      const int col = i * 256 + lane * 4;
      const float4 s4 = *(const float4*)(sc + col);
      const float4 h4 = *(const float4*)(sh + col);
#pragma unroll
      for (int r = 0; r < R; ++r) {
        u32x2 pk;
        pk.x = pack2(v[r][i].x * rstd[r] * (1.f + s4.x) + h4.x, v[r][i].y * rstd[r] * (1.f + s4.y) + h4.y);
        pk.y = pack2(v[r][i].z * rstd[r] * (1.f + s4.z) + h4.z, v[r][i].w * rstd[r] * (1.f + s4.w) + h4.w);
        *(u32x2*)(p.H + (size_t)(row0 + r) * DM + col) = pk;
      }
    }
  }
}

__device__ __forceinline__ void phase_router_prep(const Params& p) {
  const int t = tid_(), lane = t & 63, wid = t >> 6;
  for (int i = bid_() * 256 + t; i < 2 * 3 * 16384; i += gridDim.x * 256) {
    const int lc = i >> 14, k = (i >> 4) & 1023, e = i & 15, l = lc / 3;
    p.WR2[i] = (1.f + p.mada[(size_t)lc * 6144 + 4 * 1024 + k]) * p.w_router[(size_t)l * 16384 + k * 16 + e];
  }
  for (int o = bid_() * 4 + wid; o < 96; o += gridDim.x * 4) {
    const int lc = o >> 4, e = o & 15, l = lc / 3;
    float s = 0.f;
    for (int k = lane; k < 1024; k += 64) s += p.mada[(size_t)lc * 6144 + 3 * 1024 + k] * p.w_router[(size_t)l * 16384 + k * 16 + e];
    s = wave_sum(s);
    if (lane == 0) p.CE[o] = s;
  }
}

__device__ __forceinline__ void phase_router(const Params& p, int l, const float* xlat, const float* xctx, int nrows) {
  const int t = tid_(), lane = t & 63, wid = t >> 6, l16 = lane & 15, quad = lane >> 4;
  const int gw = bid_() * 4 + wid, nw = gridDim.x * 4;
  const int ntile = nrows >> 4;
  for (int tile = gw; tile < ntile; tile += nw) {
    const int row0 = tile * 16;
    const int cond = row_cond(row0);
    const float* xr = (row0 < T_LAT ? xlat + (size_t)(row0 + l16) * DM : xctx + (size_t)(row0 - T_LAT + l16) * DM) + quad * 4;
    const float* wp = p.WR2 + (size_t)(l * 3 + cond) * 16384 + quad * 64 + l16;
    f32x4 acc = (f32x4){0.f, 0.f, 0.f, 0.f};
    float ss = 0.f;
#pragma unroll 4
    for (int s = 0; s < 64; ++s) {
      const float4 a = *(const float4*)(xr + s * 16);
      const float b0 = wp[s * 256], b1 = wp[s * 256 + 16], b2 = wp[s * 256 + 32], b3 = wp[s * 256 + 48];
      ss += a.x * a.x + a.y * a.y + a.z * a.z + a.w * a.w;
      acc = __builtin_amdgcn_mfma_f32_16x16x4f32(a.x, b0, acc, 0, 0, 0);
      acc = __builtin_amdgcn_mfma_f32_16x16x4f32(a.y, b1, acc, 0, 0, 0);
      acc = __builtin_amdgcn_mfma_f32_16x16x4f32(a.z, b2, acc, 0, 0, 0);
      acc = __builtin_amdgcn_mfma_f32_16x16x4f32(a.w, b3, acc, 0, 0, 0);
    }
    ss += __shfl_xor(ss, 16);
    ss += __shfl_xor(ss, 32);
    const float rstd = rsqrtf(ss * (1.f / 1024.f) + 1e-6f);
    const float ce = p.CE[(l * 3 + cond) * 16 + l16];
#pragma unroll
    for (int j = 0; j < 4; ++j) {
      const int tk = quad * 4 + j;
      const float r = __shfl(rstd, tk);
      const float lg = acc[j] * r + ce;
      float mx = lg;
#pragma unroll
      for (int o = 8; o; o >>= 1) mx = fmaxf(mx, __shfl_xor(mx, o));
      const float ex = __expf(lg - mx);
      float sm = ex;
#pragma unroll
      for (int o = 8; o; o >>= 1) sm += __shfl_xor(sm, o);
      const float aff = ex / sm;
      const int row = row0 + tk;
      if (row < T_LAT) p.AFFT[(size_t)((row >> 13) * 16 + l16) * SEQ + (row & (SEQ - 1))] = aff;
      else { const int rc = row - T_LAT; p.AFFT[(size_t)32 * SEQ + ((rc >> 8) * 16 + l16) * CTX + (rc & 255)] = aff; }
    }
  }
}

__device__ __forceinline__ void phase_in_gemm(const Params& p, int l, unsigned char* smem) {
  const u16* W = p.WinT + (size_t)l * 1536 * 1024;
  XCD_FOR(t, 132 * 11) {
    const int mt = t / 11, nt = t % 11;
    const int row_base = mt * 128;
    auto epi = [&](f32x4(&acc)[4][4], int r0, int c0) {
      const bool act = nt < 4;
      auto vf = [&](int, int, float v) { return act ? gelu_tanh(v) : v; };
      auto rp = [&](int r) -> u16* {
        const int row = row_base + r;
        if (nt < 4) return p.PX + (size_t)row * 1024 + nt * 128;
        if (nt >= 8) return p.PX + (size_t)row * 1024 + 512 + (nt - 8) * 128;
        const int ri = (nt - 4) >> 1, jx = ((nt - 4) & 1) * 128;
        if (row < T_LAT) return p.GD + ((size_t)((row >> 13) * 2 + ri) * SEQ + (row & (SEQ - 1))) * 256 + jx;
        const int rc = row - T_LAT;
        return p.GDc + ((size_t)((rc >> 8) * 2 + ri) * CTX + (rc & 255)) * 256 + jx;
      };
      epi_staged_bf16<4>(acc, r0, c0, smem, vf, rp);
    };
    gemm_tile<4, false>(p.H + (size_t)row_base * 1024, 1024, nullptr, 128, W + (size_t)nt * 128 * 1024, 1024, 1024, smem, epi);
  }
  XCD_FOR(t, 132) {
    const int row_base = t * 128;
    auto epi = [&](f32x4(&acc)[4][2], int r0, int c0) {
      auto vf = [&](int, int, float v) { return v; };
      auto rp = [&](int r) -> u16* { return p.PX + (size_t)(row_base + r) * 1024 + 896; };
      epi_staged_bf16<2>(acc, r0, c0, smem, vf, rp);
    };
    gemm_tile<2, false>(p.H + (size_t)row_base * 1024, 1024, nullptr, 128, W + (size_t)11 * 128 * 1024, 1024, 1024, smem, epi);
  }
}

__device__ __forceinline__ void phase_rownorm(const Params& p, int l) {
  constexpr int R = 4;
  const int t = tid_(), lane = t & 63, wid = t >> 6;
  const int gw = bid_() * 4 + wid, nw = gridDim.x * 4;
  const float* nv = p.sgu_norm + l * 256 + lane * 4;
  const float* nq = p.q_lora_norm + l * 256 + lane * 4;
  const float* nk = p.kv_lora_norm + l * 128 + lane * 2;
  for (int row0 = gw * R; row0 < TT; row0 += nw * R) {
    u16* px = p.PX + (size_t)row0 * 1024;
    u32x2 rv[R], rq[R];
    unsigned rk[R];
#pragma unroll
    for (int r = 0; r < R; ++r) {
      rv[r] = *(const u32x2*)(px + r * 1024 + 256 + lane * 4);
      rq[r] = *(const u32x2*)(px + r * 1024 + 512 + lane * 4);
      rk[r] = *(const unsigned*)(px + r * 1024 + 768 + lane * 2);
    }
#pragma unroll
    for (int r = 0; r < R; ++r) {
      {
        const float a = bf2f((u16)(rv[r].x & 0xffff)), b = bf2f((u16)(rv[r].x >> 16)), c = bf2f((u16)(rv[r].y & 0xffff)), d = bf2f((u16)(rv[r].y >> 16));
        const float rstd = rsqrtf(wave_sum(a * a + b * b + c * c + d * d) * (1.f / 256.f) + 1e-6f);
        u32x2 o;
        o.x = pack2(a * rstd * nv[0], b * rstd * nv[1]);
        o.y = pack2(c * rstd * nv[2], d * rstd * nv[3]);
        *(u32x2*)(px + r * 1024 + 256 + lane * 4) = o;
      }
      {
        const float a = bf2f((u16)(rq[r].x & 0xffff)), b = bf2f((u16)(rq[r].x >> 16)), c = bf2f((u16)(rq[r].y & 0xffff)), d = bf2f((u16)(rq[r].y >> 16));
        const float rstd = rsqrtf(wave_sum(a * a + b * b + c * c + d * d) * (1.f / 256.f) + 1e-6f);
        u32x2 o;
        o.x = pack2(a * rstd * nq[0], b * rstd * nq[1]);
        o.y = pack2(c * rstd * nq[2], d * rstd * nq[3]);
        *(u32x2*)(px + r * 1024 + 512 + lane * 4) = o;
      }
      {
        const float a = bf2f((u16)(rk[r] & 0xffff)), b = bf2f((u16)(rk[r] >> 16));
        const float rstd = rsqrtf(wave_sum(a * a + b * b) * (1.f / 128.f) + 1e-6f);
        *(unsigned*)(px + r * 1024 + 768 + lane * 2) = pack2(a * rstd * nk[0], b * rstd * nk[1]);
      }
    }
  }
}

__device__ __forceinline__ void phase_mix_a(const Params& p, int l, bool last, unsigned char* smem) {
  {
    const u16* W = p.WuqT + (size_t)l * 768 * 256;
    XCD_FOR(t, 132 * 6) {
      const int mt = t / 6, nt = t % 6, row_base = mt * 128;
      auto epi = [&](f32x4(&acc)[4][4], int r0, int c0) {
        const float* rs = (const float*)(smem + 65536);
        auto vf = [&](int r, int, float v) { return v * rs[r]; };
        auto rp = [&](int r) -> u16* { return p.QR + (size_t)(row_base + r) * 768 + nt * 128; };
        epi_staged_bf16<4>(acc, r0, c0, smem, vf, rp);
      };
      gemm_tile<4, false, false, true>(p.PX + (size_t)row_base * 1024 + 512, 1024, nullptr, 128, W + (size_t)nt * 128 * 256, 256, 256, smem, epi);
    }
  }
  {
    const u16* W = p.WukvT + (size_t)l * 1024 * 128;
    XCD_FOR(t, 132 * 8) {
      const int mt = t >> 3, nt = t & 7, row_base = mt * 128, h = nt >> 1;
      const int b = row_batch(row_base), pos_base = row_pos(row_base);
      auto epi = [&](f32x4(&acc)[4][4], int r0, int c0) {
#pragma unroll
        for (int mi = 0; mi < 4; ++mi)
#pragma unroll
          for (int ni = 0; ni < 4; ++ni) {
            const int col = c0 + ni * 16;
            if ((nt & 1) == 0) {
            } else {
              u32x2 pk;
              pk.x = pack2(acc[mi][ni][0], acc[mi][ni][1]);
              pk.y = pack2(acc[mi][ni][2], acc[mi][ni][3]);
              *(u32x2*)(p.Vt + ((size_t)(b * 4 + h) * 128 + col) * NPOS + pos_base + r0 + mi * 16) = pk;
            }
          }
      };
      auto epi2 = [&](f32x4(&acc)[4][4], int r0, int c0) {
        const float* rs = (const float*)(smem + 65536);
        if ((nt & 1) == 0) {
          auto vf = [&](int r, int, float v) { return v * rs[r]; };
          auto rp = [&](int r) -> u16* { return p.KN + (size_t)(row_base + r) * 512 + h * 128; };
          epi_staged_bf16<4>(acc, r0, c0, smem, vf, rp);
        } else {
#pragma unroll
          for (int mi = 0; mi < 4; ++mi)
#pragma unroll
            for (int j = 0; j < 4; ++j) {
              const float sc = rs[r0 + mi * 16 + j];
#pragma unroll
              for (int ni = 0; ni < 4; ++ni) acc[mi][ni][j] *= sc;
            }
          auto cp = [&](int c) -> u16* { return p.Vt + ((size_t)(b * 4 + h) * 128 + c) * NPOS + pos_base; };
          epi_staged_bf16_T(acc, r0, c0, smem, cp);
        }
      };
      gemm_tile<4, false, false, true>(p.PX + (size_t)row_base * 1024 + 768, 1024, nullptr, 128, W + (size_t)nt * 128 * 128, 128, 128, smem, epi2);
    }
  }
  {
    const int nch = last ? 128 : 132;
    XCD_FOR(t, nch * 4) {
      const int ch = t >> 2, h = t & 3, row_base = ch * 128;
      const float* bs = p.b_sgu + (l * 4 + h) * 128;
      const float* sgn = p.sgu_norm + l * 256 + h * 64;
      float* rsv = (float*)(smem + 65536 + 512);
      {
        const int t3 = tid_(), q = t3 >> 1, half = t3 & 1;
        const u16* vp = p.PX + (size_t)(row_base + q) * 1024 + 256 + half * 128;
        float s = 0.f;
#pragma unroll
        for (int i = 0; i < 16; ++i) {
          const u32x4 w = *(const u32x4*)(vp + i * 8);
          const float a0 = __uint_as_float(w.x << 16), a1 = __uint_as_float(w.x & 0xffff0000u), a2 = __uint_as_float(w.y << 16), a3 = __uint_as_float(w.y & 0xffff0000u);
          const float a4 = __uint_as_float(w.z << 16), a5 = __uint_as_float(w.z & 0xffff0000u), a6 = __uint_as_float(w.w << 16), a7 = __uint_as_float(w.w & 0xffff0000u);
          s += (a0 * a0 + a1 * a1) + (a2 * a2 + a3 * a3) + (a4 * a4 + a5 * a5) + (a6 * a6 + a7 * a7);
        }
        s += __shfl_xor(s, 1);
        __syncthreads();
        if (half == 0) rsv[q] = rsqrtf(s * (1.f / 256.f) + 1e-6f);
      }
      auto epi = [&](f32x4(&acc)[4][2], int r0, int c0) {
        float* Ts = (float*)smem;
        const int t2 = tid_();
        __syncthreads();
#pragma unroll
        for (int mi = 0; mi < 4; ++mi)
#pragma unroll
          for (int ni = 0; ni < 2; ++ni)
#pragma unroll
            for (int j = 0; j < 4; ++j) {
              const int pr = r0 + mi * 16 + j;
              Ts[pr * 68 + c0 + ni * 16] = acc[mi][ni][j] * sgn[c0 + ni * 16] + bs[pr];
            }
        __syncthreads();
#pragma unroll
        for (int i = 0; i < 4; ++i) {
          const int c = t2 + 256 * i, pr = c >> 3, ch = c & 7;
          const size_t o = (size_t)(row_base + pr) * 1024 + h * 64 + ch * 8;
          const u32x4 u = *(const u32x4*)(p.PX + o);
          const float4 z0 = *(const float4*)(Ts + pr * 68 + ch * 8), z1 = *(const float4*)(Ts + pr * 68 + ch * 8 + 4);
          u32x4 r;
          r.x = pack2(bf2f((u16)(u.x & 0xffffu)) * z0.x, bf2f((u16)(u.x >> 16)) * z0.y);
          r.y = pack2(bf2f((u16)(u.y & 0xffffu)) * z0.z, bf2f((u16)(u.y >> 16)) * z0.w);
          r.z = pack2(bf2f((u16)(u.z & 0xffffu)) * z1.x, bf2f((u16)(u.z >> 16)) * z1.y);
          r.w = pack2(bf2f((u16)(u.w & 0xffffu)) * z1.z, bf2f((u16)(u.w >> 16)) * z1.w);
          *(u32x4*)(p.YM + o) = r;
        }
      };
      gemm_tile<2, true>(p.Wsgu + (size_t)(l * 4 + h) * 16384, 128, nullptr, 128, p.PX + (size_t)row_base * 1024 + 256 + h * 64, 1024, 128, smem, epi, rsv);
    }
  }
  {
    XCD_FOR(t, 512) {
      const int nh = t & 1, n1 = (t >> 1) & 127, b = t >> 8;
      auto epi = [&](f32x4(&acc)[4][4], int r0, int c0) {
        auto vf = [&](int, int, float v) { return v; };
        auto rp = [&](int m) -> u16* { const int rip = m >> 6, k2 = m & 63; return p.PF + ((size_t)((b * 64 + k2) * 2 + rip) * 128 + n1) * 256 + nh * 128; };
        epi_staged_bf16<4>(acc, r0, c0, smem, vf, rp);
      };
      gemm_tile<4, true>(p.M1 + (size_t)n1 * 16384, 128, nullptr, 128, p.GD + (size_t)b * 2 * SEQ * 256 + (size_t)n1 * 256 + nh * 128, 128 * 256, 128, smem, epi);
    }
  }
  if (!last) {
    for (int t = bid_(); t < 8; t += gridDim.x) {
      const int nh = t & 1, mt = (t >> 1) & 1, b = t >> 2;
      auto epi = [&](f32x4(&acc)[4][4], int r0, int c0) {
#pragma unroll
        for (int mi = 0; mi < 4; ++mi)
#pragma unroll
          for (int ni = 0; ni < 4; ++ni)
#pragma unroll
            for (int j = 0; j < 4; ++j) {
              const int k = mt * 128 + r0 + mi * 16 + j;
              p.YM[(size_t)(T_LAT + b * CTX + k) * 1024 + 256 + nh * 128 + c0 + ni * 16] = f2bf(acc[mi][ni][j] * (1.f / 128.f));
            }
      };
      gemm_tile<4, true>(p.Mc + (size_t)mt * 128 * 512, 512, nullptr, 128, p.GDc + (size_t)b * 2 * CTX * 256 + nh * 128, 256, 512, smem, epi);
    }
  }
}

__device__ __forceinline__ void phase_mix_b(const Params& p, int l, bool last, unsigned char* smem) {
  XCD_FOR(t, 512) {
    const int nq = t & 3, k2 = (t >> 2) & 63, b = t >> 8;
    auto epi = [&](f32x4(&acc)[4][2], int r0, int c0) {
      auto vf = [&](int, int, float v) { return v * 0.001381067932004976f; };
      auto rp = [&](int k1) -> u16* { return p.YM + (size_t)(b * SEQ + 64 * k1 + k2) * 1024 + 256 + nq * 64; };
      epi_staged_bf16<2>(acc, r0, c0, smem, vf, rp);
    };
    gemm_tile<2, true>(p.M2, 256, nullptr, 128, p.PF + (size_t)(b * 64 + k2) * 2 * 128 * 256 + nq * 64, 256, 256, smem, epi);
  }
  const int tt = tid_(), lane = tt & 63, wid = tt >> 6;
  const int gw = bid_() * 4 + wid, nw = gridDim.x * 4;
  const float QSCALE = 0.07216878364870322f * 1.4426950408889634f;
  for (int row = gw; row < TT; row += nw) {
    const bool lat = row < T_LAT;
    const int b = row_batch(row), pos = row_pos(row);
    float cs = 1.f, sn = 0.f;
    if (lat) {
      const int n = row & (SEQ - 1);
      const int r = lane, sub = r & 31, i = sub & 15;
      const float ps = (r < 32) ? (float)(n >> 6) : (float)(n & 63);
      const float fr = __builtin_amdgcn_exp2f(-(float)i * 0.83048202372184058696f);
      const float ang = ps * fr;
      sn = __sinf(ang);
      cs = __cosf(ang);
    }
    const bool hi = ((lane & 31) >= 16);
    if (lat || !last) {
#pragma unroll
      for (int h = 0; h < 4; ++h) {
        const u16* q = p.QR + (size_t)row * 768 + h * 192;
        float v0 = bf2f(q[lane]), v1 = bf2f(q[lane + 64]), v2 = bf2f(q[lane + 128]);
        const float ss = wave_sum(v0 * v0 + v1 * v1 + v2 * v2);
        const float rstd = rsqrtf(ss * (1.f / 192.f) + 1e-6f);
        const float* qn = p.q_norm + l * 192;
        v0 *= rstd * qn[lane]; v1 *= rstd * qn[lane + 64]; v2 *= rstd * qn[lane + 128];
        if (lat) {
          const float xp = __shfl_xor(v2, 16);
          v2 = hi ? (xp * sn + v2 * cs) : (v2 * cs - xp * sn);
        }
        u16* o = p.Qall + ((size_t)(b * 4 + h) * NPOS + pos) * 192;
        o[lane] = f2bf(v0 * QSCALE); o[lane + 64] = f2bf(v1 * QSCALE); o[lane + 128] = f2bf(v2 * QSCALE);
      }
    }
    {
      const float kr = bf2f(p.PX[(size_t)row * 1024 + 896 + lane]);
#pragma unroll
      for (int h = 0; h < 4; ++h) {
        const u16* kk = p.KN + (size_t)row * 512 + h * 128;
        float v0 = bf2f(kk[lane]), v1 = bf2f(kk[lane + 64]), v2 = kr;
        const float ss = wave_sum(v0 * v0 + v1 * v1 + v2 * v2);
        const float rstd = rsqrtf(ss * (1.f / 192.f) + 1e-6f);
        const float* kn = p.k_norm + l * 192;
        v0 *= rstd * kn[lane]; v1 *= rstd * kn[lane + 64]; v2 *= rstd * kn[lane + 128];
        if (lat) {
          const float xp = __shfl_xor(v2, 16);
          v2 = hi ? (xp * sn + v2 * cs) : (v2 * cs - xp * sn);
        }
        u16* o = p.Kb + ((size_t)(b * 4 + h) * NPOS + pos) * 192;
        o[lane] = f2bf(v0); o[lane + 64] = f2bf(v1); o[lane + 128] = f2bf(v2);
      }
    }
  }
}

__device__ __forceinline__ void attn_item(const Params& p, int b, int h, int qt, unsigned char* smem) {
  constexpr int STAGE = 32 * 208 + 128 * 40;
  u16* sbase = (u16*)smem;
  const int t = tid_(), lane = t & 63, wid = t >> 6, l16 = lane & 15, quad = lane >> 4;
  const int nkeys = (qt < 2) ? CTX : NPOS;
  const int ntile = nkeys >> 5;
  const u16* Qp = p.Qall + ((size_t)(b * 4 + h) * NPOS + qt * 128 + wid * 32) * 192;
  const u16* kp = p.Kb + (size_t)(b * 4 + h) * NPOS * 192 + t * 8;
  const u16* vp = p.Vt + (size_t)(b * 4 + h) * 128 * NPOS + (size_t)(t >> 2) * NPOS + (t & 3) * 8;
  const u16* qlane = Qp + (size_t)l16 * 192 + quad * 8;
  bf16x8 bq[2][6];
#pragma unroll
  for (int qi = 0; qi < 2; ++qi)
#pragma unroll
    for (int ks = 0; ks < 6; ++ks) bq[qi][ks] = *(const bf16x8*)(qlane + qi * 16 * 192 + ks * 32);
  f32x4 o[8][2];
#pragma unroll
  for (int vt = 0; vt < 8; ++vt)
#pragma unroll
    for (int qi = 0; qi < 2; ++qi) o[vt][qi] = (f32x4){0.f, 0.f, 0.f, 0.f};
  float mrun0 = -1e30f, mrun1 = -1e30f, lrun0 = 0.f, lrun1 = 0.f;
  u32x4 rk[3], rv[2];
  f32x4 sA[2][2], sB[2][2];
#define ATT_LOAD(kt_)                                                                                   \
  {                                                                                                     \
    _Pragma("unroll") for (int i = 0; i < 3; ++i) rk[i] = *(const u32x4*)(kp + (size_t)(kt_) * 6144 + i * 2048); \
    _Pragma("unroll") for (int i = 0; i < 2; ++i) rv[i] = *(const u32x4*)(vp + (size_t)(64 * i) * NPOS + (kt_) * 32); \
  }
#define ATT_STORE(st_)                                                                                  \
  {                                                                                                     \
    u16* kd = sbase + (st_) * STAGE;                                                                    \
    _Pragma("unroll") for (int i = 0; i < 3; ++i) {                                                     \
      const int c = t + 256 * i;                                                                        \
      *(u32x4*)(kd + (c / 24) * 208 + (c % 24) * 8) = rk[i];                                            \
    }                                                                                                   \
    _Pragma("unroll") for (int i = 0; i < 2; ++i) *(u32x4*)(kd + 6656 + ((t >> 2) + 64 * i) * 40 + (t & 3) * 8) = rv[i]; \
  }
#define ATT_S(SX, kst_)                                                                                 \
  {                                                                                                     \
    const u16* Ks = sbase + (kst_) * STAGE;                                                             \
    _Pragma("unroll") for (int a = 0; a < 2; ++a)                                                       \
      _Pragma("unroll") for (int qi = 0; qi < 2; ++qi) SX[a][qi] = (f32x4){0.f, 0.f, 0.f, 0.f};         \
    _Pragma("unroll") for (int ks = 0; ks < 6; ++ks) {                                                  \
      _Pragma("unroll") for (int a = 0; a < 2; ++a) {                                                   \
        const bf16x8 kf = *(const bf16x8*)(Ks + (a * 16 + l16) * 208 + ks * 32 + quad * 8);             \
        _Pragma("unroll") for (int qi = 0; qi < 2; ++qi) SX[a][qi] = __builtin_amdgcn_mfma_f32_16x16x32_bf16(kf, bq[qi][ks], SX[a][qi], 0, 0, 0); \
      }                                                                                                 \
    }                                                                                                   \
  }
#define ATT_VLOAD(vst_, hv_)                                                                            \
  {                                                                                                     \
    const u16* Vs = sbase + (vst_) * STAGE + 6656;                                                      \
    _Pragma("unroll") for (int vt = 0; vt < 4; ++vt) {                                                  \
      const u16* vb = Vs + (((hv_) * 4 + vt) * 16 + l16) * 40 + quad * 4;                               \
      const u32x2 va = *(const u32x2*)(vb);                                                             \
      const u32x2 vc = *(const u32x2*)(vb + 16);                                                        \
      const u32x4 vw = {va.x, va.y, vc.x, vc.y};                                                        \
      vfr[vt] = (bf16x8)vw;                                                                             \
    }                                                                                                   \
  }
#define ATT_DECIDE(SX)                                                                                  \
  {                                                                                                     \
    float mxq[2];                                                                                       \
    _Pragma("unroll") for (int qi = 0; qi < 2; ++qi) {                                                  \
      float mx = fmaxf(fmaxf(fmaxf(SX[0][qi][0], SX[0][qi][1]), fmaxf(SX[0][qi][2], SX[0][qi][3])),     \
                       fmaxf(fmaxf(SX[1][qi][0], SX[1][qi][1]), fmaxf(SX[1][qi][2], SX[1][qi][3])));    \
      auto r16 = __builtin_amdgcn_permlane16_swap(__float_as_uint(mx), __float_as_uint(mx), false, false); \
      mx = fmaxf(__uint_as_float(r16[0]), __uint_as_float(r16[1]));                                     \
      auto r32 = __builtin_amdgcn_permlane32_swap(__float_as_uint(mx), __float_as_uint(mx), false, false); \
      mxq[qi] = fmaxf(__uint_as_float(r32[0]), __uint_as_float(r32[1]));                                \
    }                                                                                                   \
    if (__any((mxq[0] > mrun0 + 8.f) || (mxq[1] > mrun1 + 8.f))) {        \
      const float mn0 = fmaxf(mrun0, mxq[0]), mn1 = fmaxf(mrun1, mxq[1]);                               \
      const float al0 = __builtin_amdgcn_exp2f(mrun0 - mn0), al1 = __builtin_amdgcn_exp2f(mrun1 - mn1); \
      lrun0 *= al0; lrun1 *= al1; mrun0 = mn0; mrun1 = mn1;                                             \
      _Pragma("unroll") for (int vt = 0; vt < 8; ++vt) {                                                \
        o[vt][0][0] *= al0; o[vt][0][1] *= al0; o[vt][0][2] *= al0; o[vt][0][3] *= al0;                 \
        o[vt][1][0] *= al1; o[vt][1][1] *= al1; o[vt][1][2] *= al1; o[vt][1][3] *= al1;                 \
      }                                                                                                 \
    }                                                                                                   \
  }
#define ATT_FINISH(SX, vst_)                                                                            \
  {                                                                                                     \
    bf16x8 pb[2];                                                                                       \
    _Pragma("unroll") for (int qi = 0; qi < 2; ++qi) {                                                  \
      const float mcur = qi ? mrun1 : mrun0;                                                            \
      float psum = 0.f;                                                                                 \
      _Pragma("unroll") for (int a = 0; a < 2; ++a)                                                     \
        _Pragma("unroll") for (int j = 0; j < 4; ++j) {                                                 \
          const float pe = __builtin_amdgcn_exp2f(SX[a][qi][j] - mcur);                                 \
          SX[a][qi][j] = pe;                                                                            \
          psum += pe;                                                                                   \
        }                                                                                               \
      if (qi) lrun1 += psum; else lrun0 += psum;                                                        \
      u32x4 pk;                                                                                         \
      pk.x = pack2(SX[0][qi][0], SX[0][qi][1]);                                                         \
      pk.y = pack2(SX[0][qi][2], SX[0][qi][3]);                                                         \
      pk.z = pack2(SX[1][qi][0], SX[1][qi][1]);                                                         \
      pk.w = pack2(SX[1][qi][2], SX[1][qi][3]);                                                         \
      pb[qi] = (bf16x8)pk;                                                                              \
    }                                                                                                   \
    _Pragma("unroll") for (int vt = 0; vt < 4; ++vt)                                                    \
      _Pragma("unroll") for (int qi = 0; qi < 2; ++qi) o[vt][qi] = __builtin_amdgcn_mfma_f32_16x16x32_bf16(vfr[vt], pb[qi], o[vt][qi], 0, 0, 0); \
    ATT_VLOAD(vst_, 1);                                                                                 \
    _Pragma("unroll") for (int vt = 0; vt < 4; ++vt)                                                    \
      _Pragma("unroll") for (int qi = 0; qi < 2; ++qi) o[4 + vt][qi] = __builtin_amdgcn_mfma_f32_16x16x32_bf16(vfr[vt], pb[qi], o[4 + vt][qi], 0, 0, 0); \
  }
#define ATT_STEP(SNEW, SOLD, tt_)                                                                       \
  {                                                                                                     \
    const int tn_ = ((tt_) + 1 < ntile) ? (tt_) + 1 : ntile - 1;                                        \
    ATT_LOAD(tn_);                                                                                      \
    bf16x8 vfr[4];                                                                                      \
    ATT_VLOAD(((tt_) - 1) % 3, 0);                                                                      \
    ATT_DECIDE(SOLD);                                                                                   \
    ATT_S(SNEW, (tt_) % 3);                                                                             \
    ATT_FINISH(SOLD, ((tt_) - 1) % 3);                                                                  \
    ATT_STORE(((tt_) + 1) % 3);                                                                         \
    __syncthreads();                                                                                    \
  }
  __syncthreads();
  ATT_LOAD(0);
  ATT_STORE(0);
  ATT_LOAD(1);
  __syncthreads();
  ATT_S(sA, 0);
  ATT_STORE(1);
  __syncthreads();
  for (int tt = 1; tt < ntile - 1; tt += 2) {
    ATT_STEP(sB, sA, tt);
    ATT_STEP(sA, sB, tt + 1);
  }
  ATT_STEP(sB, sA, ntile - 1);
  {
    bf16x8 vfr[4];
    ATT_VLOAD((ntile - 1) % 3, 0);
    ATT_DECIDE(sB);
    ATT_FINISH(sB, (ntile - 1) % 3);
  }
  __syncthreads();
#undef ATT_LOAD
#undef ATT_STORE
#undef ATT_S
#undef ATT_VLOAD
#undef ATT_DECIDE
#undef ATT_FINISH
#undef ATT_STEP
#pragma unroll
  for (int qi = 0; qi < 2; ++qi) {
    float ls = qi ? lrun1 : lrun0;
    ls += __shfl_xor(ls, 16);
    ls += __shfl_xor(ls, 32);
    const float inv = 1.f / ls;
    const int pos = qt * 128 + wid * 32 + qi * 16 + l16;
    const int row = (pos < CTX) ? (T_LAT + b * CTX + pos) : (b * SEQ + pos - CTX);
    u16* orow = p.YM + (size_t)row * 1024 + 512 + h * 128 + quad * 4;
#pragma unroll
    for (int vt = 0; vt < 8; ++vt) {
      u32x2 pk;
      pk.x = pack2(o[vt][qi][0] * inv, o[vt][qi][1] * inv);
      pk.y = pack2(o[vt][qi][2] * inv, o[vt][qi][3] * inv);
      *(u32x2*)(orow + vt * 16) = pk;
    }
  }
}

__device__ __forceinline__ void phase_attn(const Params& p, bool last, unsigned char* smem) {
  const int x = bid_() & 7, j = bid_() >> 3, gb = gridDim.x >> 3;
  for (int q = j; q < 64; q += gb) attn_item(p, x >> 2, x & 3, 2 + q, smem);
  if (!last)
    for (int q = j; q < 2; q += gb) attn_item(p, x >> 2, x & 3, q, smem);
}

__device__ __forceinline__ void phase_out_gemm(const Params& p, int l, bool last, const float* slat, const float* sctx, float* dlat, float* dctx, unsigned char* smem) {
  const u16* W = p.WoutT + (size_t)l * 1024 * 1024;
  XCD_FOR(t, 128 * 8) {
    const int mt = t >> 3, nt = t & 7, row_base = mt * 128;
    const float* g1 = p.mada + (size_t)(l * 3 + (row_base >> 13)) * 6144 + 2 * 1024 + nt * 128;
    const float* xs = slat + (size_t)row_base * DM;
    float* xd = dlat + (size_t)row_base * DM;
    auto epi = [&](f32x4(&acc)[4][4], int r0, int c0) { epi_staged_residual(acc, r0, c0, smem, g1, xs + nt * 128, xd + nt * 128); };
    gemm_tile<4, false>(p.YM + (size_t)row_base * 1024, 1024, nullptr, 128, W + (size_t)nt * 128 * 1024, 1024, 1024, smem, epi);
  }
  if (!last) {
    XCD_FOR(t, 4 * 32) {
      const int mt = t >> 5, nt = t & 31, row_base = mt * 128;
      const float* g1 = p.mada + (size_t)(l * 3 + 2) * 6144 + 2 * 1024 + nt * 32;
      const float* xs = sctx + (size_t)row_base * DM;
      float* xd = dctx + (size_t)row_base * DM;
      auto epi = [&](f32x4(&acc)[4][1], int r0, int c0) {
#pragma unroll
        for (int mi = 0; mi < 4; ++mi) {
          const float g = g1[c0];
#pragma unroll
          for (int j = 0; j < 4; ++j) {
            const size_t o = (size_t)(r0 + mi * 16 + j) * DM + nt * 32 + c0;
            xd[o] = xs[o] + g * acc[mi][0][j];
          }
        }
      };
      gemm_tile<1, false>(p.YM + (size_t)(T_LAT + row_base) * 1024, 1024, nullptr, 128, W + (size_t)nt * 32 * 1024, 1024, 1024, smem, epi);
    }
  }
}

__device__ __forceinline__ unsigned block_incl_scan(unsigned x, unsigned* wsum, int lane, int wid, unsigned& total) {
  unsigned v = x;
#pragma unroll
  for (int off = 1; off < 64; off <<= 1) {
    const unsigned n = __shfl_up(v, off);
    if (lane >= off) v += n;
  }
  __syncthreads();
  if (lane == 63) wsum[wid] = v;
  __syncthreads();
  const unsigned w0 = wsum[0], w1 = wsum[1], w2 = wsum[2], w3 = wsum[3];
  total = w0 + w1 + w2 + w3;
  const unsigned base = (wid > 0 ? w0 : 0u) + (wid > 1 ? w1 : 0u) + (wid > 2 ? w2 : 0u);
  return base + v;
}

__device__ __forceinline__ void phase_topk(const Params& p, bool last, unsigned char* smem) {
  unsigned* key = (unsigned*)smem;
  unsigned* hist = key + 8192;
  unsigned* wsum = hist + 256;
  unsigned* sh = wsum + 4;
  const int t = tid_(), lane = t & 63, wid = t >> 6;
  const int ninst = last ? 32 : 64;
  for (int inst = bid_(); inst < ninst; inst += gridDim.x) {
    const bool lat = inst < 32;
    const int n = lat ? SEQ : CTX, cap = lat ? 1024 : 32;
    const float* src = lat ? p.AFFT + (size_t)inst * SEQ : p.AFFT + (size_t)32 * SEQ + (inst - 32) * CTX;
    const int rowbase = lat ? (inst >> 4) * SEQ : T_LAT + ((inst - 32) >> 4) * CTX;
    for (int i = t; i < n; i += 256) key[i] = __float_as_uint(src[i]);
    unsigned prefix = 0u, mask = 0u, remaining = (unsigned)cap;
    for (int shift = 24; shift >= 0; shift -= 8) {
      hist[t] = 0u;
      __syncthreads();
      for (int i = t; i < n; i += 256) {
        const unsigned k = key[i];
        if ((k & mask) == prefix) atomicAdd(&hist[(k >> shift) & 255u], 1u);
      }
      __syncthreads();
      const unsigned hc = hist[t];
      unsigned total;
      const unsigned incl = block_incl_scan(hc, wsum, lane, wid, total);
      const unsigned suf = total - incl + hc;
      const unsigned sufn = total - incl;
      if (suf >= remaining && sufn < remaining) { sh[0] = prefix | ((unsigned)t << shift); sh[1] = remaining - sufn; }
      __syncthreads();
      prefix = sh[0];
      remaining = sh[1];
      mask |= (255u << shift);
      __syncthreads();
    }
    const int per = n >> 8;
    unsigned cgt = 0u, ceq = 0u;
    for (int i = 0; i < per; ++i) {
      const unsigned k = key[t * per + i];
      cgt += (k > prefix) ? 1u : 0u;
      ceq += (k == prefix) ? 1u : 0u;
    }
    unsigned ngt, neq;
    unsigned og = block_incl_scan(cgt, wsum, lane, wid, ngt) - cgt;
    unsigned oe = block_incl_scan(ceq, wsum, lane, wid, neq) - ceq;
    int* idx = p.IDXG + (size_t)inst * 1024;
    float* gt = p.GATE + (size_t)inst * 1024;
    int* inv = p.INV + (size_t)rowbase * 16 + (inst & 15);
    for (int i = 0; i < per; ++i) {
      const int e = t * per + i;
      const unsigned k = key[e];
      int slot = -1;
      if (k > prefix) {
        slot = (int)og; ++og;
      } else if (k == prefix) {
        if (oe < remaining) slot = (int)(ngt + oe);
        ++oe;
      }
      if (slot >= 0) { idx[slot] = rowbase + e; gt[slot] = __uint_as_float(k); }
      inv[(size_t)e * 16] = slot;
    }
    __syncthreads();
  }
}

__device__ __forceinline__ void phase_moe_up(const Params& p, int l, bool last, unsigned char* smem) {
  const int npass = last ? 1 : 2;
  for (int pass = 0; pass < npass; ++pass)
  XCD_FOR(t, ((pass == npass - 1) ? 2048 : 256)) {
    int inst, mt, nt, mvalid, hid_row;
    if (pass == npass - 1) { const int e_ = t >> 7, b_ = (t >> 6) & 1; inst = b_ * 16 + e_; mt = (t >> 3) & 7; nt = t & 7; mvalid = 128; hid_row = inst * 1024 + mt * 128; }
    else { const int e_ = t >> 4, b_ = (t >> 3) & 1; inst = 32 + b_ * 16 + e_; mt = 0; nt = t & 7; mvalid = 32; hid_row = 32768 + (inst - 32) * 128; }
    const int e = inst & 15;
    const u16* W = p.WguT + (size_t)(l * 16 + e) * 1024 * 1024 + (size_t)nt * 128 * 1024;
    auto epi = [&](f32x4(&acc)[4][4], int r0, int c0) {
      u16* Ts = (u16*)smem;
      const int t2 = tid_();
      __syncthreads();
#pragma unroll
      for (int mi = 0; mi < 4; ++mi)
#pragma unroll
        for (int n2 = 0; n2 < 2; ++n2)
#pragma unroll
          for (int j = 0; j < 4; ++j) {
            const int m = r0 + mi * 16 + j;
            const int fl = (c0 >> 6) * 32 + n2 * 16 + (c0 & 15);
            Ts[m * 72 + fl] = f2bf(silu_f(acc[mi][2 * n2][j]) * acc[mi][2 * n2 + 1][j]);
          }
      __syncthreads();
#pragma unroll
      for (int i = 0; i < 4; ++i) {
        const int c = t2 + 256 * i, row = c >> 3, ch = c & 7;
        if (row < mvalid) *(u32x4*)(p.HID + (size_t)(hid_row + row) * 512 + nt * 64 + ch * 8) = *(const u32x4*)(Ts + row * 72 + ch * 8);
      }
    };
    if (mvalid == 128) gemm_tile<4, false, false>(p.H, 1024, p.IDXG + (size_t)inst * 1024 + mt * 128, 128, W, 1024, 1024, smem, epi);
    else gemm_tile<4, false, true>(p.H, 1024, p.IDXG + (size_t)inst * 1024 + mt * 128, mvalid, W, 1024, 1024, smem, epi);
  }
}

__device__ __forceinline__ void phase_moe_down(const Params& p, int l, bool last, unsigned char* smem) {
  const int npass = last ? 1 : 2;
  for (int pass = 0; pass < npass; ++pass)
  XCD_FOR(t, ((pass == npass - 1) ? 2048 : 256)) {
    int inst, mt, nt, mvalid, hid_row;
    if (pass == npass - 1) { const int e_ = t >> 7, b_ = (t >> 6) & 1; inst = b_ * 16 + e_; mt = (t >> 3) & 7; nt = t & 7; mvalid = 128; hid_row = inst * 1024 + mt * 128; }
    else { const int e_ = t >> 4, b_ = (t >> 3) & 1; inst = 32 + b_ * 16 + e_; mt = 0; nt = t & 7; mvalid = 32; hid_row = 32768 + (inst - 32) * 128; }
    const int e = inst & 15;
    const float* gate = p.GATE + (size_t)inst * 1024 + mt * 128;
    const u16* W = p.WdT + (size_t)(l * 16 + e) * 1024 * 512 + (size_t)nt * 128 * 512;
    u16* yb = p.YB + (size_t)hid_row * 1024 + nt * 128;
    auto epi = [&](f32x4(&acc)[4][4], int r0, int c0) {
      auto vf = [&](int r, int, float v) { return (r < mvalid ? gate[r] : 0.f) * v; };
      auto rp = [&](int r) -> u16* { return r < mvalid ? yb + (size_t)r * 1024 : nullptr; };
      epi_staged_bf16<4>(acc, r0, c0, smem, vf, rp);
    };
    if (mvalid == 128) gemm_tile<4, false, false>(p.HID + (size_t)hid_row * 512, 512, nullptr, 128, W, 512, 512, smem, epi);
    else gemm_tile<4, false, true>(p.HID + (size_t)hid_row * 512, 512, nullptr, mvalid, W, 512, 512, smem, epi);
  }
}

template <bool COMBINE, bool MOD>
__device__ __forceinline__ void phase_combine_modulate(const Params& p, int lprev, int lnext, const float* xlat, const float* xctx,
                                                       float* olat, float* octx, int nrows) {
  constexpr int R = 2;
  const int t = tid_(), lane = t & 63, wid = t >> 6;
  const int gw = bid_() * 4 + wid, nw = gridDim.x * 4;
  for (int row0 = gw * R; row0 < nrows; row0 += nw * R) {
    const bool lat = row0 < T_LAT;
    const float* xr = lat ? xlat + (size_t)row0 * DM : xctx + (size_t)(row0 - T_LAT) * DM;
    const int cond = row_cond(row0);
    float4 v[R][4];
#pragma unroll
    for (int r = 0; r < R; ++r)
#pragma unroll
      for (int i = 0; i < 4; ++i) v[r][i] = *(const float4*)(xr + (size_t)r * DM + i * 256 + lane * 4);
    if (COMBINE) {
      const int b = row_batch(row0);
      const int myinv = p.INV[(size_t)row0 * 16 + (lane & 31)];
      const float* g2 = p.mada + (size_t)(lprev * 3 + cond) * 6144 + 5 * 1024;
      float* orow = lat ? olat + (size_t)row0 * DM : octx + (size_t)(row0 - T_LAT) * DM;
#pragma unroll
      for (int r = 0; r < R; ++r) {
        float4 s[4];
#pragma unroll
        for (int i = 0; i < 4; ++i) s[i] = make_float4(0.f, 0.f, 0.f, 0.f);
        unsigned mask = (unsigned)((__ballot(myinv >= 0) >> (16 * r)) & 0xFFFFull);
        while (mask) {
          const int e0 = __builtin_ctz(mask);
          mask &= mask - 1;
          const bool two = mask != 0u;
          const int e1 = two ? __builtin_ctz(mask) : e0;
          mask &= mask - 1;
          const int s0 = __shfl(myinv, 16 * r + e0), s1 = __shfl(myinv, 16 * r + e1);
          const size_t y0 = lat ? (size_t)(b * 16 + e0) * 1024 + s0 : (size_t)32768 + (size_t)(b * 16 + e0) * 128 + s0;
          const size_t y1 = lat ? (size_t)(b * 16 + e1) * 1024 + s1 : (size_t)32768 + (size_t)(b * 16 + e1) * 128 + s1;
          u32x2 a0[4], a1[4];
#pragma unroll
          for (int i = 0; i < 4; ++i) { a0[i] = *(const u32x2*)(p.YB + y0 * 1024 + lane * 4 + i * 256); a1[i] = *(const u32x2*)(p.YB + y1 * 1024 + lane * 4 + i * 256); }
          const float w1 = two ? 1.f : 0.f;
#pragma unroll
          for (int i = 0; i < 4; ++i) {
            s[i].x += bf2f((u16)(a0[i].x & 0xffffu)); s[i].y += bf2f((u16)(a0[i].x >> 16));
            s[i].z += bf2f((u16)(a0[i].y & 0xffffu)); s[i].w += bf2f((u16)(a0[i].y >> 16));
            s[i].x += w1 * bf2f((u16)(a1[i].x & 0xffffu)); s[i].y += w1 * bf2f((u16)(a1[i].x >> 16));
            s[i].z += w1 * bf2f((u16)(a1[i].y & 0xffffu)); s[i].w += w1 * bf2f((u16)(a1[i].y >> 16));
          }
        }
#pragma unroll
        for (int i = 0; i < 4; ++i) {
          const int col = i * 256 + lane * 4;
          const float4 g4 = *(const float4*)(g2 + col);
          v[r][i].x += g4.x * s[i].x; v[r][i].y += g4.y * s[i].y; v[r][i].z += g4.z * s[i].z; v[r][i].w += g4.w * s[i].w;
          *(float4*)(orow + (size_t)r * DM + col) = v[r][i];
        }
      }
    }
    if (MOD) {
      const float* sh = p.mada + (size_t)(lnext * 3 + cond) * 6144;
      const float* sc = sh + 1024;
      float rstd[R];
#pragma unroll
      for (int r = 0; r < R; ++r) {
        float ss = 0.f;
#pragma unroll
        for (int i = 0; i < 4; ++i) ss += v[r][i].x * v[r][i].x + v[r][i].y * v[r][i].y + v[r][i].z * v[r][i].z + v[r][i].w * v[r][i].w;
        rstd[r] = rsqrtf(wave_sum(ss) * (1.f / 1024.f) + 1e-6f);
      }
#pragma unroll
      for (int i = 0; i < 4; ++i) {
        const int col = i * 256 + lane * 4;
        const float4 s4 = *(const float4*)(sc + col);
        const float4 h4 = *(const float4*)(sh + col);
#pragma unroll
        for (int r = 0; r < R; ++r) {
          u32x2 pk;
          pk.x = pack2(v[r][i].x * rstd[r] * (1.f + s4.x) + h4.x, v[r][i].y * rstd[r] * (1.f + s4.y) + h4.y);
          pk.y = pack2(v[r][i].z * rstd[r] * (1.f + s4.z) + h4.z, v[r][i].w * rstd[r] * (1.f + s4.w) + h4.w);
          *(u32x2*)(p.H + (size_t)(row0 + r) * DM + col) = pk;
        }
      }
    }
  }
}

__global__ void __launch_bounds__(256, 2) fwd_megakernel(Params p_unused) {
  const Params& p = *(const Params*)__builtin_amdgcn_kernarg_segment_ptr();
  __shared__ __attribute__((aligned(16))) unsigned char smem[SMEM_BYTES];
  __shared__ uint4 xb_words;
  cg::grid_group grid = cg::this_grid();
  if (threadIdx.x == 0) xb_words = make_uint4(0u, 0u, 0u, 0u);
  __syncthreads();
  XcdBarrier xb = xcd_barrier_post(p.bar, (volatile LAS unsigned*)&xb_words);

#define LP (*launder_(&p))
  phase_prep(LP, smem);
  if (xb_ld(&p.bar[XB_TMO]) == 0xFFFFFFFFu) grid.sync();
  if (threadIdx.x == 0) {
    XB_SPIN(xb_ld(&p.bar[64]) < 192u, p.bar);
    __builtin_amdgcn_fence(__ATOMIC_ACQUIRE, "agent");
    asm volatile("s_waitcnt vmcnt(0)" ::: "memory");
  }
  __syncthreads();

  for (int l = 0; l < 2; ++l) {
    const bool last = (l == 1);
    if (!last) { phase_router_prep(LP); phase_combine_modulate<false, true>(LP, 0, 0, p.x, p.ctx, nullptr, nullptr, TT); }
    else phase_combine_modulate<true, true>(LP, 0, 1, p.out, p.XC, p.out, p.XC, TT);
    xcd_barrier(xb);
    phase_in_gemm(LP, l, smem);
    xcd_barrier(xb);
    phase_mix_a(LP, l, last, smem);
    xcd_barrier(xb);
    phase_mix_b(LP, l, last, smem);
    xcd_barrier(xb);
    phase_attn(LP, last, smem);
    xcd_barrier(xb);
    phase_out_gemm(LP, l, last, last ? p.out : p.x, last ? p.XC : p.ctx, p.out, p.XC, smem);
    xcd_barrier(xb);
    phase_router(LP, l, p.out, p.XC, last ? T_LAT : TT);
    xcd_barrier(xb);
    phase_topk(LP, last, smem);
    phase_modulate<4>(LP, l, p.out, p.XC, last ? T_LAT : TT, 3, last ? 32 : 64);
    xcd_barrier(xb);
    phase_moe_up(LP, l, last, smem);
    xcd_barrier(xb);
    phase_moe_down(LP, l, last, smem);
    xcd_barrier(xb);
  }
  phase_combine_modulate<true, false>(LP, 1, 1, p.out, p.XC, p.out, p.XC, T_LAT);
#undef LP
}

extern "C" void kernel_launch(void* const* d_in, const int* in_sizes, int n_in, void* d_out, int out_size, void* d_ws,
                              size_t ws_size, hipStream_t stream) {
  static int grid_blocks = 0;
  if (!grid_blocks) {
    int dev = 0, cus = 0, per_cu = 0;
    hipGetDevice(&dev);
    hipDeviceGetAttribute(&cus, hipDeviceAttributeMultiprocessorCount, dev);
    hipOccupancyMaxActiveBlocksPerMultiprocessor(&per_cu, fwd_megakernel, 256, 0);
    if (per_cu > 2) per_cu = 2;
    if (per_cu < 1) per_cu = 1;
    grid_blocks = (cus * per_cu) & ~7;
    if (grid_blocks < 8) grid_blocks = 8;
  }
  Params p{};
  const float* const* in = (const float* const*)d_in;
  p.x = in[0]; p.c = in[1]; p.ctx = in[2]; p.c_ctx = in[3]; p.w_ada = in[4]; p.b_ada = in[5]; p.w_in = in[6];
  p.sgu_norm = in[7]; p.w_sgu = in[8]; p.b_sgu = in[9]; p.q_lora_norm = in[10]; p.w_uq = in[11]; p.kv_lora_norm = in[12];
  p.w_ukv = in[13]; p.q_norm = in[14]; p.k_norm = in[15]; p.w_out = in[16]; p.w_router = in[17]; p.w_gate = in[18];
  p.w_up = in[19]; p.w_down = in[20];
  p.out = (float*)d_out;
  unsigned char* base = (unsigned char*)d_ws;
  size_t off = 0;
  auto alloc = [&](size_t bytes) { void* r = base + off; off += (bytes + 255) & ~(size_t)255; return r; };
  p.bar = (unsigned*)alloc(16384);
  p.mada = (float*)alloc((size_t)2 * 3 * 6144 * 4);
  p.WinT = (u16*)alloc((size_t)2 * 1536 * 1024 * 2);
  p.WuqT = (u16*)alloc((size_t)2 * 768 * 256 * 2);
  p.WukvT = (u16*)alloc((size_t)2 * 1024 * 128 * 2);
  p.WoutT = (u16*)alloc((size_t)2 * 1024 * 1024 * 2);
  p.WguT = (u16*)alloc((size_t)2 * 16 * 1024 * 1024 * 2);
  p.WdT = (u16*)alloc((size_t)2 * 16 * 1024 * 512 * 2);
  p.Wsgu = (u16*)alloc((size_t)2 * 4 * 128 * 128 * 2);
  p.M1 = (u16*)alloc((size_t)128 * 128 * 128 * 2);
  p.M2 = (u16*)alloc((size_t)128 * 256 * 2);
  p.Mc = (u16*)alloc((size_t)256 * 512 * 2);
  p.XC = (float*)alloc((size_t)T_CTX * DM * 4);
  p.AFFT = (float*)alloc((size_t)(32 * SEQ + 32 * CTX) * 4);
  p.GATE = (float*)alloc((size_t)64 * 1024 * 4);
  p.IDXG = (int*)alloc((size_t)64 * 1024 * 4);
  p.INV = (int*)alloc((size_t)TT * 16 * 4);
  p.WR2 = (float*)alloc((size_t)2 * 3 * 16384 * 4);
  p.CE = (float*)alloc((size_t)96 * 4);
  p.GDc = (u16*)alloc((size_t)2 * 2 * CTX * 256 * 2);
  unsigned char* RH = (unsigned char*)alloc((size_t)TT * 1024 * 2);
  p.H = (u16*)RH;
  p.PF = (u16*)RH;
  p.KN = (u16*)(RH + (size_t)2 * 64 * 2 * 128 * 256 * 2);
  p.PX = (u16*)alloc((size_t)TT * 1024 * 2);
  p.YM = (u16*)alloc((size_t)TT * 1024 * 2);
  unsigned char* RA = (unsigned char*)alloc((size_t)2 * 4 * NPOS * 192 * 2);
  unsigned char* RB = (unsigned char*)alloc((size_t)2 * 4 * NPOS * 192 * 2);
  p.GD = (u16*)RA;
  p.Qall = (u16*)RA;
  p.Kb = (u16*)RB;
  p.QR = (u16*)alloc((size_t)TT * 768 * 2);
  p.HID = p.QR;
  p.YB = p.PX;
  p.Vt = (u16*)alloc((size_t)2 * 4 * 128 * NPOS * 2);
  if (off > ws_size) fprintf(stderr, "workspace too small: need %zu have %zu\n", off, ws_size);

  hipMemsetAsync(p.bar, 0, 16384, stream);
  void* args[] = {&p};
  hipError_t e = hipLaunchCooperativeKernel((void*)fwd_megakernel, dim3(grid_blocks), dim3(256), args, 0, stream);
  if (e != hipSuccess) fprintf(stderr, "cooperative launch failed: %s (grid %d)\n", hipGetErrorString(e), grid_blocks);
}
```

```cpp
#include <hip/hip_runtime.h>
#include <hip/hip_cooperative_groups.h>
#include <stdint.h>
#include <stdio.h>
namespace cg = cooperative_groups;

typedef unsigned short u16;
typedef __attribute__((ext_vector_type(8))) short bf16x8;
typedef __attribute__((ext_vector_type(4))) float f32x4;
typedef unsigned __attribute__((ext_vector_type(4))) u32x4;
typedef unsigned __attribute__((ext_vector_type(2))) u32x2;

constexpr int DM = 1024;
constexpr int SEQ = 8192, CTX = 256;
constexpr int T_LAT = 2 * SEQ, T_CTX = 2 * CTX, TT = T_LAT + T_CTX;
constexpr int NPOS = SEQ + CTX;
constexpr int SMEM_BYTES = 71680;

struct Params {
  const float *x, *c, *ctx, *c_ctx, *w_ada, *b_ada, *w_in, *sgu_norm, *w_sgu, *b_sgu, *q_lora_norm, *w_uq,
      *kv_lora_norm, *w_ukv, *q_norm, *k_norm, *w_out, *w_router, *w_gate, *w_up, *w_down;
  float* out;
  unsigned* bar;
  float* mada;
  u16 *WinT, *WuqT, *WukvT, *WoutT, *WguT, *WdT, *Wsgu, *M1, *M2, *Mc;
  float* XC;
  u16 *H, *PX, *YM, *GD, *GDc, *PF, *QR, *KN, *Vt, *Qall, *Kb, *HID;
  float *AFFT, *GATE, *WR2, *CE;
  int *IDXG, *INV;
  u16* YB;
};

typedef float f32x2_t __attribute__((ext_vector_type(2)));
typedef __bf16 bf16x2_t __attribute__((ext_vector_type(2)));
__device__ __forceinline__ unsigned pack2(float a, float b) {
  f32x2_t v = {a, b};
  bf16x2_t r = __builtin_convertvector(v, bf16x2_t);
  return __builtin_bit_cast(unsigned, r);
}
__device__ __forceinline__ u16 f2bf(float f) { return (u16)(pack2(f, 0.f) & 0xffffu); }
__device__ __forceinline__ float bf2f(u16 b) { return __uint_as_float(((unsigned)b) << 16); }
__device__ __forceinline__ float wave_sum(float v) {
#pragma unroll
  for (int o = 32; o; o >>= 1) v += __shfl_xor(v, o);
  return v;
}
__device__ __forceinline__ int tid_() { int t = threadIdx.x; asm volatile("" : "+v"(t)); return t; }
__device__ __forceinline__ const struct Params* launder_(const struct Params* q) { asm volatile("" : "+s"(q)); return q; }
__device__ __forceinline__ int bid_() { int b = blockIdx.x; asm volatile("" : "+s"(b)); return b; }
__device__ __forceinline__ float gelu_tanh(float x) {
  float y = 0.7978845608028654f * (x + 0.044715f * x * x * x);
  return x / (1.f + __expf(-2.f * y));
}
__device__ __forceinline__ float silu_f(float x) { return x / (1.f + __expf(-x)); }

#define XB_TMO 128
#define XB_XCNT(j) (256 + 64 * (j))
#define XB_XSUB(j) (1280 + 64 * (j))
#define XB_XGEN(j) (2304 + 64 * (j))
#define XB_TOP 3328
#define XB_TOPGEN 3392
#define XCD_BAR_WORDS 3456
#define XB_SPIN_CAP (1u << 22)
#define LAS __attribute__((address_space(3)))

__device__ __forceinline__ unsigned xb_ld(unsigned* p) { return __hip_atomic_load(p, __ATOMIC_RELAXED, __HIP_MEMORY_SCOPE_AGENT); }
__device__ __forceinline__ unsigned xb_add(unsigned* p, unsigned v) { return __hip_atomic_fetch_add(p, v, __ATOMIC_RELAXED, __HIP_MEMORY_SCOPE_AGENT); }
__device__ __forceinline__ unsigned xb_xcc_id() { return (unsigned)__builtin_amdgcn_s_getreg((3 << 11) | 20) & 0xFu; }
#define XB_SPIN(cond, bar)                                            \
  do {                                                                \
    unsigned _sp = 0;                                                 \
    while (cond) {                                                    \
      __builtin_amdgcn_s_sleep(1);                                    \
      if ((++_sp & 255u) == 0u) {                                     \
        if (xb_ld(&(bar)[XB_TMO])) break;                             \
        if (_sp > XB_SPIN_CAP) { atomicAdd(&(bar)[XB_TMO], 1u); break; } \
      }                                                               \
    }                                                                 \
  } while (0)

struct XcdBarrier {
  unsigned* bar;
  unsigned x;
  volatile LAS unsigned* st;
};
__device__ __forceinline__ XcdBarrier xcd_barrier_post(unsigned* bar, volatile LAS unsigned* st) {
  XcdBarrier b;
  b.bar = bar;
  b.x = xb_xcc_id();
  b.st = st;
  if (threadIdx.x == 0) (void)xb_add(&bar[XB_XCNT(b.x)], 1u);
  return b;
}
__device__ __forceinline__ void xcd_barrier_complete(unsigned* bar, unsigned x, unsigned& nloc, unsigned& nx) {
  const unsigned G = gridDim.x * gridDim.y * gridDim.z;
  unsigned sum, cnt, mine, sp = 0u;
  for (;;) {
    sum = 0u; cnt = 0u; mine = 0u;
#pragma unroll
    for (unsigned j = 0; j < 16; ++j) {
      const unsigned c = xb_ld(&bar[XB_XCNT(j)]);
      sum += c; cnt += (c > 0u) ? 1u : 0u; mine = (j == x) ? c : mine;
    }
    if (sum == G) break;
    __builtin_amdgcn_s_sleep(1);
    if ((++sp & 255u) == 0u) {
      if (xb_ld(&bar[XB_TMO])) break;
      if (sp > XB_SPIN_CAP) { atomicAdd(&bar[XB_TMO], 1u); break; }
    }
  }
  nloc = mine > 0u ? mine : 1u;
  nx = cnt > 0u ? cnt : 1u;
}
__device__ __forceinline__ void xcd_barrier(const XcdBarrier& b) {
  asm volatile("s_waitcnt vmcnt(0)" ::: "memory");
  __syncthreads();
  if (threadIdx.x == 0) {
    unsigned* bar = b.bar;
    __builtin_amdgcn_s_waitcnt(0);
    unsigned nloc = b.st[0], nx = b.st[1];
    if (nloc == 0u) { xcd_barrier_complete(bar, b.x, nloc, nx); b.st[0] = nloc; b.st[1] = nx; }
    const unsigned old = xb_add(&bar[XB_XSUB(b.x)], 1u);
    const unsigned gen = old / nloc;
    if (old + 1u == (gen + 1u) * nloc) {
      __builtin_amdgcn_fence(__ATOMIC_RELEASE, "agent");
      asm volatile("s_waitcnt vmcnt(0)" ::: "memory");
      const unsigned og = xb_add(&bar[XB_TOP], 1u);
      const unsigned tg = og / nx;
      if (og + 1u == (tg + 1u) * nx) xb_add(&bar[XB_TOPGEN], 1u);
      else XB_SPIN(xb_ld(&bar[XB_TOPGEN]) == tg, bar);
      __builtin_amdgcn_fence(__ATOMIC_ACQUIRE, "agent");
      xb_add(&bar[XB_XGEN(b.x)], 1u);
      asm volatile("s_waitcnt vmcnt(0)" ::: "memory");
    } else {
      XB_SPIN(xb_ld(&bar[XB_XGEN(b.x)]) == gen, bar);
      __builtin_amdgcn_fence(__ATOMIC_ACQUIRE, "agent");
      asm volatile("s_waitcnt vmcnt(0)" ::: "memory");
    }
  }
  __syncthreads();
}

#define XCD_FOR(u, T)                                                                                         \
  for (int _x = bid_() & 7, _gb = gridDim.x >> 3, _hi = (int)(((long)(_x + 1) * (T)) >> 3),                    \
           u = (int)(((long)_x * (T)) >> 3) + (bid_() >> 3);                                                  \
       u < _hi; u += _gb)

template <int NT, bool BKN, bool MASK = false, bool ROWSS = false, class Epi>
__device__ __forceinline__ void gemm_tile(const u16* __restrict__ A, int lda, const int* __restrict__ arows, int mvalid,
                                          const u16* __restrict__ B, int ldb, int K, unsigned char* smem, Epi epi,
                                          const float* ascale = nullptr) {
  constexpr int BN = NT * 32;
  constexpr int CPR = BN / 8;
  u16* S0 = (u16*)smem;
  const int t = tid_(), lane = t & 63, wid = t >> 6, wr = wid >> 1, wc = wid & 1, l16 = lane & 15, quad = lane >> 4;
  const u16* ap[4];
  const u16* bp[NT];
  unsigned amask = 0u;
#pragma unroll
  for (int i = 0; i < 4; ++i) {
    const int row = (t >> 3) + 32 * i;
    const bool v = MASK ? (row < mvalid) : true;
    amask |= v ? (1u << i) : 0u;
    int r = v ? row : 0;
    if (arows) r = arows[r];
    ap[i] = A + (size_t)r * lda + (t & 7) * 8;
  }
#pragma unroll
  for (int i = 0; i < NT; ++i) {
    if (!BKN) bp[i] = B + (size_t)((t >> 3) + 32 * i) * ldb + (t & 7) * 8;
    else { const int c = t + 256 * i; bp[i] = B + (size_t)(c / CPR) * ldb + (c % CPR) * 8; }
  }
  const size_t bstep = BKN ? (size_t)64 * ldb : (size_t)64;
  int nmi = 4;
  if (MASK) { nmi = (mvalid - wr * 64 + 15) >> 4; nmi = nmi < 0 ? 0 : (nmi > 4 ? 4 : nmi); nmi = __builtin_amdgcn_readfirstlane(nmi); }
  u32x4 ra0[4], rb0[NT], ra1[4], rb1[NT];
#define GEMM_LOAD(RA, RB, kt_)                                                                      \
  {                                                                                                 \
    _Pragma("unroll") for (int i = 0; i < 4; ++i) {                                                 \
      RA[i] = *(const u32x4*)(ap[i] + (size_t)(kt_) * 64);                                          \
      if (MASK && !((amask >> i) & 1u)) RA[i] = (u32x4){0u, 0u, 0u, 0u};                            \
    }                                                                                               \
    _Pragma("unroll") for (int i = 0; i < NT; ++i) RB[i] = *(const u32x4*)(bp[i] + (size_t)(kt_) * bstep); \
  }
#define GEMM_STORE(RA, RB, st_)                                                                     \
  {                                                                                                 \
    u16* As_ = S0 + (st_) * 16384;                                                                  \
    u16* Bs_ = As_ + 8192;                                                                          \
    if (ROWSS) {                                                                                    \
      _Pragma("unroll") for (int i = 0; i < 4; ++i) {                                               \
        const u32x4 w_ = RA[i];                                                                     \
        const float a0 = __uint_as_float(w_.x << 16), a1 = __uint_as_float(w_.x & 0xffff0000u);     \
        const float a2 = __uint_as_float(w_.y << 16), a3 = __uint_as_float(w_.y & 0xffff0000u);     \
        const float a4 = __uint_as_float(w_.z << 16), a5 = __uint_as_float(w_.z & 0xffff0000u);     \
        const float a6 = __uint_as_float(w_.w << 16), a7 = __uint_as_float(w_.w & 0xffff0000u);     \
        ss_[i] += (a0 * a0 + a1 * a1) + (a2 * a2 + a3 * a3) + (a4 * a4 + a5 * a5) + (a6 * a6 + a7 * a7); \
      }                                                                                             \
    }                                                                                               \
    if (ascale) {                                                                                   \
      const float* sc_ = ascale + stk_ * 64 + (t & 7) * 8;                                          \
      const float4 s0_ = *(const float4*)(sc_), s1_ = *(const float4*)(sc_ + 4);                    \
      _Pragma("unroll") for (int i = 0; i < 4; ++i) {                                               \
        u32x4 w_ = RA[i];                                                                           \
        w_.x = pack2(__uint_as_float(w_.x << 16) * s0_.x, __uint_as_float(w_.x & 0xffff0000u) * s0_.y); \
        w_.y = pack2(__uint_as_float(w_.y << 16) * s0_.z, __uint_as_float(w_.y & 0xffff0000u) * s0_.w); \
        w_.z = pack2(__uint_as_float(w_.z << 16) * s1_.x, __uint_as_float(w_.z & 0xffff0000u) * s1_.y); \
        w_.w = pack2(__uint_as_float(w_.w << 16) * s1_.z, __uint_as_float(w_.w & 0xffff0000u) * s1_.w); \
        RA[i] = w_;                                                                                 \
      }                                                                                             \
    }                                                                                               \
    ++stk_;                                                                                         \
    _Pragma("unroll") for (int i = 0; i < 4; ++i) {                                                 \
      const int row = (t >> 3) + 32 * i;                                                            \
      *(u32x4*)(As_ + row * 64 + (((t & 7) ^ ((row >> 1) & 7)) << 3)) = RA[i];                      \
    }                                                                                               \
    if (!BKN) {                                                                                     \
      _Pragma("unroll") for (int i = 0; i < NT; ++i) {                                              \
        const int row = (t >> 3) + 32 * i;                                                          \
        *(u32x4*)(Bs_ + row * 64 + (((t & 7) ^ ((row >> 1) & 7)) << 3)) = RB[i];                    \
      }                                                                                             \
    } else {                                                                                        \
      _Pragma("unroll") for (int i = 0; i < NT; ++i) {                                              \
        const int c = t + 256 * i;                                                                  \
        const int k = c / CPR, n8 = (c % CPR) * 8;                                                  \
        const u32x4 w = RB[i];                                                                      \
        const unsigned e[8] = {w.x & 0xffffu, w.x >> 16, w.y & 0xffffu, w.y >> 16, w.z & 0xffffu, w.z >> 16, w.w & 0xffffu, w.w >> 16}; \
        _Pragma("unroll") for (int j = 0; j < 8; ++j) {                                             \
          const int n = n8 + j;                                                                     \
          Bs_[n * 64 + ((((k >> 3) ^ ((n >> 1) & 7))) << 3) + (k & 7)] = (u16)e[j];                 \
        }                                                                                           \
      }                                                                                             \
    }                                                                                               \
  }
#define GEMM_COMPUTE(st_)                                                                           \
  {                                                                                                 \
    const u16* As_ = S0 + (st_) * 16384;                                                            \
    const u16* Bs_ = As_ + 8192;                                                                    \
    _Pragma("unroll") for (int ks = 0; ks < 2; ++ks) {                                              \
      bf16x8 af[4], bfr[NT];                                                                        \
      _Pragma("unroll") for (int mi = 0; mi < 4; ++mi) {                                            \
        const int row = wr * 64 + mi * 16 + l16;                                                    \
        af[mi] = *(const bf16x8*)(As_ + row * 64 + (((ks * 4 + quad) ^ ((row >> 1) & 7)) << 3));    \
      }                                                                                             \
      _Pragma("unroll") for (int ni = 0; ni < NT; ++ni) {                                           \
        const int row = wc * (BN / 2) + ni * 16 + l16;                                              \
        bfr[ni] = *(const bf16x8*)(Bs_ + row * 64 + (((ks * 4 + quad) ^ ((row >> 1) & 7)) << 3));   \
      }                                                                                             \
      _Pragma("unroll") for (int mi = 0; mi < 4; ++mi)                                              \
        if (!MASK || mi < nmi)                                                                      \
        _Pragma("unroll") for (int ni = 0; ni < NT; ++ni) acc[mi][ni] = __builtin_amdgcn_mfma_f32_16x16x32_bf16(af[mi], bfr[ni], acc[mi][ni], 0, 0, 0); \
    }                                                                                               \
  }
  float ss_[4] = {0.f, 0.f, 0.f, 0.f};
  int stk_ = 0;
  f32x4 acc[4][NT];
#pragma unroll
  for (int i = 0; i < 4; ++i)
#pragma unroll
    for (int j = 0; j < NT; ++j) acc[i][j] = (f32x4){0.f, 0.f, 0.f, 0.f};
  const int nk = K >> 6;
  const int nkm1 = nk - 1;
  __syncthreads();
  GEMM_LOAD(ra0, rb0, 0);
  GEMM_LOAD(ra1, rb1, 1);
  GEMM_STORE(ra0, rb0, 0);
  GEMM_LOAD(ra0, rb0, (2 < nkm1 ? 2 : nkm1));
  __syncthreads();
  for (int kt = 0; kt < nk - 2; kt += 2) {
    GEMM_COMPUTE(0);
    GEMM_STORE(ra1, rb1, 1);
    GEMM_LOAD(ra1, rb1, kt + 3);
    __syncthreads();
    GEMM_COMPUTE(1);
    GEMM_STORE(ra0, rb0, 0);
    GEMM_LOAD(ra0, rb0, (kt + 4 < nkm1 ? kt + 4 : nkm1));
    __syncthreads();
  }
  GEMM_COMPUTE(0);
  GEMM_STORE(ra1, rb1, 1);
  __syncthreads();
  GEMM_COMPUTE(1);
#undef GEMM_LOAD
#undef GEMM_STORE
#undef GEMM_COMPUTE
  if (ROWSS) {
    float* rs = (float*)(smem + 65536);
#pragma unroll
    for (int i = 0; i < 4; ++i) {
      float s = ss_[i];
      s += __shfl_xor(s, 1); s += __shfl_xor(s, 2); s += __shfl_xor(s, 4);
      if ((t & 7) == 0) rs[(t >> 3) + 32 * i] = rsqrtf(s / (float)K + 1e-6f);
    }
    __syncthreads();
  }
  epi(acc, wr * 64 + quad * 4, wc * (BN / 2) + l16);
}

template <int NT, class VF, class RP>
__device__ __forceinline__ void epi_staged_bf16(f32x4 (&acc)[4][NT], int r0, int c0, unsigned char* smem, VF vf, RP rowptr) {
  constexpr int BN = NT * 32, PITCH = BN + 8, CPR = BN / 8;
  u16* Ts = (u16*)smem;
  const int t = tid_();
  __syncthreads();
#pragma unroll
  for (int mi = 0; mi < 4; ++mi)
#pragma unroll
    for (int ni = 0; ni < NT; ++ni)
#pragma unroll
      for (int j = 0; j < 4; ++j) {
        const int r = r0 + mi * 16 + j, c = c0 + ni * 16;
        Ts[r * PITCH + c] = f2bf(vf(r, c, acc[mi][ni][j]));
      }
  __syncthreads();
#pragma unroll
  for (int i = 0; i < CPR / 2; ++i) {
    const int c = t + 256 * i, row = c / CPR, ch = c % CPR;
    u16* d = rowptr(row);
    if (d) *(u32x4*)(d + ch * 8) = *(const u32x4*)(Ts + row * PITCH + ch * 8);
  }
}

template <class RP>
__device__ __forceinline__ void epi_staged_bf16_T(f32x4 (&acc)[4][4], int r0, int c0, unsigned char* smem, RP colptr) {
  constexpr int PITCH = 136;
  u16* Ts = (u16*)smem;
  const int t = tid_();
  __syncthreads();
#pragma unroll
  for (int mi = 0; mi < 4; ++mi)
#pragma unroll
    for (int ni = 0; ni < 4; ++ni) {
      u32x2 pk;
      pk.x = pack2(acc[mi][ni][0], acc[mi][ni][1]);
      pk.y = pack2(acc[mi][ni][2], acc[mi][ni][3]);
      *(u32x2*)(Ts + (c0 + ni * 16) * PITCH + r0 + mi * 16) = pk;
    }
  __syncthreads();
#pragma unroll
  for (int i = 0; i < 8; ++i) {
    const int c = t + 256 * i, col = c >> 4, ch = c & 15;
    *(u32x4*)(colptr(col) + ch * 8) = *(const u32x4*)(Ts + col * PITCH + ch * 8);
  }
}

__device__ __forceinline__ void epi_staged_residual(f32x4 (&acc)[4][4], int r0, int c0, unsigned char* smem, const float* __restrict__ g,
                                                    const float* __restrict__ xs, float* __restrict__ xd) {
  constexpr int PITCH = 132;
  float* Ts = (float*)smem;
  const int t = tid_();
  const int wr = r0 >> 6;
#pragma unroll
  for (int pass = 0; pass < 2; ++pass) {
    __syncthreads();
    if (wr == pass) {
#pragma unroll
      for (int mi = 0; mi < 4; ++mi)
#pragma unroll
        for (int ni = 0; ni < 4; ++ni)
#pragma unroll
          for (int j = 0; j < 4; ++j) Ts[((r0 & 63) + mi * 16 + j) * PITCH + c0 + ni * 16] = acc[mi][ni][j];
    }
    __syncthreads();
#pragma unroll
    for (int i = 0; i < 8; ++i) {
      const int c = t + 256 * i, row = c >> 5, ch = c & 31;
      const float4 a = *(const float4*)(Ts + row * PITCH + ch * 4);
      const float4 gg = *(const float4*)(g + ch * 4);
      const size_t o = (size_t)(pass * 64 + row) * DM + ch * 4;
      float4 x = *(const float4*)(xs + o);
      x.x += gg.x * a.x; x.y += gg.y * a.y; x.z += gg.z * a.z; x.w += gg.w * a.w;
      *(float4*)(xd + o) = x;
    }
  }
}

__device__ __forceinline__ void ada_item(const Params& p, int it, unsigned char* smem) {
  float* sc = (float*)smem;
  float* red = sc + 3072;
  const int t = tid_(), lane = t & 63, wid = t >> 6;
  const int l = it / 96, jc = it % 96;
#pragma unroll
  for (int i = 0; i < 12; ++i) {
    const int idx = t + 256 * i, r = idx >> 10, k = idx & 1023;
    const float cv = r < 2 ? p.c[r * 1024 + k] : p.c_ctx[k];
    sc[idx] = silu_f(cv);
  }
  __syncthreads();
  const float* w = p.w_ada + (size_t)l * 1024 * 6144 + jc * 64 + lane;
  float a0 = 0.f, a1 = 0.f, a2 = 0.f;
  const int kb = wid * 256;
#pragma unroll 8
  for (int k = 0; k < 256; ++k) {
    const float wv = w[(size_t)(kb + k) * 6144];
    a0 += sc[kb + k] * wv;
    a1 += sc[1024 + kb + k] * wv;
    a2 += sc[2048 + kb + k] * wv;
  }
  red[(wid * 3 + 0) * 64 + lane] = a0;
  red[(wid * 3 + 1) * 64 + lane] = a1;
  red[(wid * 3 + 2) * 64 + lane] = a2;
  __syncthreads();
  if (t < 192) {
    const int r = t >> 6, ln = t & 63;
    float s = 0.f;
#pragma unroll
    for (int w4 = 0; w4 < 4; ++w4) s += red[(w4 * 3 + r) * 64 + ln];
    s += p.b_ada[l * 6144 + jc * 64 + ln];
    p.mada[(l * 3 + r) * 6144 + jc * 64 + ln] = s;
  }
  asm volatile("s_waitcnt vmcnt(0)" ::: "memory");
  __syncthreads();
  if (t == 0) {
    __builtin_amdgcn_fence(__ATOMIC_RELEASE, "agent");
    asm volatile("s_waitcnt vmcnt(0)" ::: "memory");
    (void)xb_add(&p.bar[64], 1u);
  }
}

__device__ __forceinline__ void fold_item(const Params& p, int it, unsigned char* smem) {
  float* tile = (float*)smem;
  float* ct = tile + 64 * 65;
  const int t = tid_();
  const int l = it >> 6, rem = it & 63, g = rem >> 4, k0 = (rem & 15) * 64;
#pragma unroll
  for (int i = 0; i < 16; ++i) {
    const int kk = i * 4 + (t >> 6), d = t & 63;
    tile[kk * 65 + d] = p.w_in[(size_t)(l * 1024 + k0 + kk) * 1216 + 512 + g * 64 + d];
  }
  if (t < 64) ct[t] = cospif((float)t / 32.f);
  __syncthreads();
  const int k = t & 63, jg = t >> 6;
  u16* dst = p.WinT + (size_t)l * 1536 * 1024;
  for (int jj = 0; jj < 16; ++jj) {
    const int j = jg + 4 * jj;
    float sr = 0.f, si = 0.f;
#pragma unroll 8
    for (int d = 0; d < 64; ++d) {
      const float v = tile[k * 65 + d];
      const int m = (j * d) & 63;
      sr += v * ct[m];
      si += v * ct[(m - 16) & 63];
    }
    dst[(size_t)(512 + g * 64 + j) * 1024 + k0 + k] = f2bf(sr);
    dst[(size_t)(768 + g * 64 + j) * 1024 + k0 + k] = f2bf(-si);
  }
  __syncthreads();
}

__device__ __forceinline__ void convT_tile(const float* __restrict__ src, int lds, int k0, int c0, u16* __restrict__ dst, int Kd,
                                           int rbase, int mode, int which, unsigned char* smem, const float* __restrict__ kscale = nullptr) {
  float* tile = (float*)smem;
  const int t = tid_();
  float4 v4[4];
#pragma unroll
  for (int i = 0; i < 4; ++i) v4[i] = *(const float4*)(src + (size_t)(k0 + i * 16 + (t >> 4)) * lds + c0 + (t & 15) * 4);
#pragma unroll
  for (int i = 0; i < 4; ++i) {
    const int kk = i * 16 + (t >> 4), cc = (t & 15) * 4;
    const float sc = kscale ? kscale[k0 + kk] : 1.f;
    tile[kk * 65 + cc + 0] = v4[i].x * sc; tile[kk * 65 + cc + 1] = v4[i].y * sc;
    tile[kk * 65 + cc + 2] = v4[i].z * sc; tile[kk * 65 + cc + 3] = v4[i].w * sc;
  }
  __syncthreads();
#pragma unroll
  for (int i = 0; i < 16; ++i) {
    const int cc = i * 4 + (t >> 6), kk = t & 63;
    int row;
    if (mode == 0) row = rbase + cc;
    else { const int f = c0 + cc; row = (((f >> 4) * 2 + which) << 4) + (f & 15); }
    dst[(size_t)row * Kd + k0 + kk] = f2bf(tile[kk * 65 + cc]);
  }
  __syncthreads();
}

__device__ __forceinline__ void conv_item(const Params& p, int it, unsigned char* smem) {
  const int l = it / 6720;
  int r = it % 6720;
  if (r < 240) {
    const int ct = r >> 4, kt = r & 15;
    const int c0 = (ct < 8 ? ct : ct + 4) * 64;
    const int n0 = c0 + (c0 >= 768 ? 256 : 0);
    convT_tile(p.w_in + (size_t)l * 1024 * 1216, 1216, kt * 64, c0, p.WinT + (size_t)l * 1536 * 1024, 1024, n0, 0, 0, smem);
    return;
  }
  r -= 240;
  if (r < 48) {
    const int ct = r >> 2, kt = r & 3;
    convT_tile(p.w_uq + (size_t)l * 256 * 768, 768, kt * 64, ct * 64, p.WuqT + (size_t)l * 768 * 256, 256, ct * 64, 0, 0, smem, p.q_lora_norm + l * 256);
    return;
  }
  r -= 48;
  if (r < 32) {
    const int ct = r >> 1, kt = r & 1;
    convT_tile(p.w_ukv + (size_t)l * 128 * 1024, 1024, kt * 64, ct * 64, p.WukvT + (size_t)l * 1024 * 128, 128, ct * 64, 0, 0, smem, p.kv_lora_norm + l * 128);
    return;
  }
  r -= 32;
  if (r < 256) {
    const int ct = r >> 4, kt = r & 15;
    convT_tile(p.w_out + (size_t)l * 1024 * 1024, 1024, kt * 64, ct * 64, p.WoutT + (size_t)l * 1024 * 1024, 1024, ct * 64, 0, 0, smem);
    return;
  }
  r -= 256;
  if (r < 4096) {
    const int which = r >> 11, r2 = r & 2047, e = r2 >> 7, r3 = r2 & 127, ct = r3 >> 4, kt = r3 & 15;
    const float* src = (which ? p.w_up : p.w_gate) + (size_t)(l * 16 + e) * 1024 * 512;
    convT_tile(src, 512, kt * 64, ct * 64, p.WguT + (size_t)(l * 16 + e) * 1024 * 1024, 1024, 0, 1, which, smem);
    return;
  }
  r -= 4096;
  {
    const int e = r >> 7, r3 = r & 127, ct = r3 >> 3, kt = r3 & 7;
    convT_tile(p.w_down + (size_t)(l * 16 + e) * 512 * 1024, 1024, kt * 64, ct * 64, p.WdT + (size_t)(l * 16 + e) * 1024 * 512, 512, ct * 64, 0, 0, smem);
  }
}

__device__ __forceinline__ void elem_item(const Params& p, int it) {
  const int t = tid_();
  if (it < 128) {
#pragma unroll
    for (int i = 0; i < 4; ++i) { const int idx = it * 1024 + i * 256 + t; p.Wsgu[idx] = f2bf(p.w_sgu[idx]); }
    return;
  }
  it -= 128;
  if (it < 2048) {
#pragma unroll
    for (int i = 0; i < 4; ++i) {
      const int idx = it * 1024 + i * 256 + t;
      const int n1 = idx >> 14, m = (idx >> 7) & 127, kk = idx & 127;
      const int rip = m >> 6, k2 = m & 63, ri = kk >> 6, n2 = kk & 63;
      const int n = n1 + 128 * n2;
      const int ph = (k2 * n) & 8191;
      const float xx = (float)ph / 4096.f;
      const float cs = cospif(xx), sn = sinpif(xx);
      const float v = rip == 0 ? (ri == 0 ? cs : sn) : (ri == 0 ? -sn : cs);
      p.M1[idx] = f2bf(v);
    }
    return;
  }
  it -= 2048;
  if (it < 32) {
#pragma unroll
    for (int i = 0; i < 4; ++i) {
      const int idx = it * 1024 + i * 256 + t;
      const int k1 = idx >> 8, kk = idx & 255, ri = kk >> 7, n1 = kk & 127;
      const int ph = (k1 * n1) & 127;
      const float xx = (float)ph / 64.f;
      p.M2[idx] = f2bf(ri ? sinpif(xx) : cospif(xx));
    }
    return;
  }
  it -= 32;
  {
#pragma unroll
    for (int i = 0; i < 4; ++i) {
      const int idx = it * 1024 + i * 256 + t;
      const int k = idx >> 9, kk = idx & 511, ri = kk >> 8, n = kk & 255;
      const int ph = (k * n) & 255;
      const float xx = (float)ph / 128.f;
      p.Mc[idx] = f2bf(ri ? sinpif(xx) : cospif(xx));
    }
  }
}

__device__ __forceinline__ void phase_prep(const Params& p, unsigned char* smem) {
  const int G = gridDim.x;
  int t = bid_();
  for (; t < 192; t += G) ada_item(p, t, smem);
  t -= 192;
  for (; t < 128; t += G) fold_item(p, t, smem);
  t -= 128;
  for (; t < 13440; t += G) conv_item(p, t, smem);
  t -= 13440;
  for (; t < 2336; t += G) elem_item(p, t);
}

__device__ __forceinline__ int row_cond(int row) { return row < T_LAT ? (row >> 13) : 2; }
__device__ __forceinline__ int row_batch(int row) { return row < T_LAT ? (row >> 13) : ((row - T_LAT) >> 8); }
__device__ __forceinline__ int row_pos(int row) { return row < T_LAT ? (CTX + (row & (SEQ - 1))) : ((row - T_LAT) & (CTX - 1)); }

template <int R>
__device__ __forceinline__ void phase_modulate(const Params& p, int l, const float* xlat, const float* xctx, int nrows, int chunk, int bskip) {
  const int t = tid_(), lane = t & 63, wid = t >> 6;
  const int bb = bid_() - bskip;
  if (bb < 0) return;
  const int gw = bb * 4 + wid, nw = ((int)gridDim.x - bskip) * 4;
  for (int row0 = gw * R; row0 < nrows; row0 += nw * R) {
    const float* xr = row0 < T_LAT ? xlat + (size_t)row0 * DM : xctx + (size_t)(row0 - T_LAT) * DM;
    const float* sh = p.mada + (size_t)(l * 3 + row_cond(row0)) * 6144 + chunk * 1024;
    const float* sc = sh + 1024;
    float4 v[R][4];
#pragma unroll
    for (int r = 0; r < R; ++r)
#pragma unroll
      for (int i = 0; i < 4; ++i) v[r][i] = *(const float4*)(xr + (size_t)r * DM + i * 256 + lane * 4);
    float rstd[R];
#pragma unroll
    for (int r = 0; r < R; ++r) {
      float ss = 0.f;
#pragma unroll
      for (int i = 0; i < 4; ++i) ss += v[r][i].x * v[r][i].x + v[r][i].y * v[r][i].y + v[r][i].z * v[r][i].z + v[r][i].w * v[r][i].w;
      ss = wave_sum(ss);
      rstd[r] = rsqrtf(ss * (1.f / 1024.f) + 1e-6f);
    }
#pragma unroll
    for (int i = 0; i < 4; ++i) {
      const int col = i * 256 + lane * 4;
      const float4 s4 = *(const float4*)(sc + col);
      const float4 h4 = *(const float4*)(sh + col);
#pragma unroll
      for (int r = 0; r < R; ++r) {
        u32x2 pk;
        pk.x = pack2(v[r][i].x * rstd[r] * (1.f + s4.x) + h4.x, v[r][i].y * rstd[r] * (1.f + s4.y) + h4.y);
        pk.y = pack2(v[r][i].z * rstd[r] * (1.f + s4.z) + h4.z, v[r][i].w * rstd[r] * (1.f + s4.w) + h4.w);
        *(u32x2*)(p.H + (size_t)(row0 + r) * DM + col) = pk;
      }
    }
  }
}

__device__ __forceinline__ void phase_router_prep(const Params& p) {
  const int t = tid_(), lane = t & 63, wid = t >> 6;
  for (int i = bid_() * 256 + t; i < 2 * 3 * 16384; i += gridDim.x * 256) {
    const int lc = i >> 14, k = (i >> 4) & 1023, e = i & 15, l = lc / 3;
    p.WR2[i] = (1.f + p.mada[(size_t)lc * 6144 + 4 * 1024 + k]) * p.w_router[(size_t)l * 16384 + k * 16 + e];
  }
  for (int o = bid_() * 4 + wid; o < 96; o += gridDim.x * 4) {
    const int lc = o >> 4, e = o & 15, l = lc / 3;
    float s = 0.f;
    for (int k = lane; k < 1024; k += 64) s += p.mada[(size_t)lc * 6144 + 3 * 1024 + k] * p.w_router[(size_t)l * 16384 + k * 16 + e];
    s = wave_sum(s);
    if (lane == 0) p.CE[o] = s;
  }
}

__device__ __forceinline__ void phase_router(const Params& p, int l, const float* xlat, const float* xctx, int nrows) {
  const int t = tid_(), lane = t & 63, wid = t >> 6, l16 = lane & 15, quad = lane >> 4;
  const int gw = bid_() * 4 + wid, nw = gridDim.x * 4;
  const int ntile = nrows >> 4;
  for (int tile = gw; tile < ntile; tile += nw) {
    const int row0 = tile * 16;
    const int cond = row_cond(row0);
    const float* xr = (row0 < T_LAT ? xlat + (size_t)(row0 + l16) * DM : xctx + (size_t)(row0 - T_LAT + l16) * DM) + quad * 4;
    const float* wp = p.WR2 + (size_t)(l * 3 + cond) * 16384 + quad * 64 + l16;
    f32x4 acc = (f32x4){0.f, 0.f, 0.f, 0.f};
    float ss = 0.f;
#pragma unroll 4
    for (int s = 0; s < 64; ++s) {
      const float4 a = *(const float4*)(xr + s * 16);
      const float b0 = wp[s * 256], b1 = wp[s * 256 + 16], b2 = wp[s * 256 + 32], b3 = wp[s * 256 + 48];
      ss += a.x * a.x + a.y * a.y + a.z * a.z + a.w * a.w;
      acc = __builtin_amdgcn_mfma_f32_16x16x4f32(a.x, b0, acc, 0, 0, 0);
      acc = __builtin_amdgcn_mfma_f32_16x16x4f32(a.y, b1, acc, 0, 0, 0);
      acc = __builtin_amdgcn_mfma_f32_16x16x4f32(a.z, b2, acc, 0, 0, 0);
      acc = __builtin_amdgcn_mfma_f32_16x16x4f32(a.w, b3, acc, 0, 0, 0);
    }
    ss += __shfl_xor(ss, 16);
    ss += __shfl_xor(ss, 32);
    const float rstd = rsqrtf(ss * (1.f / 1024.f) + 1e-6f);
    const float ce = p.CE[(l * 3 + cond) * 16 + l16];
#pragma unroll
    for (int j = 0; j < 4; ++j) {
      const int tk = quad * 4 + j;
      const float r = __shfl(rstd, tk);
      const float lg = acc[j] * r + ce;
      float mx = lg;
#pragma unroll
      for (int o = 8; o; o >>= 1) mx = fmaxf(mx, __shfl_xor(mx, o));
      const float ex = __expf(lg - mx);
      float sm = ex;
#pragma unroll
      for (int o = 8; o; o >>= 1) sm += __shfl_xor(sm, o);
      const float aff = ex / sm;
      const int row = row0 + tk;
      if (row < T_LAT) p.AFFT[(size_t)((row >> 13) * 16 + l16) * SEQ + (row & (SEQ - 1))] = aff;
      else { const int rc = row - T_LAT; p.AFFT[(size_t)32 * SEQ + ((rc >> 8) * 16 + l16) * CTX + (rc & 255)] = aff; }
    }
  }
}

__device__ __forceinline__ void phase_in_gemm(const Params& p, int l, unsigned char* smem) {
  const u16* W = p.WinT + (size_t)l * 1536 * 1024;
  XCD_FOR(t, 132 * 11) {
    const int mt = t / 11, nt = t % 11;
    const int row_base = mt * 128;
    auto epi = [&](f32x4(&acc)[4][4], int r0, int c0) {
      const bool act = nt < 4;
      auto vf = [&](int, int, float v) { return act ? gelu_tanh(v) : v; };
      auto rp = [&](int r) -> u16* {
        const int row = row_base + r;
        if (nt < 4) return p.PX + (size_t)row * 1024 + nt * 128;
        if (nt >= 8) return p.PX + (size_t)row * 1024 + 512 + (nt - 8) * 128;
        const int ri = (nt - 4) >> 1, jx = ((nt - 4) & 1) * 128;
        if (row < T_LAT) return p.GD + ((size_t)((row >> 13) * 2 + ri) * SEQ + (row & (SEQ - 1))) * 256 + jx;
        const int rc = row - T_LAT;
        return p.GDc + ((size_t)((rc >> 8) * 2 + ri) * CTX + (rc & 255)) * 256 + jx;
      };
      epi_staged_bf16<4>(acc, r0, c0, smem, vf, rp);
    };
    gemm_tile<4, false>(p.H + (size_t)row_base * 1024, 1024, nullptr, 128, W + (size_t)nt * 128 * 1024, 1024, 1024, smem, epi);
  }
  XCD_FOR(t, 132) {
    const int row_base = t * 128;
    auto epi = [&](f32x4(&acc)[4][2], int r0, int c0) {
      auto vf = [&](int, int, float v) { return v; };
      auto rp = [&](int r) -> u16* { return p.PX + (size_t)(row_base + r) * 1024 + 896; };
      epi_staged_bf16<2>(acc, r0, c0, smem, vf, rp);
    };
    gemm_tile<2, false>(p.H + (size_t)row_base * 1024, 1024, nullptr, 128, W + (size_t)11 * 128 * 1024, 1024, 1024, smem, epi);
  }
}

__device__ __forceinline__ void phase_rownorm(const Params& p, int l) {
  constexpr int R = 4;
  const int t = tid_(), lane = t & 63, wid = t >> 6;
  const int gw = bid_() * 4 + wid, nw = gridDim.x * 4;
  const float* nv = p.sgu_norm + l * 256 + lane * 4;
  const float* nq = p.q_lora_norm + l * 256 + lane * 4;
  const float* nk = p.kv_lora_norm + l * 128 + lane * 2;
  for (int row0 = gw * R; row0 < TT; row0 += nw * R) {
    u16* px = p.PX + (size_t)row0 * 1024;
    u32x2 rv[R], rq[R];
    unsigned rk[R];
#pragma unroll
    for (int r = 0; r < R; ++r) {
      rv[r] = *(const u32x2*)(px + r * 1024 + 256 + lane * 4);
      rq[r] = *(const u32x2*)(px + r * 1024 + 512 + lane * 4);
      rk[r] = *(const unsigned*)(px + r * 1024 + 768 + lane * 2);
    }
#pragma unroll
    for (int r = 0; r < R; ++r) {
      {
        const float a = bf2f((u16)(rv[r].x & 0xffff)), b = bf2f((u16)(rv[r].x >> 16)), c = bf2f((u16)(rv[r].y & 0xffff)), d = bf2f((u16)(rv[r].y >> 16));
        const float rstd = rsqrtf(wave_sum(a * a + b * b + c * c + d * d) * (1.f / 256.f) + 1e-6f);
        u32x2 o;
        o.x = pack2(a * rstd * nv[0], b * rstd * nv[1]);
        o.y = pack2(c * rstd * nv[2], d * rstd * nv[3]);
        *(u32x2*)(px + r * 1024 + 256 + lane * 4) = o;
      }
      {
        const float a = bf2f((u16)(rq[r].x & 0xffff)), b = bf2f((u16)(rq[r].x >> 16)), c = bf2f((u16)(rq[r].y & 0xffff)), d = bf2f((u16)(rq[r].y >> 16));
        const float rstd = rsqrtf(wave_sum(a * a + b * b + c * c + d * d) * (1.f / 256.f) + 1e-6f);
        u32x2 o;
        o.x = pack2(a * rstd * nq[0], b * rstd * nq[1]);
        o.y = pack2(c * rstd * nq[2], d * rstd * nq[3]);
        *(u32x2*)(px + r * 1024 + 512 + lane * 4) = o;
      }
      {
        const float a = bf2f((u16)(rk[r] & 0xffff)), b = bf2f((u16)(rk[r] >> 16));
        const float rstd = rsqrtf(wave_sum(a * a + b * b) * (1.f / 128.f) + 1e-6f);
        *(unsigned*)(px + r * 1024 + 768 + lane * 2) = pack2(a * rstd * nk[0], b * rstd * nk[1]);
      }
    }
  }
}

__device__ __forceinline__ void phase_mix_a(const Params& p, int l, bool last, unsigned char* smem) {
  {
    const u16* W = p.WuqT + (size_t)l * 768 * 256;
    XCD_FOR(t, 132 * 6) {
      const int mt = t / 6, nt = t % 6, row_base = mt * 128;
      auto epi = [&](f32x4(&acc)[4][4], int r0, int c0) {
        const float* rs = (const float*)(smem + 65536);
        auto vf = [&](int r, int, float v) { return v * rs[r]; };
        auto rp = [&](int r) -> u16* { return p.QR + (size_t)(row_base + r) * 768 + nt * 128; };
        epi_staged_bf16<4>(acc, r0, c0, smem, vf, rp);
      };
      gemm_tile<4, false, false, true>(p.PX + (size_t)row_base * 1024 + 512, 1024, nullptr, 128, W + (size_t)nt * 128 * 256, 256, 256, smem, epi);
    }
  }
  {
    const u16* W = p.WukvT + (size_t)l * 1024 * 128;
    XCD_FOR(t, 132 * 8) {
      const int mt = t >> 3, nt = t & 7, row_base = mt * 128, h = nt >> 1;
      const int b = row_batch(row_base), pos_base = row_pos(row_base);
      auto epi = [&](f32x4(&acc)[4][4], int r0, int c0) {
#pragma unroll
        for (int mi = 0; mi < 4; ++mi)
#pragma unroll
          for (int ni = 0; ni < 4; ++ni) {
            const int col = c0 + ni * 16;
            if ((nt & 1) == 0) {
            } else {
              u32x2 pk;
              pk.x = pack2(acc[mi][ni][0], acc[mi][ni][1]);
              pk.y = pack2(acc[mi][ni][2], acc[mi][ni][3]);
              *(u32x2*)(p.Vt + ((size_t)(b * 4 + h) * 128 + col) * NPOS + pos_base + r0 + mi * 16) = pk;
            }
          }
      };
      auto epi2 = [&](f32x4(&acc)[4][4], int r0, int c0) {
        const float* rs = (const float*)(smem + 65536);
        if ((nt & 1) == 0) {
          auto vf = [&](int r, int, float v) { return v * rs[r]; };
          auto rp = [&](int r) -> u16* { return p.KN + (size_t)(row_base + r) * 512 + h * 128; };
          epi_staged_bf16<4>(acc, r0, c0, smem, vf, rp);
        } else {
#pragma unroll
          for (int mi = 0; mi < 4; ++mi)
#pragma unroll
            for (int j = 0; j < 4; ++j) {
              const float sc = rs[r0 + mi * 16 + j];
#pragma unroll
              for (int ni = 0; ni < 4; ++ni) acc[mi][ni][j] *= sc;
            }
          auto cp = [&](int c) -> u16* { return p.Vt + ((size_t)(b * 4 + h) * 128 + c) * NPOS + pos_base; };
          epi_staged_bf16_T(acc, r0, c0, smem, cp);
        }
      };
      gemm_tile<4, false, false, true>(p.PX + (size_t)row_base * 1024 + 768, 1024, nullptr, 128, W + (size_t)nt * 128 * 128, 128, 128, smem, epi2);
    }
  }
  {
    const int nch = last ? 128 : 132;
    XCD_FOR(t, nch * 4) {
      const int ch = t >> 2, h = t & 3, row_base = ch * 128;
      const float* bs = p.b_sgu + (l * 4 + h) * 128;
      const float* sgn = p.sgu_norm + l * 256 + h * 64;
      float* rsv = (float*)(smem + 65536 + 512);
      {
        const int t3 = tid_(), q = t3 >> 1, half = t3 & 1;
        const u16* vp = p.PX + (size_t)(row_base + q) * 1024 + 256 + half * 128;
        float s = 0.f;
#pragma unroll
        for (int i = 0; i < 16; ++i) {
          const u32x4 w = *(const u32x4*)(vp + i * 8);
          const float a0 = __uint_as_float(w.x << 16), a1 = __uint_as_float(w.x & 0xffff0000u), a2 = __uint_as_float(w.y << 16), a3 = __uint_as_float(w.y & 0xffff0000u);
          const float a4 = __uint_as_float(w.z << 16), a5 = __uint_as_float(w.z & 0xffff0000u), a6 = __uint_as_float(w.w << 16), a7 = __uint_as_float(w.w & 0xffff0000u);
          s += (a0 * a0 + a1 * a1) + (a2 * a2 + a3 * a3) + (a4 * a4 + a5 * a5) + (a6 * a6 + a7 * a7);
        }
        s += __shfl_xor(s, 1);
        __syncthreads();
        if (half == 0) rsv[q] = rsqrtf(s * (1.f / 256.f) + 1e-6f);
      }
      auto epi = [&](f32x4(&acc)[4][2], int r0, int c0) {
        float* Ts = (float*)smem;
        const int t2 = tid_();
        __syncthreads();
#pragma unroll
        for (int mi = 0; mi < 4; ++mi)
#pragma unroll
          for (int ni = 0; ni < 2; ++ni)
#pragma unroll
            for (int j = 0; j < 4; ++j) {
              const int pr = r0 + mi * 16 + j;
              Ts[pr * 68 + c0 + ni * 16] = acc[mi][ni][j] * sgn[c0 + ni * 16] + bs[pr];
            }
        __syncthreads();
#pragma unroll
        for (int i = 0; i < 4; ++i) {
          const int c = t2 + 256 * i, pr = c >> 3, ch = c & 7;
          const size_t o = (size_t)(row_base + pr) * 1024 + h * 64 + ch * 8;
          const u32x4 u = *(const u32x4*)(p.PX + o);
          const float4 z0 = *(const float4*)(Ts + pr * 68 + ch * 8), z1 = *(const float4*)(Ts + pr * 68 + ch * 8 + 4);
          u32x4 r;
          r.x = pack2(bf2f((u16)(u.x & 0xffffu)) * z0.x, bf2f((u16)(u.x >> 16)) * z0.y);
          r.y = pack2(bf2f((u16)(u.y & 0xffffu)) * z0.z, bf2f((u16)(u.y >> 16)) * z0.w);
          r.z = pack2(bf2f((u16)(u.z & 0xffffu)) * z1.x, bf2f((u16)(u.z >> 16)) * z1.y);
          r.w = pack2(bf2f((u16)(u.w & 0xffffu)) * z1.z, bf2f((u16)(u.w >> 16)) * z1.w);
          *(u32x4*)(p.YM + o) = r;
        }
      };
      gemm_tile<2, true>(p.Wsgu + (size_t)(l * 4 + h) * 16384, 128, nullptr, 128, p.PX + (size_t)row_base * 1024 + 256 + h * 64, 1024, 128, smem, epi, rsv);
    }
  }
  {
    XCD_FOR(t, 512) {
      const int nh = t & 1, n1 = (t >> 1) & 127, b = t >> 8;
      auto epi = [&](f32x4(&acc)[4][4], int r0, int c0) {
        auto vf = [&](int, int, float v) { return v; };
        auto rp = [&](int m) -> u16* { const int rip = m >> 6, k2 = m & 63; return p.PF + ((size_t)((b * 64 + k2) * 2 + rip) * 128 + n1) * 256 + nh * 128; };
        epi_staged_bf16<4>(acc, r0, c0, smem, vf, rp);
      };
      gemm_tile<4, true>(p.M1 + (size_t)n1 * 16384, 128, nullptr, 128, p.GD + (size_t)b * 2 * SEQ * 256 + (size_t)n1 * 256 + nh * 128, 128 * 256, 128, smem, epi);
    }
  }
  if (!last) {
    for (int t = bid_(); t < 8; t += gridDim.x) {
      const int nh = t & 1, mt = (t >> 1) & 1, b = t >> 2;
      auto epi = [&](f32x4(&acc)[4][4], int r0, int c0) {
#pragma unroll
        for (int mi = 0; mi < 4; ++mi)
#pragma unroll
          for (int ni = 0; ni < 4; ++ni)
#pragma unroll
            for (int j = 0; j < 4; ++j) {
              const int k = mt * 128 + r0 + mi * 16 + j;
              p.YM[(size_t)(T_LAT + b * CTX + k) * 1024 + 256 + nh * 128 + c0 + ni * 16] = f2bf(acc[mi][ni][j] * (1.f / 128.f));
            }
      };
      gemm_tile<4, true>(p.Mc + (size_t)mt * 128 * 512, 512, nullptr, 128, p.GDc + (size_t)b * 2 * CTX * 256 + nh * 128, 256, 512, smem, epi);
    }
  }
}

__device__ __forceinline__ void phase_mix_b(const Params& p, int l, bool last, unsigned char* smem) {
  XCD_FOR(t, 512) {
    const int nq = t & 3, k2 = (t >> 2) & 63, b = t >> 8;
    auto epi = [&](f32x4(&acc)[4][2], int r0, int c0) {
      auto vf = [&](int, int, float v) { return v * 0.001381067932004976f; };
      auto rp = [&](int k1) -> u16* { return p.YM + (size_t)(b * SEQ + 64 * k1 + k2) * 1024 + 256 + nq * 64; };
      epi_staged_bf16<2>(acc, r0, c0, smem, vf, rp);
    };
    gemm_tile<2, true>(p.M2, 256, nullptr, 128, p.PF + (size_t)(b * 64 + k2) * 2 * 128 * 256 + nq * 64, 256, 256, smem, epi);
  }
  const int tt = tid_(), lane = tt & 63, wid = tt >> 6;
  const int gw = bid_() * 4 + wid, nw = gridDim.x * 4;
  const float QSCALE = 0.07216878364870322f * 1.4426950408889634f;
  for (int row = gw; row < TT; row += nw) {
    const bool lat = row < T_LAT;
    const int b = row_batch(row), pos = row_pos(row);
    float cs = 1.f, sn = 0.f;
    if (lat) {
      const int n = row & (SEQ - 1);
      const int r = lane, sub = r & 31, i = sub & 15;
      const float ps = (r < 32) ? (float)(n >> 6) : (float)(n & 63);
      const float fr = __builtin_amdgcn_exp2f(-(float)i * 0.83048202372184058696f);
      const float ang = ps * fr;
      sn = __sinf(ang);
      cs = __cosf(ang);
    }
    const bool hi = ((lane & 31) >= 16);
    if (lat || !last) {
#pragma unroll
      for (int h = 0; h < 4; ++h) {
        const u16* q = p.QR + (size_t)row * 768 + h * 192;
        float v0 = bf2f(q[lane]), v1 = bf2f(q[lane + 64]), v2 = bf2f(q[lane + 128]);
        const float ss = wave_sum(v0 * v0 + v1 * v1 + v2 * v2);
        const float rstd = rsqrtf(ss * (1.f / 192.f) + 1e-6f);
        const float* qn = p.q_norm + l * 192;
        v0 *= rstd * qn[lane]; v1 *= rstd * qn[lane + 64]; v2 *= rstd * qn[lane + 128];
        if (lat) {
          const float xp = __shfl_xor(v2, 16);
          v2 = hi ? (xp * sn + v2 * cs) : (v2 * cs - xp * sn);
        }
        u16* o = p.Qall + ((size_t)(b * 4 + h) * NPOS + pos) * 192;
        o[lane] = f2bf(v0 * QSCALE); o[lane + 64] = f2bf(v1 * QSCALE); o[lane + 128] = f2bf(v2 * QSCALE);
      }
    }
    {
      const float kr = bf2f(p.PX[(size_t)row * 1024 + 896 + lane]);
#pragma unroll
      for (int h = 0; h < 4; ++h) {
        const u16* kk = p.KN + (size_t)row * 512 + h * 128;
        float v0 = bf2f(kk[lane]), v1 = bf2f(kk[lane + 64]), v2 = kr;
        const float ss = wave_sum(v0 * v0 + v1 * v1 + v2 * v2);
        const float rstd = rsqrtf(ss * (1.f / 192.f) + 1e-6f);
        const float* kn = p.k_norm + l * 192;
        v0 *= rstd * kn[lane]; v1 *= rstd * kn[lane + 64]; v2 *= rstd * kn[lane + 128];
        if (lat) {
          const float xp = __shfl_xor(v2, 16);
          v2 = hi ? (xp * sn + v2 * cs) : (v2 * cs - xp * sn);
        }
        u16* o = p.Kb + ((size_t)(b * 4 + h) * NPOS + pos) * 192;
        o[lane] = f2bf(v0); o[lane + 64] = f2bf(v1); o[lane + 128] = f2bf(v2);
      }
    }
  }
}

__device__ __forceinline__ void attn_item(const Params& p, int b, int h, int qt, float shift, unsigned char* smem) {
  constexpr int STAGE = 32 * 208 + 128 * 40;
  u16* sbase = (u16*)smem;
  const int t = tid_(), lane = t & 63, wid = t >> 6, l16 = lane & 15, quad = lane >> 4;
  const int nkeys = (qt < 2) ? CTX : NPOS;
  const int ntile = nkeys >> 5;
  const u16* Qp = p.Qall + ((size_t)(b * 4 + h) * NPOS + qt * 128 + wid * 32) * 192;
  const u16* kp = p.Kb + (size_t)(b * 4 + h) * NPOS * 192 + t * 8;
  const u16* vp = p.Vt + (size_t)(b * 4 + h) * 128 * NPOS + (size_t)(t >> 2) * NPOS + (t & 3) * 8;
  const u16* qlane = Qp + (size_t)l16 * 192 + quad * 8;
  bf16x8 bq[2][6];
#pragma unroll
  for (int qi = 0; qi < 2; ++qi)
#pragma unroll
    for (int ks = 0; ks < 6; ++ks) bq[qi][ks] = *(const bf16x8*)(qlane + qi * 16 * 192 + ks * 32);
  f32x4 o[8][2];
#pragma unroll
  for (int vt = 0; vt < 8; ++vt)
#pragma unroll
    for (int qi = 0; qi < 2; ++qi) o[vt][qi] = (f32x4){0.f, 0.f, 0.f, 0.f};
  float lrun0 = 0.f, lrun1 = 0.f;
  u32x4 rk[3], rv[2];
  f32x4 sA[2][2], sB[2][2];
#define ATT_LOAD(kt_)                                                                                   \
  {                                                                                                     \
    _Pragma("unroll") for (int i = 0; i < 3; ++i) rk[i] = *(const u32x4*)(kp + (size_t)(kt_) * 6144 + i * 2048); \
    _Pragma("unroll") for (int i = 0; i < 2; ++i) rv[i] = *(const u32x4*)(vp + (size_t)(64 * i) * NPOS + (kt_) * 32); \
  }
#define ATT_STORE(st_)                                                                                  \
  {                                                                                                     \
    u16* kd = sbase + (st_) * STAGE;                                                                    \
    _Pragma("unroll") for (int i = 0; i < 3; ++i) {                                                     \
      const int c = t + 256 * i;                                                                        \
      *(u32x4*)(kd + (c / 24) * 208 + (c % 24) * 8) = rk[i];                                            \
    }                                                                                                   \
    _Pragma("unroll") for (int i = 0; i < 2; ++i) *(u32x4*)(kd + 6656 + ((t >> 2) + 64 * i) * 40 + (t & 3) * 8) = rv[i]; \
  }
#define ATT_S(SX, kst_)                                                                                 \
  {                                                                                                     \
    const u16* Ks = sbase + (kst_) * STAGE;                                                             \
    _Pragma("unroll") for (int a = 0; a < 2; ++a)                                                       \
      _Pragma("unroll") for (int qi = 0; qi < 2; ++qi) SX[a][qi] = (f32x4){0.f, 0.f, 0.f, 0.f};         \
    _Pragma("unroll") for (int ks = 0; ks < 6; ++ks) {                                                  \
      _Pragma("unroll") for (int a = 0; a < 2; ++a) {                                                   \
        const bf16x8 kf = *(const bf16x8*)(Ks + (a * 16 + l16) * 208 + ks * 32 + quad * 8);             \
        _Pragma("unroll") for (int qi = 0; qi < 2; ++qi) SX[a][qi] = __builtin_amdgcn_mfma_f32_16x16x32_bf16(kf, bq[qi][ks], SX[a][qi], 0, 0, 0); \
      }                                                                                                 \
    }                                                                                                   \
  }
#define ATT_VLOAD(vst_, hv_)                                                                            \
  {                                                                                                     \
    const u16* Vs = sbase + (vst_) * STAGE + 6656;                                                      \
    _Pragma("unroll") for (int vt = 0; vt < 4; ++vt) {                                                  \
      const u16* vb = Vs + (((hv_) * 4 + vt) * 16 + l16) * 40 + quad * 4;                               \
      const u32x2 va = *(const u32x2*)(vb);                                                             \
      const u32x2 vc = *(const u32x2*)(vb + 16);                                                        \
      const u32x4 vw = {va.x, va.y, vc.x, vc.y};                                                        \
      vfr[vt] = (bf16x8)vw;                                                                             \
    }                                                                                                   \
  }
#define ATT_FINISH(SX, vst_)                                                                            \
  {                                                                                                     \
    bf16x8 pb[2];                                                                                       \
    _Pragma("unroll") for (int qi = 0; qi < 2; ++qi) {                                                  \
      float psum = 0.f;                                                                                 \
      _Pragma("unroll") for (int a = 0; a < 2; ++a)                                                     \
        _Pragma("unroll") for (int j = 0; j < 4; ++j) {                                                 \
          const float pe = __builtin_amdgcn_exp2f(SX[a][qi][j]);                                        \
          SX[a][qi][j] = pe;                                                                            \
          psum += pe;                                                                                   \
        }                                                                                               \
      if (qi) lrun1 += psum; else lrun0 += psum;                                                        \
      u32x4 pk;                                                                                         \
      pk.x = pack2(SX[0][qi][0], SX[0][qi][1]);                                                         \
      pk.y = pack2(SX[0][qi][2], SX[0][qi][3]);                                                         \
      pk.z = pack2(SX[1][qi][0], SX[1][qi][1]);                                                         \
      pk.w = pack2(SX[1][qi][2], SX[1][qi][3]);                                                         \
      pb[qi] = (bf16x8)pk;                                                                              \
    }                                                                                                   \
    _Pragma("unroll") for (int vt = 0; vt < 4; ++vt)                                                    \
      _Pragma("unroll") for (int qi = 0; qi < 2; ++qi) o[vt][qi] = __builtin_amdgcn_mfma_f32_16x16x32_bf16(vfr[vt], pb[qi], o[vt][qi], 0, 0, 0); \
    ATT_VLOAD(vst_, 1);                                                                                 \
    _Pragma("unroll") for (int vt = 0; vt < 4; ++vt)                                                    \
      _Pragma("unroll") for (int qi = 0; qi < 2; ++qi) o[4 + vt][qi] = __builtin_amdgcn_mfma_f32_16x16x32_bf16(vfr[vt], pb[qi], o[4 + vt][qi], 0, 0, 0); \
  }
#define ATT_SHIFT(SX)                                                                                   \
  if (shift > 0.f) {                                                                                    \
    _Pragma("unroll") for (int a = 0; a < 2; ++a)                                                       \
      _Pragma("unroll") for (int qi = 0; qi < 2; ++qi) {                                                \
        SX[a][qi][0] -= shift; SX[a][qi][1] -= shift; SX[a][qi][2] -= shift; SX[a][qi][3] -= shift;     \
      }                                                                                                 \
  }
#define ATT_STEP(SNEW, SOLD, tt_)                                                                       \
  {                                                                                                     \
    const int tn_ = ((tt_) + 1 < ntile) ? (tt_) + 1 : ntile - 1;                                        \
    ATT_LOAD(tn_);                                                                                      \
    bf16x8 vfr[4];                                                                                      \
    ATT_VLOAD(((tt_) - 1) % 3, 0);                                                                      \
    ATT_SHIFT(SOLD);                                                                                    \
    ATT_S(SNEW, (tt_) % 3);                                                                             \
    ATT_FINISH(SOLD, ((tt_) - 1) % 3);                                                                  \
    __builtin_amdgcn_sched_barrier(0);                                                                  \
    ATT_STORE(((tt_) + 1) % 3);                                                                         \
    __syncthreads();                                                                                    \
  }
  __syncthreads();
  ATT_LOAD(0);
  ATT_STORE(0);
  ATT_LOAD(1);
  __syncthreads();
  ATT_S(sA, 0);
  ATT_STORE(1);
  __syncthreads();
#pragma unroll 1
  for (int tt = 1; tt < ntile - 1; tt += 2) {
    ATT_STEP(sB, sA, tt);
    ATT_STEP(sA, sB, tt + 1);
  }
  ATT_STEP(sB, sA, ntile - 1);
  {
    bf16x8 vfr[4];
    ATT_VLOAD((ntile - 1) % 3, 0);
    ATT_SHIFT(sB);
    ATT_FINISH(sB, (ntile - 1) % 3);
  }
  __syncthreads();
#undef ATT_LOAD
#undef ATT_STORE
#undef ATT_S
#undef ATT_VLOAD
#undef ATT_FINISH
#undef ATT_STEP
#undef ATT_SHIFT
#pragma unroll
  for (int qi = 0; qi < 2; ++qi) {
    float ls = qi ? lrun1 : lrun0;
    ls += __shfl_xor(ls, 16);
    ls += __shfl_xor(ls, 32);
    const float inv = 1.f / ls;
    const int pos = qt * 128 + wid * 32 + qi * 16 + l16;
    const int row = (pos < CTX) ? (T_LAT + b * CTX + pos) : (b * SEQ + pos - CTX);
    u16* orow = p.YM + (size_t)row * 1024 + 512 + h * 128 + quad * 4;
#pragma unroll
    for (int vt = 0; vt < 8; ++vt) {
      u32x2 pk;
      pk.x = pack2(o[vt][qi][0] * inv, o[vt][qi][1] * inv);
      pk.y = pack2(o[vt][qi][2] * inv, o[vt][qi][3] * inv);
      *(u32x2*)(orow + vt * 16) = pk;
    }
  }
}

__device__ __forceinline__ void phase_attn(const Params& p, int l, bool last, unsigned char* smem) {
  float shift;
  {
    const int lane = tid_() & 63;
    float mq = 0.f, mk = 0.f;
#pragma unroll
    for (int i = 0; i < 3; ++i) { mq = fmaxf(mq, fabsf(p.q_norm[l * 192 + lane + 64 * i])); mk = fmaxf(mk, fabsf(p.k_norm[l * 192 + lane + 64 * i])); }
#pragma unroll
    for (int o = 32; o; o >>= 1) { mq = fmaxf(mq, __shfl_xor(mq, o)); mk = fmaxf(mk, __shfl_xor(mk, o)); }
    const float bound = 192.f * mq * mk * (0.07216878364870322f * 1.4426950408889634f);
    shift = fmaxf(0.f, bound - 24.f);
  }
  const int x = bid_() & 7, j = bid_() >> 3, gb = gridDim.x >> 3;
  for (int q = j; q < 64; q += gb) attn_item(p, x >> 2, x & 3, 2 + q, shift, smem);
  if (!last)
    for (int q = j; q < 2; q += gb) attn_item(p, x >> 2, x & 3, q, shift, smem);
}

__device__ __forceinline__ void phase_out_gemm(const Params& p, int l, bool last, const float* slat, const float* sctx, float* dlat, float* dctx, unsigned char* smem) {
  const u16* W = p.WoutT + (size_t)l * 1024 * 1024;
  XCD_FOR(t, 128 * 8) {
    const int mt = t >> 3, nt = t & 7, row_base = mt * 128;
    const float* g1 = p.mada + (size_t)(l * 3 + (row_base >> 13)) * 6144 + 2 * 1024 + nt * 128;
    const float* xs = slat + (size_t)row_base * DM;
    float* xd = dlat + (size_t)row_base * DM;
    auto epi = [&](f32x4(&acc)[4][4], int r0, int c0) { epi_staged_residual(acc, r0, c0, smem, g1, xs + nt * 128, xd + nt * 128); };
    gemm_tile<4, false>(p.YM + (size_t)row_base * 1024, 1024, nullptr, 128, W + (size_t)nt * 128 * 1024, 1024, 1024, smem, epi);
  }
  if (!last) {
    XCD_FOR(t, 4 * 32) {
      const int mt = t >> 5, nt = t & 31, row_base = mt * 128;
      const float* g1 = p.mada + (size_t)(l * 3 + 2) * 6144 + 2 * 1024 + nt * 32;
      const float* xs = sctx + (size_t)row_base * DM;
      float* xd = dctx + (size_t)row_base * DM;
      auto epi = [&](f32x4(&acc)[4][1], int r0, int c0) {
#pragma unroll
        for (int mi = 0; mi < 4; ++mi) {
          const float g = g1[c0];
#pragma unroll
          for (int j = 0; j < 4; ++j) {
            const size_t o = (size_t)(r0 + mi * 16 + j) * DM + nt * 32 + c0;
            xd[o] = xs[o] + g * acc[mi][0][j];
          }
        }
      };
      gemm_tile<1, false>(p.YM + (size_t)(T_LAT + row_base) * 1024, 1024, nullptr, 128, W + (size_t)nt * 32 * 1024, 1024, 1024, smem, epi);
    }
  }
}

__device__ __forceinline__ unsigned block_incl_scan(unsigned x, unsigned* wsum, int lane, int wid, unsigned& total) {
  unsigned v = x;
#pragma unroll
  for (int off = 1; off < 64; off <<= 1) {
    const unsigned n = __shfl_up(v, off);
    if (lane >= off) v += n;
  }
  __syncthreads();
  if (lane == 63) wsum[wid] = v;
  __syncthreads();
  const unsigned w0 = wsum[0], w1 = wsum[1], w2 = wsum[2], w3 = wsum[3];
  total = w0 + w1 + w2 + w3;
  const unsigned base = (wid > 0 ? w0 : 0u) + (wid > 1 ? w1 : 0u) + (wid > 2 ? w2 : 0u);
  return base + v;
}

__device__ __forceinline__ void phase_topk(const Params& p, bool last, unsigned char* smem) {
  unsigned* key = (unsigned*)smem;
  unsigned* hist = key + 8192;
  unsigned* wsum = hist + 256;
  unsigned* sh = wsum + 4;
  const int t = tid_(), lane = t & 63, wid = t >> 6;
  const int ninst = last ? 32 : 64;
  for (int inst = bid_(); inst < ninst; inst += gridDim.x) {
    const bool lat = inst < 32;
    const int n = lat ? SEQ : CTX, cap = lat ? 1024 : 32;
    const float* src = lat ? p.AFFT + (size_t)inst * SEQ : p.AFFT + (size_t)32 * SEQ + (inst - 32) * CTX;
    const int rowbase = lat ? (inst >> 4) * SEQ : T_LAT + ((inst - 32) >> 4) * CTX;
    for (int i = t; i < n; i += 256) key[i] = __float_as_uint(src[i]);
    unsigned prefix = 0u, mask = 0u, remaining = (unsigned)cap;
    for (int shift = 24; shift >= 0; shift -= 8) {
      hist[t] = 0u;
      __syncthreads();
      for (int i = t; i < n; i += 256) {
        const unsigned k = key[i];
        if ((k & mask) == prefix) atomicAdd(&hist[(k >> shift) & 255u], 1u);
      }
      __syncthreads();
      const unsigned hc = hist[t];
      unsigned total;
      const unsigned incl = block_incl_scan(hc, wsum, lane, wid, total);
      const unsigned suf = total - incl + hc;
      const unsigned sufn = total - incl;
      if (suf >= remaining && sufn < remaining) { sh[0] = prefix | ((unsigned)t << shift); sh[1] = remaining - sufn; }
      __syncthreads();
      prefix = sh[0];
      remaining = sh[1];
      mask |= (255u << shift);
      __syncthreads();
    }
    const int per = n >> 8;
    unsigned cgt = 0u, ceq = 0u;
    for (int i = 0; i < per; ++i) {
      const unsigned k = key[t * per + i];
      cgt += (k > prefix) ? 1u : 0u;
      ceq += (k == prefix) ? 1u : 0u;
    }
    unsigned ngt, neq;
    unsigned og = block_incl_scan(cgt, wsum, lane, wid, ngt) - cgt;
    unsigned oe = block_incl_scan(ceq, wsum, lane, wid, neq) - ceq;
    int* idx = p.IDXG + (size_t)inst * 1024;
    float* gt = p.GATE + (size_t)inst * 1024;
    int* inv = p.INV + (size_t)rowbase * 16 + (inst & 15);
    for (int i = 0; i < per; ++i) {
      const int e = t * per + i;
      const unsigned k = key[e];
      int slot = -1;
      if (k > prefix) {
        slot = (int)og; ++og;
      } else if (k == prefix) {
        if (oe < remaining) slot = (int)(ngt + oe);
        ++oe;
      }
      if (slot >= 0) { idx[slot] = rowbase + e; gt[slot] = __uint_as_float(k); }
      inv[(size_t)e * 16] = slot;
    }
    __syncthreads();
  }
}

__device__ __forceinline__ void phase_moe_up(const Params& p, int l, bool last, unsigned char* smem) {
  const int npass = last ? 1 : 2;
  for (int pass = 0; pass < npass; ++pass)
  XCD_FOR(t, ((pass == npass - 1) ? 2048 : 256)) {
    int inst, mt, nt, mvalid, hid_row;
    if (pass == npass - 1) { const int e_ = t >> 7, b_ = (t >> 6) & 1; inst = b_ * 16 + e_; mt = (t >> 3) & 7; nt = t & 7; mvalid = 128; hid_row = inst * 1024 + mt * 128; }
    else { const int e_ = t >> 4, b_ = (t >> 3) & 1; inst = 32 + b_ * 16 + e_; mt = 0; nt = t & 7; mvalid = 32; hid_row = 32768 + (inst - 32) * 128; }
    const int e = inst & 15;
    const u16* W = p.WguT + (size_t)(l * 16 + e) * 1024 * 1024 + (size_t)nt * 128 * 1024;
    auto epi = [&](f32x4(&acc)[4][4], int r0, int c0) {
      u16* Ts = (u16*)smem;
      const int t2 = tid_();
      __syncthreads();
#pragma unroll
      for (int mi = 0; mi < 4; ++mi)
#pragma unroll
        for (int n2 = 0; n2 < 2; ++n2)
#pragma unroll
          for (int j = 0; j < 4; ++j) {
            const int m = r0 + mi * 16 + j;
            const int fl = (c0 >> 6) * 32 + n2 * 16 + (c0 & 15);
            Ts[m * 72 + fl] = f2bf(silu_f(acc[mi][2 * n2][j]) * acc[mi][2 * n2 + 1][j]);
          }
      __syncthreads();
#pragma unroll
      for (int i = 0; i < 4; ++i) {
        const int c = t2 + 256 * i, row = c >> 3, ch = c & 7;
        if (row < mvalid) *(u32x4*)(p.HID + (size_t)(hid_row + row) * 512 + nt * 64 + ch * 8) = *(const u32x4*)(Ts + row * 72 + ch * 8);
      }
    };
    if (mvalid == 128) gemm_tile<4, false, false>(p.H, 1024, p.IDXG + (size_t)inst * 1024 + mt * 128, 128, W, 1024, 1024, smem, epi);
    else gemm_tile<4, false, true>(p.H, 1024, p.IDXG + (size_t)inst * 1024 + mt * 128, mvalid, W, 1024, 1024, smem, epi);
  }
}

__device__ __forceinline__ void phase_moe_down(const Params& p, int l, bool last, unsigned char* smem) {
  const int npass = last ? 1 : 2;
  for (int pass = 0; pass < npass; ++pass)
  XCD_FOR(t, ((pass == npass - 1) ? 2048 : 256)) {
    int inst, mt, nt, mvalid, hid_row;
    if (pass == npass - 1) { const int e_ = t >> 7, b_ = (t >> 6) & 1; inst = b_ * 16 + e_; mt = (t >> 3) & 7; nt = t & 7; mvalid = 128; hid_row = inst * 1024 + mt * 128; }
    else { const int e_ = t >> 4, b_ = (t >> 3) & 1; inst = 32 + b_ * 16 + e_; mt = 0; nt = t & 7; mvalid = 32; hid_row = 32768 + (inst - 32) * 128; }
    const int e = inst & 15;
    const float* gate = p.GATE + (size_t)inst * 1024 + mt * 128;
    const u16* W = p.WdT + (size_t)(l * 16 + e) * 1024 * 512 + (size_t)nt * 128 * 512;
    u16* yb = p.YB + (size_t)hid_row * 1024 + nt * 128;
    auto epi = [&](f32x4(&acc)[4][4], int r0, int c0) {
      auto vf = [&](int r, int, float v) { return (r < mvalid ? gate[r] : 0.f) * v; };
      auto rp = [&](int r) -> u16* { return r < mvalid ? yb + (size_t)r * 1024 : nullptr; };
      epi_staged_bf16<4>(acc, r0, c0, smem, vf, rp);
    };
    if (mvalid == 128) gemm_tile<4, false, false>(p.HID + (size_t)hid_row * 512, 512, nullptr, 128, W, 512, 512, smem, epi);
    else gemm_tile<4, false, true>(p.HID + (size_t)hid_row * 512, 512, nullptr, mvalid, W, 512, 512, smem, epi);
  }
}

template <bool COMBINE, bool MOD>
__device__ __forceinline__ void phase_combine_modulate(const Params& p, int lprev, int lnext, const float* xlat, const float* xctx,
                                                       float* olat, float* octx, int nrows) {
  constexpr int R = 2;
  const int t = tid_(), lane = t & 63, wid = t >> 6;
  const int gw = bid_() * 4 + wid, nw = gridDim.x * 4;
  for (int row0 = gw * R; row0 < nrows; row0 += nw * R) {
    const bool lat = row0 < T_LAT;
    const float* xr = lat ? xlat + (size_t)row0 * DM : xctx + (size_t)(row0 - T_LAT) * DM;
    const int cond = row_cond(row0);
    float4 v[R][4];
#pragma unroll
    for (int r = 0; r < R; ++r)
#pragma unroll
      for (int i = 0; i < 4; ++i) v[r][i] = *(const float4*)(xr + (size_t)r * DM + i * 256 + lane * 4);
    if (COMBINE) {
      const int b = row_batch(row0);
      const int myinv = p.INV[(size_t)row0 * 16 + (lane & 31)];
      const float* g2 = p.mada + (size_t)(lprev * 3 + cond) * 6144 + 5 * 1024;
      float* orow = lat ? olat + (size_t)row0 * DM : octx + (size_t)(row0 - T_LAT) * DM;
#pragma unroll
      for (int r = 0; r < R; ++r) {
        float4 s[4];
#pragma unroll
        for (int i = 0; i < 4; ++i) s[i] = make_float4(0.f, 0.f, 0.f, 0.f);
        unsigned mask = (unsigned)((__ballot(myinv >= 0) >> (16 * r)) & 0xFFFFull);
        while (mask) {
          const int e0 = __builtin_ctz(mask);
          mask &= mask - 1;
          const bool two = mask != 0u;
          const int e1 = two ? __builtin_ctz(mask) : e0;
          mask &= mask - 1;
          const int s0 = __shfl(myinv, 16 * r + e0), s1 = __shfl(myinv, 16 * r + e1);
          const size_t y0 = lat ? (size_t)(b * 16 + e0) * 1024 + s0 : (size_t)32768 + (size_t)(b * 16 + e0) * 128 + s0;
          const size_t y1 = lat ? (size_t)(b * 16 + e1) * 1024 + s1 : (size_t)32768 + (size_t)(b * 16 + e1) * 128 + s1;
          u32x2 a0[4], a1[4];
#pragma unroll
          for (int i = 0; i < 4; ++i) { a0[i] = *(const u32x2*)(p.YB + y0 * 1024 + lane * 4 + i * 256); a1[i] = *(const u32x2*)(p.YB + y1 * 1024 + lane * 4 + i * 256); }
          const float w1 = two ? 1.f : 0.f;
#pragma unroll
          for (int i = 0; i < 4; ++i) {
            s[i].x += bf2f((u16)(a0[i].x & 0xffffu)); s[i].y += bf2f((u16)(a0[i].x >> 16));
            s[i].z += bf2f((u16)(a0[i].y & 0xffffu)); s[i].w += bf2f((u16)(a0[i].y >> 16));
            s[i].x += w1 * bf2f((u16)(a1[i].x & 0xffffu)); s[i].y += w1 * bf2f((u16)(a1[i].x >> 16));
            s[i].z += w1 * bf2f((u16)(a1[i].y & 0xffffu)); s[i].w += w1 * bf2f((u16)(a1[i].y >> 16));
          }
        }
#pragma unroll
        for (int i = 0; i < 4; ++i) {
          const int col = i * 256 + lane * 4;
          const float4 g4 = *(const float4*)(g2 + col);
          v[r][i].x += g4.x * s[i].x; v[r][i].y += g4.y * s[i].y; v[r][i].z += g4.z * s[i].z; v[r][i].w += g4.w * s[i].w;
          *(float4*)(orow + (size_t)r * DM + col) = v[r][i];
        }
      }
    }
    if (MOD) {
      const float* sh = p.mada + (size_t)(lnext * 3 + cond) * 6144;
      const float* sc = sh + 1024;
      float rstd[R];
#pragma unroll
      for (int r = 0; r < R; ++r) {
        float ss = 0.f;
#pragma unroll
        for (int i = 0; i < 4; ++i) ss += v[r][i].x * v[r][i].x + v[r][i].y * v[r][i].y + v[r][i].z * v[r][i].z + v[r][i].w * v[r][i].w;
        rstd[r] = rsqrtf(wave_sum(ss) * (1.f / 1024.f) + 1e-6f);
      }
#pragma unroll
      for (int i = 0; i < 4; ++i) {
        const int col = i * 256 + lane * 4;
        const float4 s4 = *(const float4*)(sc + col);
        const float4 h4 = *(const float4*)(sh + col);
#pragma unroll
        for (int r = 0; r < R; ++r) {
          u32x2 pk;
          pk.x = pack2(v[r][i].x * rstd[r] * (1.f + s4.x) + h4.x, v[r][i].y * rstd[r] * (1.f + s4.y) + h4.y);
          pk.y = pack2(v[r][i].z * rstd[r] * (1.f + s4.z) + h4.z, v[r][i].w * rstd[r] * (1.f + s4.w) + h4.w);
          *(u32x2*)(p.H + (size_t)(row0 + r) * DM + col) = pk;
        }
      }
    }
  }
}

__global__ void __launch_bounds__(256, 2) fwd_megakernel(Params p_unused) {
  const Params& p = *(const Params*)__builtin_amdgcn_kernarg_segment_ptr();
  __shared__ __attribute__((aligned(16))) unsigned char smem[SMEM_BYTES];
  __shared__ uint4 xb_words;
  cg::grid_group grid = cg::this_grid();
  if (threadIdx.x == 0) xb_words = make_uint4(0u, 0u, 0u, 0u);
  __syncthreads();
  XcdBarrier xb = xcd_barrier_post(p.bar, (volatile LAS unsigned*)&xb_words);

#define LP (*launder_(&p))
  phase_prep(LP, smem);
  if (xb_ld(&p.bar[XB_TMO]) == 0xFFFFFFFFu) grid.sync();
  if (threadIdx.x == 0) {
    XB_SPIN(xb_ld(&p.bar[64]) < 192u, p.bar);
    __builtin_amdgcn_fence(__ATOMIC_ACQUIRE, "agent");
    asm volatile("s_waitcnt vmcnt(0)" ::: "memory");
  }
  __syncthreads();

  for (int l = 0; l < 2; ++l) {
    const bool last = (l == 1);
    if (!last) { phase_router_prep(LP); phase_combine_modulate<false, true>(LP, 0, 0, p.x, p.ctx, nullptr, nullptr, TT); }
    else phase_combine_modulate<true, true>(LP, 0, 1, p.out, p.XC, p.out, p.XC, TT);
    xcd_barrier(xb);
    phase_in_gemm(LP, l, smem);
    xcd_barrier(xb);
    phase_mix_a(LP, l, last, smem);
    xcd_barrier(xb);
    phase_mix_b(LP, l, last, smem);
    xcd_barrier(xb);
    phase_attn(LP, l, last, smem);
    xcd_barrier(xb);
    phase_out_gemm(LP, l, last, last ? p.out : p.x, last ? p.XC : p.ctx, p.out, p.XC, smem);
    xcd_barrier(xb);
    phase_router(LP, l, p.out, p.XC, last ? T_LAT : TT);
    xcd_barrier(xb);
    phase_topk(LP, last, smem);
    phase_modulate<4>(LP, l, p.out, p.XC, last ? T_LAT : TT, 3, last ? 32 : 64);
    xcd_barrier(xb);
    phase_moe_up(LP, l, last, smem);
    xcd_barrier(xb);
    phase_moe_down(LP, l, last, smem);
    xcd_barrier(xb);
  }
  phase_combine_modulate<true, false>(LP, 1, 1, p.out, p.XC, p.out, p.XC, T_LAT);
#undef LP
}

extern "C" void kernel_launch(void* const* d_in, const int* in_sizes, int n_in, void* d_out, int out_size, void* d_ws,
                              size_t ws_size, hipStream_t stream) {
  static int grid_blocks = 0;
  if (!grid_blocks) {
    int dev = 0, cus = 0, per_cu = 0;
    hipGetDevice(&dev);
    hipDeviceGetAttribute(&cus, hipDeviceAttributeMultiprocessorCount, dev);
    hipOccupancyMaxActiveBlocksPerMultiprocessor(&per_cu, fwd_megakernel, 256, 0);
    if (per_cu > 2) per_cu = 2;
    if (per_cu < 1) per_cu = 1;
    grid_blocks = (cus * per_cu) & ~7;
    if (grid_blocks < 8) grid_blocks = 8;
  }
  Params p{};
  const float* const* in = (const float* const*)d_in;
  p.x = in[0]; p.c = in[1]; p.ctx = in[2]; p.c_ctx = in[3]; p.w_ada = in[4]; p.b_ada = in[5]; p.w_in = in[6];
  p.sgu_norm = in[7]; p.w_sgu = in[8]; p.b_sgu = in[9]; p.q_lora_norm = in[10]; p.w_uq = in[11]; p.kv_lora_norm = in[12];
  p.w_ukv = in[13]; p.q_norm = in[14]; p.k_norm = in[15]; p.w_out = in[16]; p.w_router = in[17]; p.w_gate = in[18];
  p.w_up = in[19]; p.w_down = in[20];
  p.out = (float*)d_out;
  unsigned char* base = (unsigned char*)d_ws;
  size_t off = 0;
  auto alloc = [&](size_t bytes) { void* r = base + off; off += (bytes + 255) & ~(size_t)255; return r; };
  p.bar = (unsigned*)alloc(16384);
  p.mada = (float*)alloc((size_t)2 * 3 * 6144 * 4);
  p.WinT = (u16*)alloc((size_t)2 * 1536 * 1024 * 2);
  p.WuqT = (u16*)alloc((size_t)2 * 768 * 256 * 2);
  p.WukvT = (u16*)alloc((size_t)2 * 1024 * 128 * 2);
  p.WoutT = (u16*)alloc((size_t)2 * 1024 * 1024 * 2);
  p.WguT = (u16*)alloc((size_t)2 * 16 * 1024 * 1024 * 2);
  p.WdT = (u16*)alloc((size_t)2 * 16 * 1024 * 512 * 2);
  p.Wsgu = (u16*)alloc((size_t)2 * 4 * 128 * 128 * 2);
  p.M1 = (u16*)alloc((size_t)128 * 128 * 128 * 2);
  p.M2 = (u16*)alloc((size_t)128 * 256 * 2);
  p.Mc = (u16*)alloc((size_t)256 * 512 * 2);
  p.XC = (float*)alloc((size_t)T_CTX * DM * 4);
  p.AFFT = (float*)alloc((size_t)(32 * SEQ + 32 * CTX) * 4);
  p.GATE = (float*)alloc((size_t)64 * 1024 * 4);
  p.IDXG = (int*)alloc((size_t)64 * 1024 * 4);
  p.INV = (int*)alloc((size_t)TT * 16 * 4);
  p.WR2 = (float*)alloc((size_t)2 * 3 * 16384 * 4);
  p.CE = (float*)alloc((size_t)96 * 4);
  p.GDc = (u16*)alloc((size_t)2 * 2 * CTX * 256 * 2);
  unsigned char* RH = (unsigned char*)alloc((size_t)TT * 1024 * 2);
  p.H = (u16*)RH;
  p.PF = (u16*)RH;
  p.KN = (u16*)(RH + (size_t)2 * 64 * 2 * 128 * 256 * 2);
  p.PX = (u16*)alloc((size_t)TT * 1024 * 2);
  p.YM = (u16*)alloc((size_t)TT * 1024 * 2);
  unsigned char* RA = (unsigned char*)alloc((size_t)2 * 4 * NPOS * 192 * 2);
  unsigned char* RB = (unsigned char*)alloc((size_t)2 * 4 * NPOS * 192 * 2);
  p.GD = (u16*)RA;
  p.Qall = (u16*)RA;
  p.Kb = (u16*)RB;
  p.QR = (u16*)alloc((size_t)TT * 768 * 2);
  p.HID = p.QR;
  p.YB = p.PX;
  p.Vt = (u16*)alloc((size_t)2 * 4 * 128 * NPOS * 2);
  if (off > ws_size) fprintf(stderr, "workspace too small: need %zu have %zu\n", off, ws_size);

  hipMemsetAsync(p.bar, 0, 16384, stream);
  void* args[] = {&p};
  hipError_t e = hipLaunchCooperativeKernel((void*)fwd_megakernel, dim3(grid_blocks), dim3(256), args, 0, stream);
  if (e != hipSuccess) fprintf(stderr, "cooperative launch failed: %s (grid %d)\n", hipGetErrorString(e), grid_blocks);
}
```

```cpp
#include <hip/hip_runtime.h>
#include <hip/hip_cooperative_groups.h>
#include <stdint.h>
#include <stdio.h>
namespace cg = cooperative_groups;

typedef unsigned short u16;
typedef __attribute__((ext_vector_type(8))) short bf16x8;
typedef __attribute__((ext_vector_type(4))) float f32x4;
typedef unsigned __attribute__((ext_vector_type(4))) u32x4;
typedef unsigned __attribute__((ext_vector_type(2))) u32x2;

constexpr int DM = 1024;
constexpr int SEQ = 8192, CTX = 256;
constexpr int T_LAT = 2 * SEQ, T_CTX = 2 * CTX, TT = T_LAT + T_CTX;
constexpr int NPOS = SEQ + CTX;
constexpr int SMEM_BYTES = 71680;

struct Params {
  const float *x, *c, *ctx, *c_ctx, *w_ada, *b_ada, *w_in, *sgu_norm, *w_sgu, *b_sgu, *q_lora_norm, *w_uq,
      *kv_lora_norm, *w_ukv, *q_norm, *k_norm, *w_out, *w_router, *w_gate, *w_up, *w_down;
  float* out;
  unsigned* bar;
  float* mada;
  u16 *WinT, *WuqT, *WukvT, *WoutT, *WguT, *WdT, *Wsgu, *M1, *M2, *Mc;
  float* XC;
  u16 *H, *PX, *YM, *GD, *GDc, *PF, *QR, *KN, *Vt, *Qall, *Kb, *HID;
  float *AFFT, *GATE, *WR2, *CE;
  int *IDXG, *INV;
  u16* YB;
};

typedef float f32x2_t __attribute__((ext_vector_type(2)));
typedef __bf16 bf16x2_t __attribute__((ext_vector_type(2)));
__device__ __forceinline__ unsigned pack2(float a, float b) {
  f32x2_t v = {a, b};
  bf16x2_t r = __builtin_convertvector(v, bf16x2_t);
  return __builtin_bit_cast(unsigned, r);
}
__device__ __forceinline__ u16 f2bf(float f) { return (u16)(pack2(f, 0.f) & 0xffffu); }
__device__ __forceinline__ float bf2f(u16 b) { return __uint_as_float(((unsigned)b) << 16); }
__device__ __forceinline__ float wave_sum(float v) {
#pragma unroll
  for (int o = 32; o; o >>= 1) v += __shfl_xor(v, o);
  return v;
}
__device__ __forceinline__ int tid_() { int t = threadIdx.x; asm volatile("" : "+v"(t)); return t; }
__device__ __forceinline__ const struct Params* launder_(const struct Params* q) { asm volatile("" : "+s"(q)); return q; }
__device__ __forceinline__ int bid_() { int b = blockIdx.x; asm volatile("" : "+s"(b)); return b; }
__device__ __forceinline__ float gelu_tanh(float x) {
  float y = 0.7978845608028654f * (x + 0.044715f * x * x * x);
  return x / (1.f + __expf(-2.f * y));
}
__device__ __forceinline__ float silu_f(float x) { return x / (1.f + __expf(-x)); }

#define XB_TMO 128
#define XB_XCNT(j) (256 + 64 * (j))
#define XB_XSUB(j) (1280 + 64 * (j))
#define XB_XGEN(j) (2304 + 64 * (j))
#define XB_TOP 3328
#define XB_TOPGEN 3392
#define XCD_BAR_WORDS 3456
#define XB_SPIN_CAP (1u << 22)
#define LAS __attribute__((address_space(3)))

__device__ __forceinline__ unsigned xb_ld(unsigned* p) { return __hip_atomic_load(p, __ATOMIC_RELAXED, __HIP_MEMORY_SCOPE_AGENT); }
__device__ __forceinline__ unsigned xb_add(unsigned* p, unsigned v) { return __hip_atomic_fetch_add(p, v, __ATOMIC_RELAXED, __HIP_MEMORY_SCOPE_AGENT); }
__device__ __forceinline__ unsigned xb_xcc_id() { return (unsigned)__builtin_amdgcn_s_getreg((3 << 11) | 20) & 0xFu; }
#define XB_SPIN(cond, bar)                                            \
  do {                                                                \
    unsigned _sp = 0;                                                 \
    while (cond) {                                                    \
      __builtin_amdgcn_s_sleep(1);                                    \
      if ((++_sp & 255u) == 0u) {                                     \
        if (xb_ld(&(bar)[XB_TMO])) break;                             \
        if (_sp > XB_SPIN_CAP) { atomicAdd(&(bar)[XB_TMO], 1u); break; } \
      }                                                               \
    }                                                                 \
  } while (0)

struct XcdBarrier {
  unsigned* bar;
  unsigned x;
  volatile LAS unsigned* st;
};
__device__ __forceinline__ XcdBarrier xcd_barrier_post(unsigned* bar, volatile LAS unsigned* st) {
  XcdBarrier b;
  b.bar = bar;
  b.x = xb_xcc_id();
  b.st = st;
  if (threadIdx.x == 0) (void)xb_add(&bar[XB_XCNT(b.x)], 1u);
  return b;
}
__device__ __forceinline__ void xcd_barrier_complete(unsigned* bar, unsigned x, unsigned& nloc, unsigned& nx) {
  const unsigned G = gridDim.x * gridDim.y * gridDim.z;
  unsigned sum, cnt, mine, sp = 0u;
  for (;;) {
    sum = 0u; cnt = 0u; mine = 0u;
#pragma unroll
    for (unsigned j = 0; j < 16; ++j) {
      const unsigned c = xb_ld(&bar[XB_XCNT(j)]);
      sum += c; cnt += (c > 0u) ? 1u : 0u; mine = (j == x) ? c : mine;
    }
    if (sum == G) break;
    __builtin_amdgcn_s_sleep(1);
    if ((++sp & 255u) == 0u) {
      if (xb_ld(&bar[XB_TMO])) break;
      if (sp > XB_SPIN_CAP) { atomicAdd(&bar[XB_TMO], 1u); break; }
    }
  }
  nloc = mine > 0u ? mine : 1u;
  nx = cnt > 0u ? cnt : 1u;
}
__device__ __forceinline__ void xcd_barrier(const XcdBarrier& b) {
  asm volatile("s_waitcnt vmcnt(0)" ::: "memory");
  __syncthreads();
  if (threadIdx.x == 0) {
    unsigned* bar = b.bar;
    __builtin_amdgcn_s_waitcnt(0);
    unsigned nloc = b.st[0], nx = b.st[1];
    if (nloc == 0u) { xcd_barrier_complete(bar, b.x, nloc, nx); b.st[0] = nloc; b.st[1] = nx; }
    const unsigned old = xb_add(&bar[XB_XSUB(b.x)], 1u);
    const unsigned gen = old / nloc;
    if (old + 1u == (gen + 1u) * nloc) {
      __builtin_amdgcn_fence(__ATOMIC_RELEASE, "agent");
      asm volatile("s_waitcnt vmcnt(0)" ::: "memory");
      const unsigned og = xb_add(&bar[XB_TOP], 1u);
      const unsigned tg = og / nx;
      if (og + 1u == (tg + 1u) * nx) xb_add(&bar[XB_TOPGEN], 1u);
      else XB_SPIN(xb_ld(&bar[XB_TOPGEN]) == tg, bar);
      __builtin_amdgcn_fence(__ATOMIC_ACQUIRE, "agent");
      xb_add(&bar[XB_XGEN(b.x)], 1u);
      asm volatile("s_waitcnt vmcnt(0)" ::: "memory");
    } else {
      XB_SPIN(xb_ld(&bar[XB_XGEN(b.x)]) == gen, bar);
      __builtin_amdgcn_fence(__ATOMIC_ACQUIRE, "agent");
      asm volatile("s_waitcnt vmcnt(0)" ::: "memory");
    }
  }
  __syncthreads();
}

#define XCD_FOR(u, T)                                                                                         \
  for (int _x = bid_() & 7, _gb = gridDim.x >> 3, _hi = (int)(((long)(_x + 1) * (T)) >> 3),                    \
           u = (int)(((long)_x * (T)) >> 3) + (bid_() >> 3);                                                  \
       u < _hi; u += _gb)

template <int NT, bool BKN, bool MASK = false, bool ROWSS = false, class Epi>
__device__ __forceinline__ void gemm_tile(const u16* __restrict__ A, int lda, const int* __restrict__ arows, int mvalid,
                                          const u16* __restrict__ B, int ldb, int K, unsigned char* smem, Epi epi,
                                          const float* ascale = nullptr) {
  constexpr int BN = NT * 32;
  constexpr int CPR = BN / 8;
  u16* S0 = (u16*)smem;
  const int t = tid_(), lane = t & 63, wid = t >> 6, wr = wid >> 1, wc = wid & 1, l16 = lane & 15, quad = lane >> 4;
  const u16* ap[4];
  const u16* bp[NT];
  unsigned amask = 0u;
#pragma unroll
  for (int i = 0; i < 4; ++i) {
    const int row = (t >> 3) + 32 * i;
    const bool v = MASK ? (row < mvalid) : true;
    amask |= v ? (1u << i) : 0u;
    int r = v ? row : 0;
    if (arows) r = arows[r];
    ap[i] = A + (size_t)r * lda + (t & 7) * 8;
  }
#pragma unroll
  for (int i = 0; i < NT; ++i) {
    if (!BKN) bp[i] = B + (size_t)((t >> 3) + 32 * i) * ldb + (t & 7) * 8;
    else { const int c = t + 256 * i; bp[i] = B + (size_t)(c / CPR) * ldb + (c % CPR) * 8; }
  }
  const size_t bstep = BKN ? (size_t)64 * ldb : (size_t)64;
  int nmi = 4;
  if (MASK) { nmi = (mvalid - wr * 64 + 15) >> 4; nmi = nmi < 0 ? 0 : (nmi > 4 ? 4 : nmi); nmi = __builtin_amdgcn_readfirstlane(nmi); }
  u32x4 ra0[4], rb0[NT], ra1[4], rb1[NT];
#define GEMM_LOAD(RA, RB, kt_)                                                                      \
  {                                                                                                 \
    _Pragma("unroll") for (int i = 0; i < 4; ++i) {                                                 \
      RA[i] = *(const u32x4*)(ap[i] + (size_t)(kt_) * 64);                                          \
      if (MASK && !((amask >> i) & 1u)) RA[i] = (u32x4){0u, 0u, 0u, 0u};                            \
    }                                                                                               \
    _Pragma("unroll") for (int i = 0; i < NT; ++i) RB[i] = *(const u32x4*)(bp[i] + (size_t)(kt_) * bstep); \
  }
#define GEMM_STORE(RA, RB, st_)                                                                     \
  {                                                                                                 \
    u16* As_ = S0 + (st_) * 16384;                                                                  \
    u16* Bs_ = As_ + 8192;                                                                          \
    if (ROWSS) {                                                                                    \
      _Pragma("unroll") for (int i = 0; i < 4; ++i) {                                               \
        const u32x4 w_ = RA[i];                                                                     \
        const float a0 = __uint_as_float(w_.x << 16), a1 = __uint_as_float(w_.x & 0xffff0000u);     \
        const float a2 = __uint_as_float(w_.y << 16), a3 = __uint_as_float(w_.y & 0xffff0000u);     \
        const float a4 = __uint_as_float(w_.z << 16), a5 = __uint_as_float(w_.z & 0xffff0000u);     \
        const float a6 = __uint_as_float(w_.w << 16), a7 = __uint_as_float(w_.w & 0xffff0000u);     \
        ss_[i] += (a0 * a0 + a1 * a1) + (a2 * a2 + a3 * a3) + (a4 * a4 + a5 * a5) + (a6 * a6 + a7 * a7); \
      }                                                                                             \
    }                                                                                               \
    if (ascale) {                                                                                   \
      const float* sc_ = ascale + stk_ * 64 + (t & 7) * 8;                                          \
      const float4 s0_ = *(const float4*)(sc_), s1_ = *(const float4*)(sc_ + 4);                    \
      _Pragma("unroll") for (int i = 0; i < 4; ++i) {                                               \
        u32x4 w_ = RA[i];                                                                           \
        w_.x = pack2(__uint_as_float(w_.x << 16) * s0_.x, __uint_as_float(w_.x & 0xffff0000u) * s0_.y); \
        w_.y = pack2(__uint_as_float(w_.y << 16) * s0_.z, __uint_as_float(w_.y & 0xffff0000u) * s0_.w); \
        w_.z = pack2(__uint_as_float(w_.z << 16) * s1_.x, __uint_as_float(w_.z & 0xffff0000u) * s1_.y); \
        w_.w = pack2(__uint_as_float(w_.w << 16) * s1_.z, __uint_as_float(w_.w & 0xffff0000u) * s1_.w); \
        RA[i] = w_;                                                                                 \
      }                                                                                             \
    }                                                                                               \
    ++stk_;                                                                                         \
    _Pragma("unroll") for (int i = 0; i < 4; ++i) {                                                 \
      const int row = (t >> 3) + 32 * i;                                                            \
      *(u32x4*)(As_ + row * 64 + (((t & 7) ^ ((row >> 1) & 7)) << 3)) = RA[i];                      \
    }                                                                                               \
    if (!BKN) {                                                                                     \
      _Pragma("unroll") for (int i = 0; i < NT; ++i) {                                              \
        const int row = (t >> 3) + 32 * i;                                                          \
        *(u32x4*)(Bs_ + row * 64 + (((t & 7) ^ ((row >> 1) & 7)) << 3)) = RB[i];                    \
      }                                                                                             \
    } else {                                                                                        \
      _Pragma("unroll") for (int i = 0; i < NT; ++i) {                                              \
        const int c = t + 256 * i;                                                                  \
        const int k = c / CPR, n8 = (c % CPR) * 8;                                                  \
        const u32x4 w = RB[i];                                                                      \
        const unsigned e[8] = {w.x & 0xffffu, w.x >> 16, w.y & 0xffffu, w.y >> 16, w.z & 0xffffu, w.z >> 16, w.w & 0xffffu, w.w >> 16}; \
        _Pragma("unroll") for (int j = 0; j < 8; ++j) {                                             \
          const int n = n8 + j;                                                                     \
          Bs_[n * 64 + ((((k >> 3) ^ ((n >> 1) & 7))) << 3) + (k & 7)] = (u16)e[j];                 \
        }                                                                                           \
      }                                                                                             \
    }                                                                                               \
  }
#define GEMM_COMPUTE(st_)                                                                           \
  {                                                                                                 \
    const u16* As_ = S0 + (st_) * 16384;                                                            \
    const u16* Bs_ = As_ + 8192;                                                                    \
    _Pragma("unroll") for (int ks = 0; ks < 2; ++ks) {                                              \
      bf16x8 af[4], bfr[NT];                                                                        \
      _Pragma("unroll") for (int mi = 0; mi < 4; ++mi) {                                            \
        const int row = wr * 64 + mi * 16 + l16;                                                    \
        af[mi] = *(const bf16x8*)(As_ + row * 64 + (((ks * 4 + quad) ^ ((row >> 1) & 7)) << 3));    \
      }                                                                                             \
      _Pragma("unroll") for (int ni = 0; ni < NT; ++ni) {                                           \
        const int row = wc * (BN / 2) + ni * 16 + l16;                                              \
        bfr[ni] = *(const bf16x8*)(Bs_ + row * 64 + (((ks * 4 + quad) ^ ((row >> 1) & 7)) << 3));   \
      }                                                                                             \
      _Pragma("unroll") for (int mi = 0; mi < 4; ++mi)                                              \
        if (!MASK || mi < nmi)                                                                      \
        _Pragma("unroll") for (int ni = 0; ni < NT; ++ni) acc[mi][ni] = __builtin_amdgcn_mfma_f32_16x16x32_bf16(af[mi], bfr[ni], acc[mi][ni], 0, 0, 0); \
    }                                                                                               \
  }
  float ss_[4] = {0.f, 0.f, 0.f, 0.f};
  int stk_ = 0;
  f32x4 acc[4][NT];
#pragma unroll
  for (int i = 0; i < 4; ++i)
#pragma unroll
    for (int j = 0; j < NT; ++j) acc[i][j] = (f32x4){0.f, 0.f, 0.f, 0.f};
  const int nk = K >> 6;
  const int nkm1 = nk - 1;
  __syncthreads();
  GEMM_LOAD(ra0, rb0, 0);
  GEMM_LOAD(ra1, rb1, 1);
  GEMM_STORE(ra0, rb0, 0);
  GEMM_LOAD(ra0, rb0, (2 < nkm1 ? 2 : nkm1));
  __syncthreads();
  for (int kt = 0; kt < nk - 2; kt += 2) {
    GEMM_COMPUTE(0);
    GEMM_STORE(ra1, rb1, 1);
    GEMM_LOAD(ra1, rb1, kt + 3);
    __syncthreads();
    GEMM_COMPUTE(1);
    GEMM_STORE(ra0, rb0, 0);
    GEMM_LOAD(ra0, rb0, (kt + 4 < nkm1 ? kt + 4 : nkm1));
    __syncthreads();
  }
  GEMM_COMPUTE(0);
  GEMM_STORE(ra1, rb1, 1);
  __syncthreads();
  GEMM_COMPUTE(1);
#undef GEMM_LOAD
#undef GEMM_STORE
#undef GEMM_COMPUTE
  if (ROWSS) {
    float* rs = (float*)(smem + 65536);
#pragma unroll
    for (int i = 0; i < 4; ++i) {
      float s = ss_[i];
      s += __shfl_xor(s, 1); s += __shfl_xor(s, 2); s += __shfl_xor(s, 4);
      if ((t & 7) == 0) rs[(t >> 3) + 32 * i] = rsqrtf(s / (float)K + 1e-6f);
    }
    __syncthreads();
  }
  epi(acc, wr * 64 + quad * 4, wc * (BN / 2) + l16);
}

template <int NT, class VF, class RP>
__device__ __forceinline__ void epi_staged_bf16(f32x4 (&acc)[4][NT], int r0, int c0, unsigned char* smem, VF vf, RP rowptr) {
  constexpr int BN = NT * 32, PITCH = BN + 8, CPR = BN / 8;
  u16* Ts = (u16*)smem;
  const int t = tid_();
  __syncthreads();
#pragma unroll
  for (int mi = 0; mi < 4; ++mi)
#pragma unroll
    for (int ni = 0; ni < NT; ++ni)
#pragma unroll
      for (int j = 0; j < 4; ++j) {
        const int r = r0 + mi * 16 + j, c = c0 + ni * 16;
        Ts[r * PITCH + c] = f2bf(vf(r, c, acc[mi][ni][j]));
      }
  __syncthreads();
#pragma unroll
  for (int i = 0; i < CPR / 2; ++i) {
    const int c = t + 256 * i, row = c / CPR, ch = c % CPR;
    u16* d = rowptr(row);
    if (d) *(u32x4*)(d + ch * 8) = *(const u32x4*)(Ts + row * PITCH + ch * 8);
  }
}

template <class RP>
__device__ __forceinline__ void epi_staged_bf16_T(f32x4 (&acc)[4][4], int r0, int c0, unsigned char* smem, RP colptr) {
  constexpr int PITCH = 136;
  u16* Ts = (u16*)smem;
  const int t = tid_();
  __syncthreads();
#pragma unroll
  for (int mi = 0; mi < 4; ++mi)
#pragma unroll
    for (int ni = 0; ni < 4; ++ni) {
      u32x2 pk;
      pk.x = pack2(acc[mi][ni][0], acc[mi][ni][1]);
      pk.y = pack2(acc[mi][ni][2], acc[mi][ni][3]);
      *(u32x2*)(Ts + (c0 + ni * 16) * PITCH + r0 + mi * 16) = pk;
    }
  __syncthreads();
#pragma unroll
  for (int i = 0; i < 8; ++i) {
    const int c = t + 256 * i, col = c >> 4, ch = c & 15;
    *(u32x4*)(colptr(col) + ch * 8) = *(const u32x4*)(Ts + col * PITCH + ch * 8);
  }
}

__device__ __forceinline__ void epi_staged_residual(f32x4 (&acc)[4][4], int r0, int c0, unsigned char* smem, const float* __restrict__ g,
                                                    const float* __restrict__ xs, float* __restrict__ xd) {
  constexpr int PITCH = 132;
  float* Ts = (float*)smem;
  const int t = tid_();
  const int wr = r0 >> 6;
#pragma unroll
  for (int pass = 0; pass < 2; ++pass) {
    __syncthreads();
    if (wr == pass) {
#pragma unroll
      for (int mi = 0; mi < 4; ++mi)
#pragma unroll
        for (int ni = 0; ni < 4; ++ni)
#pragma unroll
          for (int j = 0; j < 4; ++j) Ts[((r0 & 63) + mi * 16 + j) * PITCH + c0 + ni * 16] = acc[mi][ni][j];
    }
    __syncthreads();
#pragma unroll
    for (int i = 0; i < 8; ++i) {
      const int c = t + 256 * i, row = c >> 5, ch = c & 31;
      const float4 a = *(const float4*)(Ts + row * PITCH + ch * 4);
      const float4 gg = *(const float4*)(g + ch * 4);
      const size_t o = (size_t)(pass * 64 + row) * DM + ch * 4;
      float4 x = *(const float4*)(xs + o);
      x.x += gg.x * a.x; x.y += gg.y * a.y; x.z += gg.z * a.z; x.w += gg.w * a.w;
      *(float4*)(xd + o) = x;
    }
  }
}

__device__ __forceinline__ void ada_item(const Params& p, int it, unsigned char* smem) {
  float* sc = (float*)smem;
  float* red = sc + 3072;
  const int t = tid_(), lane = t & 63, wid = t >> 6;
  const int l = it / 96, jc = it % 96;
#pragma unroll
  for (int i = 0; i < 12; ++i) {
    const int idx = t + 256 * i, r = idx >> 10, k = idx & 1023;
    const float cv = r < 2 ? p.c[r * 1024 + k] : p.c_ctx[k];
    sc[idx] = silu_f(cv);
  }
  __syncthreads();
  const float* w = p.w_ada + (size_t)l * 1024 * 6144 + jc * 64 + lane;
  float a0 = 0.f, a1 = 0.f, a2 = 0.f;
  const int kb = wid * 256;
#pragma unroll 8
  for (int k = 0; k < 256; ++k) {
    const float wv = w[(size_t)(kb + k) * 6144];
    a0 += sc[kb + k] * wv;
    a1 += sc[1024 + kb + k] * wv;
    a2 += sc[2048 + kb + k] * wv;
  }
  red[(wid * 3 + 0) * 64 + lane] = a0;
  red[(wid * 3 + 1) * 64 + lane] = a1;
  red[(wid * 3 + 2) * 64 + lane] = a2;
  __syncthreads();
  if (t < 192) {
    const int r = t >> 6, ln = t & 63;
    float s = 0.f;
#pragma unroll
    for (int w4 = 0; w4 < 4; ++w4) s += red[(w4 * 3 + r) * 64 + ln];
    s += p.b_ada[l * 6144 + jc * 64 + ln];
    p.mada[(l * 3 + r) * 6144 + jc * 64 + ln] = s;
  }
  asm volatile("s_waitcnt vmcnt(0)" ::: "memory");
  __syncthreads();
  if (t == 0) {
    __builtin_amdgcn_fence(__ATOMIC_RELEASE, "agent");
    asm volatile("s_waitcnt vmcnt(0)" ::: "memory");
    (void)xb_add(&p.bar[64], 1u);
  }
}

__device__ __forceinline__ void fold_item(const Params& p, int it, unsigned char* smem) {
  float* tile = (float*)smem;
  float* ct = tile + 64 * 65;
  const int t = tid_();
  const int l = it >> 6, rem = it & 63, g = rem >> 4, k0 = (rem & 15) * 64;
#pragma unroll
  for (int i = 0; i < 16; ++i) {
    const int kk = i * 4 + (t >> 6), d = t & 63;
    tile[kk * 65 + d] = p.w_in[(size_t)(l * 1024 + k0 + kk) * 1216 + 512 + g * 64 + d];
  }
  if (t < 64) ct[t] = cospif((float)t / 32.f);
  __syncthreads();
  const int k = t & 63, jg = t >> 6;
  u16* dst = p.WinT + (size_t)l * 1536 * 1024;
  for (int jj = 0; jj < 16; ++jj) {
    const int j = jg + 4 * jj;
    float sr = 0.f, si = 0.f;
#pragma unroll 8
    for (int d = 0; d < 64; ++d) {
      const float v = tile[k * 65 + d];
      const int m = (j * d) & 63;
      sr += v * ct[m];
      si += v * ct[(m - 16) & 63];
    }
    dst[(size_t)(512 + g * 64 + j) * 1024 + k0 + k] = f2bf(sr);
    dst[(size_t)(768 + g * 64 + j) * 1024 + k0 + k] = f2bf(-si);
  }
  __syncthreads();
}

__device__ __forceinline__ void convT_tile(const float* __restrict__ src, int lds, int k0, int c0, u16* __restrict__ dst, int Kd,
                                           int rbase, int mode, int which, unsigned char* smem, const float* __restrict__ kscale = nullptr) {
  float* tile = (float*)smem;
  const int t = tid_();
  float4 v4[4];
#pragma unroll
  for (int i = 0; i < 4; ++i) v4[i] = *(const float4*)(src + (size_t)(k0 + i * 16 + (t >> 4)) * lds + c0 + (t & 15) * 4);
#pragma unroll
  for (int i = 0; i < 4; ++i) {
    const int kk = i * 16 + (t >> 4), cc = (t & 15) * 4;
    const float sc = kscale ? kscale[k0 + kk] : 1.f;
    tile[kk * 65 + cc + 0] = v4[i].x * sc; tile[kk * 65 + cc + 1] = v4[i].y * sc;
    tile[kk * 65 + cc + 2] = v4[i].z * sc; tile[kk * 65 + cc + 3] = v4[i].w * sc;
  }
  __syncthreads();
#pragma unroll
  for (int i = 0; i < 16; ++i) {
    const int cc = i * 4 + (t >> 6), kk = t & 63;
    int row;
    if (mode == 0) row = rbase + cc;
    else { const int f = c0 + cc; row = (((f >> 4) * 2 + which) << 4) + (f & 15); }
    dst[(size_t)row * Kd + k0 + kk] = f2bf(tile[kk * 65 + cc]);
  }
  __syncthreads();
}

__device__ __forceinline__ void conv_item(const Params& p, int it, unsigned char* smem) {
  const int l = it / 6720;
  int r = it % 6720;
  if (r < 240) {
    const int ct = r >> 4, kt = r & 15;
    const int c0 = (ct < 8 ? ct : ct + 4) * 64;
    const int n0 = c0 + (c0 >= 768 ? 256 : 0);
    convT_tile(p.w_in + (size_t)l * 1024 * 1216, 1216, kt * 64, c0, p.WinT + (size_t)l * 1536 * 1024, 1024, n0, 0, 0, smem);
    return;
  }
  r -= 240;
  if (r < 48) {
    const int ct = r >> 2, kt = r & 3;
    convT_tile(p.w_uq + (size_t)l * 256 * 768, 768, kt * 64, ct * 64, p.WuqT + (size_t)l * 768 * 256, 256, ct * 64, 0, 0, smem, p.q_lora_norm + l * 256);
    return;
  }
  r -= 48;
  if (r < 32) {
    const int ct = r >> 1, kt = r & 1;
    convT_tile(p.w_ukv + (size_t)l * 128 * 1024, 1024, kt * 64, ct * 64, p.WukvT + (size_t)l * 1024 * 128, 128, ct * 64, 0, 0, smem, p.kv_lora_norm + l * 128);
    return;
  }
  r -= 32;
  if (r < 256) {
    const int ct = r >> 4, kt = r & 15;
    convT_tile(p.w_out + (size_t)l * 1024 * 1024, 1024, kt * 64, ct * 64, p.WoutT + (size_t)l * 1024 * 1024, 1024, ct * 64, 0, 0, smem);
    return;
  }
  r -= 256;
  if (r < 4096) {
    const int which = r >> 11, r2 = r & 2047, e = r2 >> 7, r3 = r2 & 127, ct = r3 >> 4, kt = r3 & 15;
    const float* src = (which ? p.w_up : p.w_gate) + (size_t)(l * 16 + e) * 1024 * 512;
    convT_tile(src, 512, kt * 64, ct * 64, p.WguT + (size_t)(l * 16 + e) * 1024 * 1024, 1024, 0, 1, which, smem);
    return;
  }
  r -= 4096;
  {
    const int e = r >> 7, r3 = r & 127, ct = r3 >> 3, kt = r3 & 7;
    convT_tile(p.w_down + (size_t)(l * 16 + e) * 512 * 1024, 1024, kt * 64, ct * 64, p.WdT + (size_t)(l * 16 + e) * 1024 * 512, 512, ct * 64, 0, 0, smem);
  }
}

__device__ __forceinline__ void elem_item(const Params& p, int it) {
  const int t = tid_();
  if (it < 128) {
#pragma unroll
    for (int i = 0; i < 4; ++i) { const int idx = it * 1024 + i * 256 + t; p.Wsgu[idx] = f2bf(p.w_sgu[idx]); }
    return;
  }
  it -= 128;
  if (it < 2048) {
#pragma unroll
    for (int i = 0; i < 4; ++i) {
      const int idx = it * 1024 + i * 256 + t;
      const int n1 = idx >> 14, m = (idx >> 7) & 127, kk = idx & 127;
      const int rip = m >> 6, k2 = m & 63, ri = kk >> 6, n2 = kk & 63;
      const int n = n1 + 128 * n2;
      const int ph = (k2 * n) & 8191;
      const float xx = (float)ph / 4096.f;
      const float cs = cospif(xx), sn = sinpif(xx);
      const float v = rip == 0 ? (ri == 0 ? cs : sn) : (ri == 0 ? -sn : cs);
      p.M1[idx] = f2bf(v);
    }
    return;
  }
  it -= 2048;
  if (it < 32) {
#pragma unroll
    for (int i = 0; i < 4; ++i) {
      const int idx = it * 1024 + i * 256 + t;
      const int k1 = idx >> 8, kk = idx & 255, ri = kk >> 7, n1 = kk & 127;
      const int ph = (k1 * n1) & 127;
      const float xx = (float)ph / 64.f;
      p.M2[idx] = f2bf(ri ? sinpif(xx) : cospif(xx));
    }
    return;
  }
  it -= 32;
  {
#pragma unroll
    for (int i = 0; i < 4; ++i) {
      const int idx = it * 1024 + i * 256 + t;
      const int k = idx >> 9, kk = idx & 511, ri = kk >> 8, n = kk & 255;
      const int ph = (k * n) & 255;
      const float xx = (float)ph / 128.f;
      p.Mc[idx] = f2bf(ri ? sinpif(xx) : cospif(xx));
    }
  }
}

__device__ __forceinline__ void phase_prep(const Params& p, unsigned char* smem) {
  const int G = gridDim.x;
  int t = bid_();
  for (; t < 192; t += G) ada_item(p, t, smem);
  t -= 192;
  for (; t < 128; t += G) fold_item(p, t, smem);
  t -= 128;
  for (; t < 13440; t += G) conv_item(p, t, smem);
  t -= 13440;
  for (; t < 2336; t += G) elem_item(p, t);
}

__device__ __forceinline__ int row_cond(int row) { return row < T_LAT ? (row >> 13) : 2; }
__device__ __forceinline__ int row_batch(int row) { return row < T_LAT ? (row >> 13) : ((row - T_LAT) >> 8); }
__device__ __forceinline__ int row_pos(int row) { return row < T_LAT ? (CTX + (row & (SEQ - 1))) : ((row - T_LAT) & (CTX - 1)); }

template <int R>
__device__ __forceinline__ void phase_modulate(const Params& p, int l, const float* xlat, const float* xctx, int nrows, int chunk, int bskip) {
  const int t = tid_(), lane = t & 63, wid = t >> 6;
  const int bb = bid_() - bskip;
  if (bb < 0) return;
  const int gw = bb * 4 + wid, nw = ((int)gridDim.x - bskip) * 4;
  for (int row0 = gw * R; row0 < nrows; row0 += nw * R) {
    const float* xr = row0 < T_LAT ? xlat + (size_t)row0 * DM : xctx + (size_t)(row0 - T_LAT) * DM;
    const float* sh = p.mada + (size_t)(l * 3 + row_cond(row0)) * 6144 + chunk * 1024;
    const float* sc = sh + 1024;
    float4 v[R][4];
#pragma unroll
    for (int r = 0; r < R; ++r)
#pragma unroll
      for (int i = 0; i < 4; ++i) v[r][i] = *(const float4*)(xr + (size_t)r * DM + i * 256 + lane * 4);
    float rstd[R];
#pragma unroll
    for (int r = 0; r < R; ++r) {
      float ss = 0.f;
#pragma unroll
      for (int i = 0; i < 4; ++i) ss += v[r][i].x * v[r][i].x + v[r][i].y * v[r][i].y + v[r][i].z * v[r][i].z + v[r][i].w * v[r][i].w;
      ss = wave_sum(ss);
      rstd[r] = rsqrtf(ss * (1.f / 1024.f) + 1e-6f);
    }
#pragma unroll
    for (int i = 0; i < 4; ++i) {
      const int col = i * 256 + lane * 4;
      const float4 s4 = *(const float4*)(sc + col);
      const float4 h4 = *(const float4*)(sh + col);
#pragma unroll
      for (int r = 0; r < R; ++r) {
        u32x2 pk;
        pk.x = pack2(v[r][i].x * rstd[r] * (1.f + s4.x) + h4.x, v[r][i].y * rstd[r] * (1.f + s4.y) + h4.y);
        pk.y = pack2(v[r][i].z * rstd[r] * (1.f + s4.z) + h4.z, v[r][i].w * rstd[r] * (1.f + s4.w) + h4.w);
        *(u32x2*)(p.H + (size_t)(row0 + r) * DM + col) = pk;
      }
    }
  }
}

__device__ __forceinline__ void phase_router_prep(const Params& p) {
  const int t = tid_(), lane = t & 63, wid = t >> 6;
  for (int i = bid_() * 256 + t; i < 2 * 3 * 16384; i += gridDim.x * 256) {
    const int lc = i >> 14, k = (i >> 4) & 1023, e = i & 15, l = lc / 3;
    p.WR2[i] = (1.f + p.mada[(size_t)lc * 6144 + 4 * 1024 + k]) * p.w_router[(size_t)l * 16384 + k * 16 + e];
  }
  for (int o = bid_() * 4 + wid; o < 96; o += gridDim.x * 4) {
    const int lc = o >> 4, e = o & 15, l = lc / 3;
    float s = 0.f;
    for (int k = lane; k < 1024; k += 64) s += p.mada[(size_t)lc * 6144 + 3 * 1024 + k] * p.w_router[(size_t)l * 16384 + k * 16 + e];
    s = wave_sum(s);
    if (lane == 0) p.CE[o] = s;
  }
}

__device__ __forceinline__ void phase_router(const Params& p, int l, const float* xlat, const float* xctx, int nrows) {
  const int t = tid_(), lane = t & 63, wid = t >> 6, l16 = lane & 15, quad = lane >> 4;
  const int gw = bid_() * 4 + wid, nw = gridDim.x * 4;
  const int ntile = nrows >> 4;
  for (int tile = gw; tile < ntile; tile += nw) {
    const int row0 = tile * 16;
    const int cond = row_cond(row0);
    const float* xr = (row0 < T_LAT ? xlat + (size_t)(row0 + l16) * DM : xctx + (size_t)(row0 - T_LAT + l16) * DM) + quad * 4;
    const float* wp = p.WR2 + (size_t)(l * 3 + cond) * 16384 + quad * 64 + l16;
    f32x4 acc = (f32x4){0.f, 0.f, 0.f, 0.f};
    float ss = 0.f;
#pragma unroll 4
    for (int s = 0; s < 64; ++s) {
      const float4 a = *(const float4*)(xr + s * 16);
      const float b0 = wp[s * 256], b1 = wp[s * 256 + 16], b2 = wp[s * 256 + 32], b3 = wp[s * 256 + 48];
      ss += a.x * a.x + a.y * a.y + a.z * a.z + a.w * a.w;
      acc = __builtin_amdgcn_mfma_f32_16x16x4f32(a.x, b0, acc, 0, 0, 0);
      acc = __builtin_amdgcn_mfma_f32_16x16x4f32(a.y, b1, acc, 0, 0, 0);
      acc = __builtin_amdgcn_mfma_f32_16x16x4f32(a.z, b2, acc, 0, 0, 0);
      acc = __builtin_amdgcn_mfma_f32_16x16x4f32(a.w, b3, acc, 0, 0, 0);
    }
    ss += __shfl_xor(ss, 16);
    ss += __shfl_xor(ss, 32);
    const float rstd = rsqrtf(ss * (1.f / 1024.f) + 1e-6f);
    const float ce = p.CE[(l * 3 + cond) * 16 + l16];
#pragma unroll
    for (int j = 0; j < 4; ++j) {
      const int tk = quad * 4 + j;
      const float r = __shfl(rstd, tk);
      const float lg = acc[j] * r + ce;
      float mx = lg;
#pragma unroll
      for (int o = 8; o; o >>= 1) mx = fmaxf(mx, __shfl_xor(mx, o));
      const float ex = __expf(lg - mx);
      float sm = ex;
#pragma unroll
      for (int o = 8; o; o >>= 1) sm += __shfl_xor(sm, o);
      const float aff = ex / sm;
      const int row = row0 + tk;
      if (row < T_LAT) p.AFFT[(size_t)((row >> 13) * 16 + l16) * SEQ + (row & (SEQ - 1))] = aff;
      else { const int rc = row - T_LAT; p.AFFT[(size_t)32 * SEQ + ((rc >> 8) * 16 + l16) * CTX + (rc & 255)] = aff; }
    }
  }
}

__device__ __forceinline__ void phase_in_gemm(const Params& p, int l, unsigned char* smem) {
  const u16* W = p.WinT + (size_t)l * 1536 * 1024;
  XCD_FOR(t, 132 * 11) {
    const int mt = t / 11, nt = t % 11;
    const int row_base = mt * 128;
    auto epi = [&](f32x4(&acc)[4][4], int r0, int c0) {
      const bool act = nt < 4;
      auto vf = [&](int, int, float v) { return act ? gelu_tanh(v) : v; };
      auto rp = [&](int r) -> u16* {
        const int row = row_base + r;
        if (nt < 4) return p.PX + (size_t)row * 1024 + nt * 128;
        if (nt >= 8) return p.PX + (size_t)row * 1024 + 512 + (nt - 8) * 128;
        const int ri = (nt - 4) >> 1, jx = ((nt - 4) & 1) * 128;
        if (row < T_LAT) return p.GD + ((size_t)((row >> 13) * 2 + ri) * SEQ + (row & (SEQ - 1))) * 256 + jx;
        const int rc = row - T_LAT;
        return p.GDc + ((size_t)((rc >> 8) * 2 + ri) * CTX + (rc & 255)) * 256 + jx;
      };
      epi_staged_bf16<4>(acc, r0, c0, smem, vf, rp);
    };
    gemm_tile<4, false>(p.H + (size_t)row_base * 1024, 1024, nullptr, 128, W + (size_t)nt * 128 * 1024, 1024, 1024, smem, epi);
  }
  XCD_FOR(t, 132) {
    const int row_base = t * 128;
    auto epi = [&](f32x4(&acc)[4][2], int r0, int c0) {
      auto vf = [&](int, int, float v) { return v; };
      auto rp = [&](int r) -> u16* { return p.PX + (size_t)(row_base + r) * 1024 + 896; };
      epi_staged_bf16<2>(acc, r0, c0, smem, vf, rp);
    };
    gemm_tile<2, false>(p.H + (size_t)row_base * 1024, 1024, nullptr, 128, W + (size_t)11 * 128 * 1024, 1024, 1024, smem, epi);
  }
}

__device__ __forceinline__ void phase_rownorm(const Params& p, int l) {
  constexpr int R = 4;
  const int t = tid_(), lane = t & 63, wid = t >> 6;
  const int gw = bid_() * 4 + wid, nw = gridDim.x * 4;
  const float* nv = p.sgu_norm + l * 256 + lane * 4;
  const float* nq = p.q_lora_norm + l * 256 + lane * 4;
  const float* nk = p.kv_lora_norm + l * 128 + lane * 2;
  for (int row0 = gw * R; row0 < TT; row0 += nw * R) {
    u16* px = p.PX + (size_t)row0 * 1024;
    u32x2 rv[R], rq[R];
    unsigned rk[R];
#pragma unroll
    for (int r = 0; r < R; ++r) {
      rv[r] = *(const u32x2*)(px + r * 1024 + 256 + lane * 4);
      rq[r] = *(const u32x2*)(px + r * 1024 + 512 + lane * 4);
      rk[r] = *(const unsigned*)(px + r * 1024 + 768 + lane * 2);
    }
#pragma unroll
    for (int r = 0; r < R; ++r) {
      {
        const float a = bf2f((u16)(rv[r].x & 0xffff)), b = bf2f((u16)(rv[r].x >> 16)), c = bf2f((u16)(rv[r].y & 0xffff)), d = bf2f((u16)(rv[r].y >> 16));
        const float rstd = rsqrtf(wave_sum(a * a + b * b + c * c + d * d) * (1.f / 256.f) + 1e-6f);
        u32x2 o;
        o.x = pack2(a * rstd * nv[0], b * rstd * nv[1]);
        o.y = pack2(c * rstd * nv[2], d * rstd * nv[3]);
        *(u32x2*)(px + r * 1024 + 256 + lane * 4) = o;
      }
      {
        const float a = bf2f((u16)(rq[r].x & 0xffff)), b = bf2f((u16)(rq[r].x >> 16)), c = bf2f((u16)(rq[r].y & 0xffff)), d = bf2f((u16)(rq[r].y >> 16));
        const float rstd = rsqrtf(wave_sum(a * a + b * b + c * c + d * d) * (1.f / 256.f) + 1e-6f);
        u32x2 o;
        o.x = pack2(a * rstd * nq[0], b * rstd * nq[1]);
        o.y = pack2(c * rstd * nq[2], d * rstd * nq[3]);
        *(u32x2*)(px + r * 1024 + 512 + lane * 4) = o;
      }
      {
        const float a = bf2f((u16)(rk[r] & 0xffff)), b = bf2f((u16)(rk[r] >> 16));
        const float rstd = rsqrtf(wave_sum(a * a + b * b) * (1.f / 128.f) + 1e-6f);
        *(unsigned*)(px + r * 1024 + 768 + lane * 2) = pack2(a * rstd * nk[0], b * rstd * nk[1]);
      }
    }
  }
}

__device__ __forceinline__ void phase_mix_a(const Params& p, int l, bool last, unsigned char* smem) {
  {
    const u16* W = p.WuqT + (size_t)l * 768 * 256;
    XCD_FOR(t, 132 * 6) {
      const int mt = t / 6, nt = t % 6, row_base = mt * 128;
      auto epi = [&](f32x4(&acc)[4][4], int r0, int c0) {
        const float* rs = (const float*)(smem + 65536);
        auto vf = [&](int r, int, float v) { return v * rs[r]; };
        auto rp = [&](int r) -> u16* { return p.QR + (size_t)(row_base + r) * 768 + nt * 128; };
        epi_staged_bf16<4>(acc, r0, c0, smem, vf, rp);
      };
      gemm_tile<4, false, false, true>(p.PX + (size_t)row_base * 1024 + 512, 1024, nullptr, 128, W + (size_t)nt * 128 * 256, 256, 256, smem, epi);
    }
  }
  {
    const u16* W = p.WukvT + (size_t)l * 1024 * 128;
    XCD_FOR(t, 132 * 8) {
      const int mt = t >> 3, nt = t & 7, row_base = mt * 128, h = nt >> 1;
      const int b = row_batch(row_base), pos_base = row_pos(row_base);
      auto epi = [&](f32x4(&acc)[4][4], int r0, int c0) {
#pragma unroll
        for (int mi = 0; mi < 4; ++mi)
#pragma unroll
          for (int ni = 0; ni < 4; ++ni) {
            const int col = c0 + ni * 16;
            if ((nt & 1) == 0) {
            } else {
              u32x2 pk;
              pk.x = pack2(acc[mi][ni][0], acc[mi][ni][1]);
              pk.y = pack2(acc[mi][ni][2], acc[mi][ni][3]);
              *(u32x2*)(p.Vt + ((size_t)(b * 4 + h) * 128 + col) * NPOS + pos_base + r0 + mi * 16) = pk;
            }
          }
      };
      auto epi2 = [&](f32x4(&acc)[4][4], int r0, int c0) {
        const float* rs = (const float*)(smem + 65536);
        if ((nt & 1) == 0) {
          auto vf = [&](int r, int, float v) { return v * rs[r]; };
          auto rp = [&](int r) -> u16* { return p.KN + (size_t)(row_base + r) * 512 + h * 128; };
          epi_staged_bf16<4>(acc, r0, c0, smem, vf, rp);
        } else {
#pragma unroll
          for (int mi = 0; mi < 4; ++mi)
#pragma unroll
            for (int j = 0; j < 4; ++j) {
              const float sc = rs[r0 + mi * 16 + j];
#pragma unroll
              for (int ni = 0; ni < 4; ++ni) acc[mi][ni][j] *= sc;
            }
          auto cp = [&](int c) -> u16* { return p.Vt + ((size_t)(b * 4 + h) * 128 + c) * NPOS + pos_base; };
          epi_staged_bf16_T(acc, r0, c0, smem, cp);
        }
      };
      gemm_tile<4, false, false, true>(p.PX + (size_t)row_base * 1024 + 768, 1024, nullptr, 128, W + (size_t)nt * 128 * 128, 128, 128, smem, epi2);
    }
  }
  {
    const int nch = last ? 128 : 132;
    XCD_FOR(t, nch * 4) {
      const int ch = t >> 2, h = t & 3, row_base = ch * 128;
      const float* bs = p.b_sgu + (l * 4 + h) * 128;
      const float* sgn = p.sgu_norm + l * 256 + h * 64;
      float* rsv = (float*)(smem + 65536 + 512);
      {
        const int t3 = tid_(), q = t3 >> 1, half = t3 & 1;
        const u16* vp = p.PX + (size_t)(row_base + q) * 1024 + 256 + half * 128;
        float s = 0.f;
#pragma unroll
        for (int i = 0; i < 16; ++i) {
          const u32x4 w = *(const u32x4*)(vp + i * 8);
          const float a0 = __uint_as_float(w.x << 16), a1 = __uint_as_float(w.x & 0xffff0000u), a2 = __uint_as_float(w.y << 16), a3 = __uint_as_float(w.y & 0xffff0000u);
          const float a4 = __uint_as_float(w.z << 16), a5 = __uint_as_float(w.z & 0xffff0000u), a6 = __uint_as_float(w.w << 16), a7 = __uint_as_float(w.w & 0xffff0000u);
          s += (a0 * a0 + a1 * a1) + (a2 * a2 + a3 * a3) + (a4 * a4 + a5 * a5) + (a6 * a6 + a7 * a7);
        }
        s += __shfl_xor(s, 1);
        __syncthreads();
        if (half == 0) rsv[q] = rsqrtf(s * (1.f / 256.f) + 1e-6f);
      }
      auto epi = [&](f32x4(&acc)[4][2], int r0, int c0) {
        float* Ts = (float*)smem;
        const int t2 = tid_();
        __syncthreads();
#pragma unroll
        for (int mi = 0; mi < 4; ++mi)
#pragma unroll
          for (int ni = 0; ni < 2; ++ni)
#pragma unroll
            for (int j = 0; j < 4; ++j) {
              const int pr = r0 + mi * 16 + j;
              Ts[pr * 68 + c0 + ni * 16] = acc[mi][ni][j] * sgn[c0 + ni * 16] + bs[pr];
            }
        __syncthreads();
#pragma unroll
        for (int i = 0; i < 4; ++i) {
          const int c = t2 + 256 * i, pr = c >> 3, ch = c & 7;
          const size_t o = (size_t)(row_base + pr) * 1024 + h * 64 + ch * 8;
          const u32x4 u = *(const u32x4*)(p.PX + o);
          const float4 z0 = *(const float4*)(Ts + pr * 68 + ch * 8), z1 = *(const float4*)(Ts + pr * 68 + ch * 8 + 4);
          u32x4 r;
          r.x = pack2(bf2f((u16)(u.x & 0xffffu)) * z0.x, bf2f((u16)(u.x >> 16)) * z0.y);
          r.y = pack2(bf2f((u16)(u.y & 0xffffu)) * z0.z, bf2f((u16)(u.y >> 16)) * z0.w);
          r.z = pack2(bf2f((u16)(u.z & 0xffffu)) * z1.x, bf2f((u16)(u.z >> 16)) * z1.y);
          r.w = pack2(bf2f((u16)(u.w & 0xffffu)) * z1.z, bf2f((u16)(u.w >> 16)) * z1.w);
          *(u32x4*)(p.YM + o) = r;
        }
      };
      gemm_tile<2, true>(p.Wsgu + (size_t)(l * 4 + h) * 16384, 128, nullptr, 128, p.PX + (size_t)row_base * 1024 + 256 + h * 64, 1024, 128, smem, epi, rsv);
    }
  }
  {
    XCD_FOR(t, 512) {
      const int nh = t & 1, n1 = (t >> 1) & 127, b = t >> 8;
      auto epi = [&](f32x4(&acc)[4][4], int r0, int c0) {
        auto vf = [&](int, int, float v) { return v; };
        auto rp = [&](int m) -> u16* { const int rip = m >> 6, k2 = m & 63; return p.PF + ((size_t)((b * 64 + k2) * 2 + rip) * 128 + n1) * 256 + nh * 128; };
        epi_staged_bf16<4>(acc, r0, c0, smem, vf, rp);
      };
      gemm_tile<4, true>(p.M1 + (size_t)n1 * 16384, 128, nullptr, 128, p.GD + (size_t)b * 2 * SEQ * 256 + (size_t)n1 * 256 + nh * 128, 128 * 256, 128, smem, epi);
    }
  }
  if (!last) {
    for (int t = bid_(); t < 8; t += gridDim.x) {
      const int nh = t & 1, mt = (t >> 1) & 1, b = t >> 2;
      auto epi = [&](f32x4(&acc)[4][4], int r0, int c0) {
#pragma unroll
        for (int mi = 0; mi < 4; ++mi)
#pragma unroll
          for (int ni = 0; ni < 4; ++ni)
#pragma unroll
            for (int j = 0; j < 4; ++j) {
              const int k = mt * 128 + r0 + mi * 16 + j;
              p.YM[(size_t)(T_LAT + b * CTX + k) * 1024 + 256 + nh * 128 + c0 + ni * 16] = f2bf(acc[mi][ni][j] * (1.f / 128.f));
            }
      };
      gemm_tile<4, true>(p.Mc + (size_t)mt * 128 * 512, 512, nullptr, 128, p.GDc + (size_t)b * 2 * CTX * 256 + nh * 128, 256, 512, smem, epi);
    }
  }
}

__device__ __forceinline__ void phase_mix_b(const Params& p, int l, bool last, unsigned char* smem) {
  XCD_FOR(t, 512) {
    const int nq = t & 3, k2 = (t >> 2) & 63, b = t >> 8;
    auto epi = [&](f32x4(&acc)[4][2], int r0, int c0) {
      auto vf = [&](int, int, float v) { return v * 0.001381067932004976f; };
      auto rp = [&](int k1) -> u16* { return p.YM + (size_t)(b * SEQ + 64 * k1 + k2) * 1024 + 256 + nq * 64; };
      epi_staged_bf16<2>(acc, r0, c0, smem, vf, rp);
    };
    gemm_tile<2, true>(p.M2, 256, nullptr, 128, p.PF + (size_t)(b * 64 + k2) * 2 * 128 * 256 + nq * 64, 256, 256, smem, epi);
  }
  const int tt = tid_(), lane = tt & 63, wid = tt >> 6;
  const int gw = bid_() * 4 + wid, nw = gridDim.x * 4;
  const float QSCALE = 0.07216878364870322f * 1.4426950408889634f;
  for (int row = gw; row < TT; row += nw) {
    const bool lat = row < T_LAT;
    const int b = row_batch(row), pos = row_pos(row);
    float cs = 1.f, sn = 0.f;
    if (lat) {
      const int n = row & (SEQ - 1);
      const int r = lane, sub = r & 31, i = sub & 15;
      const float ps = (r < 32) ? (float)(n >> 6) : (float)(n & 63);
      const float fr = __builtin_amdgcn_exp2f(-(float)i * 0.83048202372184058696f);
      const float ang = ps * fr;
      sn = __sinf(ang);
      cs = __cosf(ang);
    }
    const bool hi = ((lane & 31) >= 16);
    if (lat || !last) {
#pragma unroll
      for (int h = 0; h < 4; ++h) {
        const u16* q = p.QR + (size_t)row * 768 + h * 192;
        float v0 = bf2f(q[lane]), v1 = bf2f(q[lane + 64]), v2 = bf2f(q[lane + 128]);
        const float ss = wave_sum(v0 * v0 + v1 * v1 + v2 * v2);
        const float rstd = rsqrtf(ss * (1.f / 192.f) + 1e-6f);
        const float* qn = p.q_norm + l * 192;
        v0 *= rstd * qn[lane]; v1 *= rstd * qn[lane + 64]; v2 *= rstd * qn[lane + 128];
        if (lat) {
          const float xp = __shfl_xor(v2, 16);
          v2 = hi ? (xp * sn + v2 * cs) : (v2 * cs - xp * sn);
        }
        u16* o = p.Qall + ((size_t)(b * 4 + h) * NPOS + pos) * 192;
        o[lane] = f2bf(v0 * QSCALE); o[lane + 64] = f2bf(v1 * QSCALE); o[lane + 128] = f2bf(v2 * QSCALE);
      }
    }
    {
      const float kr = bf2f(p.PX[(size_t)row * 1024 + 896 + lane]);
#pragma unroll
      for (int h = 0; h < 4; ++h) {
        const u16* kk = p.KN + (size_t)row * 512 + h * 128;
        float v0 = bf2f(kk[lane]), v1 = bf2f(kk[lane + 64]), v2 = kr;
        const float ss = wave_sum(v0 * v0 + v1 * v1 + v2 * v2);
        const float rstd = rsqrtf(ss * (1.f / 192.f) + 1e-6f);
        const float* kn = p.k_norm + l * 192;
        v0 *= rstd * kn[lane]; v1 *= rstd * kn[lane + 64]; v2 *= rstd * kn[lane + 128];
        if (lat) {
          const float xp = __shfl_xor(v2, 16);
          v2 = hi ? (xp * sn + v2 * cs) : (v2 * cs - xp * sn);
        }
        u16* o = p.Kb + ((size_t)(b * 4 + h) * NPOS + pos) * 192;
        o[lane] = f2bf(v0); o[lane + 64] = f2bf(v1); o[lane + 128] = f2bf(v2);
      }
    }
  }
}

__device__ __forceinline__ void attn_item(const Params& p, int b, int h, int qt, float shift, unsigned char* smem) {
  constexpr int STAGE = 32 * 208 + 128 * 40;
  u16* sbase = (u16*)smem;
  const int t = tid_(), lane = t & 63, wid = t >> 6, l16 = lane & 15, quad = lane >> 4;
  const int nkeys = (qt < 2) ? CTX : NPOS;
  const int ntile = nkeys >> 5;
  const u16* Qp = p.Qall + ((size_t)(b * 4 + h) * NPOS + qt * 128 + wid * 32) * 192;
  const u16* kp = p.Kb + (size_t)(b * 4 + h) * NPOS * 192 + t * 8;
  const u16* vp = p.Vt + (size_t)(b * 4 + h) * 128 * NPOS + (size_t)(t >> 2) * NPOS + (t & 3) * 8;
  const u16* qlane = Qp + (size_t)l16 * 192 + quad * 8;
  bf16x8 bq[2][6];
#pragma unroll
  for (int qi = 0; qi < 2; ++qi)
#pragma unroll
    for (int ks = 0; ks < 6; ++ks) bq[qi][ks] = *(const bf16x8*)(qlane + qi * 16 * 192 + ks * 32);
  f32x4 o[8][2];
#pragma unroll
  for (int vt = 0; vt < 8; ++vt)
#pragma unroll
    for (int qi = 0; qi < 2; ++qi) o[vt][qi] = (f32x4){0.f, 0.f, 0.f, 0.f};
  float lrun0 = 0.f, lrun1 = 0.f;
  u32x4 rk[3], rv[2];
  f32x4 sA[2][2], sB[2][2];
#define ATT_LOAD(kt_)                                                                                   \
  {                                                                                                     \
    _Pragma("unroll") for (int i = 0; i < 3; ++i) rk[i] = *(const u32x4*)(kp + (size_t)(kt_) * 6144 + i * 2048); \
    _Pragma("unroll") for (int i = 0; i < 2; ++i) rv[i] = *(const u32x4*)(vp + (size_t)(64 * i) * NPOS + (kt_) * 32); \
  }
#define ATT_STORE(st_)                                                                                  \
  {                                                                                                     \
    u16* kd = sbase + (st_) * STAGE;                                                                    \
    _Pragma("unroll") for (int i = 0; i < 3; ++i) {                                                     \
      const int c = t + 256 * i;                                                                        \
      *(u32x4*)(kd + (c / 24) * 208 + (c % 24) * 8) = rk[i];                                            \
    }                                                                                                   \
    _Pragma("unroll") for (int i = 0; i < 2; ++i) *(u32x4*)(kd + 6656 + ((t >> 2) + 64 * i) * 40 + (t & 3) * 8) = rv[i]; \
  }
#define ATT_S(SX, kst_)                                                                                 \
  {                                                                                                     \
    const u16* Ks = sbase + (kst_) * STAGE;                                                             \
    _Pragma("unroll") for (int a = 0; a < 2; ++a)                                                       \
      _Pragma("unroll") for (int qi = 0; qi < 2; ++qi) SX[a][qi] = (f32x4){0.f, 0.f, 0.f, 0.f};         \
    _Pragma("unroll") for (int ks = 0; ks < 6; ++ks) {                                                  \
      _Pragma("unroll") for (int a = 0; a < 2; ++a) {                                                   \
        const bf16x8 kf = *(const bf16x8*)(Ks + (a * 16 + l16) * 208 + ks * 32 + quad * 8);             \
        _Pragma("unroll") for (int qi = 0; qi < 2; ++qi) SX[a][qi] = __builtin_amdgcn_mfma_f32_16x16x32_bf16(kf, bq[qi][ks], SX[a][qi], 0, 0, 0); \
      }                                                                                                 \
    }                                                                                                   \
  }
#define ATT_VLOAD(vst_, hv_)                                                                            \
  {                                                                                                     \
    const u16* Vs = sbase + (vst_) * STAGE + 6656;                                                      \
    _Pragma("unroll") for (int vt = 0; vt < 4; ++vt) {                                                  \
      const u16* vb = Vs + (((hv_) * 4 + vt) * 16 + l16) * 40 + quad * 4;                               \
      const u32x2 va = *(const u32x2*)(vb);                                                             \
      const u32x2 vc = *(const u32x2*)(vb + 16);                                                        \
      const u32x4 vw = {va.x, va.y, vc.x, vc.y};                                                        \
      vfr[vt] = (bf16x8)vw;                                                                             \
    }                                                                                                   \
  }
#define ATT_FINISH(SX, vst_)                                                                            \
  {                                                                                                     \
    bf16x8 pb[2];                                                                                       \
    _Pragma("unroll") for (int qi = 0; qi < 2; ++qi) {                                                  \
      float psum = 0.f;                                                                                 \
      _Pragma("unroll") for (int a = 0; a < 2; ++a)                                                     \
        _Pragma("unroll") for (int j = 0; j < 4; ++j) {                                                 \
          const float pe = __builtin_amdgcn_exp2f(SX[a][qi][j]);                                        \
          SX[a][qi][j] = pe;                                                                            \
          psum += pe;                                                                                   \
        }                                                                                               \
      if (qi) lrun1 += psum; else lrun0 += psum;                                                        \
      u32x4 pk;                                                                                         \
      pk.x = pack2(SX[0][qi][0], SX[0][qi][1]);                                                         \
      pk.y = pack2(SX[0][qi][2], SX[0][qi][3]);                                                         \
      pk.z = pack2(SX[1][qi][0], SX[1][qi][1]);                                                         \
      pk.w = pack2(SX[1][qi][2], SX[1][qi][3]);                                                         \
      pb[qi] = (bf16x8)pk;                                                                              \
    }                                                                                                   \
    _Pragma("unroll") for (int vt = 0; vt < 4; ++vt)                                                    \
      _Pragma("unroll") for (int qi = 0; qi < 2; ++qi) o[vt][qi] = __builtin_amdgcn_mfma_f32_16x16x32_bf16(vfr[vt], pb[qi], o[vt][qi], 0, 0, 0); \
    ATT_VLOAD(vst_, 1);                                                                                 \
    _Pragma("unroll") for (int vt = 0; vt < 4; ++vt)                                                    \
      _Pragma("unroll") for (int qi = 0; qi < 2; ++qi) o[4 + vt][qi] = __builtin_amdgcn_mfma_f32_16x16x32_bf16(vfr[vt], pb[qi], o[4 + vt][qi], 0, 0, 0); \
  }
#define ATT_SHIFT(SX)                                                                                   \
  if (shift > 0.f) {                                                                                    \
    _Pragma("unroll") for (int a = 0; a < 2; ++a)                                                       \
      _Pragma("unroll") for (int qi = 0; qi < 2; ++qi) {                                                \
        SX[a][qi][0] -= shift; SX[a][qi][1] -= shift; SX[a][qi][2] -= shift; SX[a][qi][3] -= shift;     \
      }                                                                                                 \
  }
#define ATT_STEP(SNEW, SOLD, tt_)                                                                       \
  {                                                                                                     \
    const int tn_ = ((tt_) + 1 < ntile) ? (tt_) + 1 : ntile - 1;                                        \
    ATT_LOAD(tn_);                                                                                      \
    bf16x8 vfr[4];                                                                                      \
    ATT_VLOAD(((tt_) - 1) % 3, 0);                                                                      \
    ATT_SHIFT(SOLD);                                                                                    \
    ATT_S(SNEW, (tt_) % 3);                                                                             \
    ATT_FINISH(SOLD, ((tt_) - 1) % 3);                                                                  \
    ATT_STORE(((tt_) + 1) % 3);                                                                         \
    __syncthreads();                                                                                    \
  }
  __syncthreads();
  ATT_LOAD(0);
  ATT_STORE(0);
  ATT_LOAD(1);
  __syncthreads();
  ATT_S(sA, 0);
  ATT_STORE(1);
  __syncthreads();
#pragma unroll 1
  for (int tt = 1; tt < ntile - 1; tt += 2) {
    ATT_STEP(sB, sA, tt);
    ATT_STEP(sA, sB, tt + 1);
  }
  ATT_STEP(sB, sA, ntile - 1);
  {
    bf16x8 vfr[4];
    ATT_VLOAD((ntile - 1) % 3, 0);
    ATT_SHIFT(sB);
    ATT_FINISH(sB, (ntile - 1) % 3);
  }
  __syncthreads();
#undef ATT_LOAD
#undef ATT_STORE
#undef ATT_S
#undef ATT_VLOAD
#undef ATT_FINISH
#undef ATT_STEP
#undef ATT_SHIFT
#pragma unroll
  for (int qi = 0; qi < 2; ++qi) {
    float ls = qi ? lrun1 : lrun0;
    ls += __shfl_xor(ls, 16);
    ls += __shfl_xor(ls, 32);
    const float inv = 1.f / ls;
    const int pos = qt * 128 + wid * 32 + qi * 16 + l16;
    const int row = (pos < CTX) ? (T_LAT + b * CTX + pos) : (b * SEQ + pos - CTX);
    u16* orow = p.YM + (size_t)row * 1024 + 512 + h * 128 + quad * 4;
#pragma unroll
    for (int vt = 0; vt < 8; ++vt) {
      u32x2 pk;
      pk.x = pack2(o[vt][qi][0] * inv, o[vt][qi][1] * inv);
      pk.y = pack2(o[vt][qi][2] * inv, o[vt][qi][3] * inv);
      *(u32x2*)(orow + vt * 16) = pk;
    }
  }
}

__device__ __forceinline__ void phase_attn(const Params& p, int l, bool last, unsigned char* smem) {
  float shift;
  {
    const int lane = tid_() & 63;
    float mq = 0.f, mk = 0.f;
#pragma unroll
    for (int i = 0; i < 3; ++i) { mq = fmaxf(mq, fabsf(p.q_norm[l * 192 + lane + 64 * i])); mk = fmaxf(mk, fabsf(p.k_norm[l * 192 + lane + 64 * i])); }
#pragma unroll
    for (int o = 32; o; o >>= 1) { mq = fmaxf(mq, __shfl_xor(mq, o)); mk = fmaxf(mk, __shfl_xor(mk, o)); }
    const float bound = 192.f * mq * mk * (0.07216878364870322f * 1.4426950408889634f);
    shift = fmaxf(0.f, bound - 24.f);
  }
  const int x = bid_() & 7, j = bid_() >> 3, gb = gridDim.x >> 3;
  for (int q = j; q < 64; q += gb) attn_item(p, x >> 2, x & 3, 2 + q, shift, smem);
  if (!last)
    for (int q = j; q < 2; q += gb) attn_item(p, x >> 2, x & 3, q, shift, smem);
}

__device__ __forceinline__ void phase_out_gemm(const Params& p, int l, bool last, const float* slat, const float* sctx, float* dlat, float* dctx, unsigned char* smem) {
  const u16* W = p.WoutT + (size_t)l * 1024 * 1024;
  XCD_FOR(t, 128 * 8) {
    const int mt = t >> 3, nt = t & 7, row_base = mt * 128;
    const float* g1 = p.mada + (size_t)(l * 3 + (row_base >> 13)) * 6144 + 2 * 1024 + nt * 128;
    const float* xs = slat + (size_t)row_base * DM;
    float* xd = dlat + (size_t)row_base * DM;
    auto epi = [&](f32x4(&acc)[4][4], int r0, int c0) { epi_staged_residual(acc, r0, c0, smem, g1, xs + nt * 128, xd + nt * 128); };
    gemm_tile<4, false>(p.YM + (size_t)row_base * 1024, 1024, nullptr, 128, W + (size_t)nt * 128 * 1024, 1024, 1024, smem, epi);
  }
  if (!last) {
    XCD_FOR(t, 4 * 32) {
      const int mt = t >> 5, nt = t & 31, row_base = mt * 128;
      const float* g1 = p.mada + (size_t)(l * 3 + 2) * 6144 + 2 * 1024 + nt * 32;
      const float* xs = sctx + (size_t)row_base * DM;
      float* xd = dctx + (size_t)row_base * DM;
      auto epi = [&](f32x4(&acc)[4][1], int r0, int c0) {
#pragma unroll
        for (int mi = 0; mi < 4; ++mi) {
          const float g = g1[c0];
#pragma unroll
          for (int j = 0; j < 4; ++j) {
            const size_t o = (size_t)(r0 + mi * 16 + j) * DM + nt * 32 + c0;
            xd[o] = xs[o] + g * acc[mi][0][j];
          }
        }
      };
      gemm_tile<1, false>(p.YM + (size_t)(T_LAT + row_base) * 1024, 1024, nullptr, 128, W + (size_t)nt * 32 * 1024, 1024, 1024, smem, epi);
    }
  }
}

__device__ __forceinline__ unsigned block_incl_scan(unsigned x, unsigned* wsum, int lane, int wid, unsigned& total) {
  unsigned v = x;
#pragma unroll
  for (int off = 1; off < 64; off <<= 1) {
    const unsigned n = __shfl_up(v, off);
    if (lane >= off) v += n;
  }
  __syncthreads();
  if (lane == 63) wsum[wid] = v;
  __syncthreads();
  const unsigned w0 = wsum[0], w1 = wsum[1], w2 = wsum[2], w3 = wsum[3];
  total = w0 + w1 + w2 + w3;
  const unsigned base = (wid > 0 ? w0 : 0u) + (wid > 1 ? w1 : 0u) + (wid > 2 ? w2 : 0u);
  return base + v;
}

__device__ __forceinline__ void phase_topk(const Params& p, bool last, unsigned char* smem) {
  unsigned* key = (unsigned*)smem;
  unsigned* hist = key + 8192;
  unsigned* wsum = hist + 256;
  unsigned* sh = wsum + 4;
  const int t = tid_(), lane = t & 63, wid = t >> 6;
  const int ninst = last ? 32 : 64;
  for (int inst = bid_(); inst < ninst; inst += gridDim.x) {
    const bool lat = inst < 32;
    const int n = lat ? SEQ : CTX, cap = lat ? 1024 : 32;
    const float* src = lat ? p.AFFT + (size_t)inst * SEQ : p.AFFT + (size_t)32 * SEQ + (inst - 32) * CTX;
    const int rowbase = lat ? (inst >> 4) * SEQ : T_LAT + ((inst - 32) >> 4) * CTX;
    for (int i = t; i < n; i += 256) key[i] = __float_as_uint(src[i]);
    unsigned prefix = 0u, mask = 0u, remaining = (unsigned)cap;
    for (int shift = 24; shift >= 0; shift -= 8) {
      hist[t] = 0u;
      __syncthreads();
      for (int i = t; i < n; i += 256) {
        const unsigned k = key[i];
        if ((k & mask) == prefix) atomicAdd(&hist[(k >> shift) & 255u], 1u);
      }
      __syncthreads();
      const unsigned hc = hist[t];
      unsigned total;
      const unsigned incl = block_incl_scan(hc, wsum, lane, wid, total);
      const unsigned suf = total - incl + hc;
      const unsigned sufn = total - incl;
      if (suf >= remaining && sufn < remaining) { sh[0] = prefix | ((unsigned)t << shift); sh[1] = remaining - sufn; }
      __syncthreads();
      prefix = sh[0];
      remaining = sh[1];
      mask |= (255u << shift);
      __syncthreads();
    }
    const int per = n >> 8;
    unsigned cgt = 0u, ceq = 0u;
    for (int i = 0; i < per; ++i) {
      const unsigned k = key[t * per + i];
      cgt += (k > prefix) ? 1u : 0u;
      ceq += (k == prefix) ? 1u : 0u;
    }
    unsigned ngt, neq;
    unsigned og = block_incl_scan(cgt, wsum, lane, wid, ngt) - cgt;
    unsigned oe = block_incl_scan(ceq, wsum, lane, wid, neq) - ceq;
    int* idx = p.IDXG + (size_t)inst * 1024;
    float* gt = p.GATE + (size_t)inst * 1024;
    int* inv = p.INV + (size_t)rowbase * 16 + (inst & 15);
    for (int i = 0; i < per; ++i) {
      const int e = t * per + i;
      const unsigned k = key[e];
      int slot = -1;
      if (k > prefix) {
        slot = (int)og; ++og;
      } else if (k == prefix) {
        if (oe < remaining) slot = (int)(ngt + oe);
        ++oe;
      }
      if (slot >= 0) { idx[slot] = rowbase + e; gt[slot] = __uint_as_float(k); }
      inv[(size_t)e * 16] = slot;
    }
    __syncthreads();
  }
}

__device__ __forceinline__ void phase_moe_up(const Params& p, int l, bool last, unsigned char* smem) {
  const int npass = last ? 1 : 2;
  for (int pass = 0; pass < npass; ++pass)
  XCD_FOR(t, ((pass == npass - 1) ? 2048 : 256)) {
    int inst, mt, nt, mvalid, hid_row;
    if (pass == npass - 1) { const int e_ = t >> 7, b_ = (t >> 6) & 1; inst = b_ * 16 + e_; mt = (t >> 3) & 7; nt = t & 7; mvalid = 128; hid_row = inst * 1024 + mt * 128; }
    else { const int e_ = t >> 4, b_ = (t >> 3) & 1; inst = 32 + b_ * 16 + e_; mt = 0; nt = t & 7; mvalid = 32; hid_row = 32768 + (inst - 32) * 128; }
    const int e = inst & 15;
    const u16* W = p.WguT + (size_t)(l * 16 + e) * 1024 * 1024 + (size_t)nt * 128 * 1024;
    auto epi = [&](f32x4(&acc)[4][4], int r0, int c0) {
      u16* Ts = (u16*)smem;
      const int t2 = tid_();
      __syncthreads();
#pragma unroll
      for (int mi = 0; mi < 4; ++mi)
#pragma unroll
        for (int n2 = 0; n2 < 2; ++n2)
#pragma unroll
          for (int j = 0; j < 4; ++j) {
            const int m = r0 + mi * 16 + j;
            const int fl = (c0 >> 6) * 32 + n2 * 16 + (c0 & 15);
            Ts[m * 72 + fl] = f2bf(silu_f(acc[mi][2 * n2][j]) * acc[mi][2 * n2 + 1][j]);
          }
      __syncthreads();
#pragma unroll
      for (int i = 0; i < 4; ++i) {
        const int c = t2 + 256 * i, row = c >> 3, ch = c & 7;
        if (row < mvalid) *(u32x4*)(p.HID + (size_t)(hid_row + row) * 512 + nt * 64 + ch * 8) = *(const u32x4*)(Ts + row * 72 + ch * 8);
      }
    };
    if (mvalid == 128) gemm_tile<4, false, false>(p.H, 1024, p.IDXG + (size_t)inst * 1024 + mt * 128, 128, W, 1024, 1024, smem, epi);
    else gemm_tile<4, false, true>(p.H, 1024, p.IDXG + (size_t)inst * 1024 + mt * 128, mvalid, W, 1024, 1024, smem, epi);
  }
}

__device__ __forceinline__ void phase_moe_down(const Params& p, int l, bool last, unsigned char* smem) {
  const int npass = last ? 1 : 2;
  for (int pass = 0; pass < npass; ++pass)
  XCD_FOR(t, ((pass == npass - 1) ? 2048 : 256)) {
    int inst, mt, nt, mvalid, hid_row;
    if (pass == npass - 1) { const int e_ = t >> 7, b_ = (t >> 6) & 1; inst = b_ * 16 + e_; mt = (t >> 3) & 7; nt = t & 7; mvalid = 128; hid_row = inst * 1024 + mt * 128; }
    else { const int e_ = t >> 4, b_ = (t >> 3) & 1; inst = 32 + b_ * 16 + e_; mt = 0; nt = t & 7; mvalid = 32; hid_row = 32768 + (inst - 32) * 128; }
    const int e = inst & 15;
    const float* gate = p.GATE + (size_t)inst * 1024 + mt * 128;
    const u16* W = p.WdT + (size_t)(l * 16 + e) * 1024 * 512 + (size_t)nt * 128 * 512;
    u16* yb = p.YB + (size_t)hid_row * 1024 + nt * 128;
    auto epi = [&](f32x4(&acc)[4][4], int r0, int c0) {
      auto vf = [&](int r, int, float v) { return (r < mvalid ? gate[r] : 0.f) * v; };
      auto rp = [&](int r) -> u16* { return r < mvalid ? yb + (size_t)r * 1024 : nullptr; };
      epi_staged_bf16<4>(acc, r0, c0, smem, vf, rp);
    };
    if (mvalid == 128) gemm_tile<4, false, false>(p.HID + (size_t)hid_row * 512, 512, nullptr, 128, W, 512, 512, smem, epi);
    else gemm_tile<4, false, true>(p.HID + (size_t)hid_row * 512, 512, nullptr, mvalid, W, 512, 512, smem, epi);
  }
}

template <bool COMBINE, bool MOD>
__device__ __forceinline__ void phase_combine_modulate(const Params& p, int lprev, int lnext, const float* xlat, const float* xctx,
                                                       float* olat, float* octx, int nrows) {
  constexpr int R = 2;
  const int t = tid_(), lane = t & 63, wid = t >> 6;
  const int gw = bid_() * 4 + wid, nw = gridDim.x * 4;
  for (int row0 = gw * R; row0 < nrows; row0 += nw * R) {
    const bool lat = row0 < T_LAT;
    const float* xr = lat ? xlat + (size_t)row0 * DM : xctx + (size_t)(row0 - T_LAT) * DM;
    const int cond = row_cond(row0);
    float4 v[R][4];
#pragma unroll
    for (int r = 0; r < R; ++r)
#pragma unroll
      for (int i = 0; i < 4; ++i) v[r][i] = *(const float4*)(xr + (size_t)r * DM + i * 256 + lane * 4);
    if (COMBINE) {
      const int b = row_batch(row0);
      const int myinv = p.INV[(size_t)row0 * 16 + (lane & 31)];
      const float* g2 = p.mada + (size_t)(lprev * 3 + cond) * 6144 + 5 * 1024;
      float* orow = lat ? olat + (size_t)row0 * DM : octx + (size_t)(row0 - T_LAT) * DM;
#pragma unroll
      for (int r = 0; r < R; ++r) {
        float4 s[4];
#pragma unroll
        for (int i = 0; i < 4; ++i) s[i] = make_float4(0.f, 0.f, 0.f, 0.f);
        unsigned mask = (unsigned)((__ballot(myinv >= 0) >> (16 * r)) & 0xFFFFull);
        while (mask) {
          const int e0 = __builtin_ctz(mask);
          mask &= mask - 1;
          const bool two = mask != 0u;
          const int e1 = two ? __builtin_ctz(mask) : e0;
          mask &= mask - 1;
          const int s0 = __shfl(myinv, 16 * r + e0), s1 = __shfl(myinv, 16 * r + e1);
          const size_t y0 = lat ? (size_t)(b * 16 + e0) * 1024 + s0 : (size_t)32768 + (size_t)(b * 16 + e0) * 128 + s0;
          const size_t y1 = lat ? (size_t)(b * 16 + e1) * 1024 + s1 : (size_t)32768 + (size_t)(b * 16 + e1) * 128 + s1;
          u32x2 a0[4], a1[4];
#pragma unroll
          for (int i = 0; i < 4; ++i) { a0[i] = *(const u32x2*)(p.YB + y0 * 1024 + lane * 4 + i * 256); a1[i] = *(const u32x2*)(p.YB + y1 * 1024 + lane * 4 + i * 256); }
          const float w1 = two ? 1.f : 0.f;
#pragma unroll
          for (int i = 0; i < 4; ++i) {
            s[i].x += bf2f((u16)(a0[i].x & 0xffffu)); s[i].y += bf2f((u16)(a0[i].x >> 16));
            s[i].z += bf2f((u16)(a0[i].y & 0xffffu)); s[i].w += bf2f((u16)(a0[i].y >> 16));
            s[i].x += w1 * bf2f((u16)(a1[i].x & 0xffffu)); s[i].y += w1 * bf2f((u16)(a1[i].x >> 16));
            s[i].z += w1 * bf2f((u16)(a1[i].y & 0xffffu)); s[i].w += w1 * bf2f((u16)(a1[i].y >> 16));
          }
        }
#pragma unroll
        for (int i = 0; i < 4; ++i) {
          const int col = i * 256 + lane * 4;
          const float4 g4 = *(const float4*)(g2 + col);
          v[r][i].x += g4.x * s[i].x; v[r][i].y += g4.y * s[i].y; v[r][i].z += g4.z * s[i].z; v[r][i].w += g4.w * s[i].w;
          *(float4*)(orow + (size_t)r * DM + col) = v[r][i];
        }
      }
    }
    if (MOD) {
      const float* sh = p.mada + (size_t)(lnext * 3 + cond) * 6144;
      const float* sc = sh + 1024;
      float rstd[R];
#pragma unroll
      for (int r = 0; r < R; ++r) {
        float ss = 0.f;
#pragma unroll
        for (int i = 0; i < 4; ++i) ss += v[r][i].x * v[r][i].x + v[r][i].y * v[r][i].y + v[r][i].z * v[r][i].z + v[r][i].w * v[r][i].w;
        rstd[r] = rsqrtf(wave_sum(ss) * (1.f / 1024.f) + 1e-6f);
      }
#pragma unroll
      for (int i = 0; i < 4; ++i) {
        const int col = i * 256 + lane * 4;
        const float4 s4 = *(const float4*)(sc + col);
        const float4 h4 = *(const float4*)(sh + col);
#pragma unroll
        for (int r = 0; r < R; ++r) {
          u32x2 pk;
          pk.x = pack2(v[r][i].x * rstd[r] * (1.f + s4.x) + h4.x, v[r][i].y * rstd[r] * (1.f + s4.y) + h4.y);
          pk.y = pack2(v[r][i].z * rstd[r] * (1.f + s4.z) + h4.z, v[r][i].w * rstd[r] * (1.f + s4.w) + h4.w);
          *(u32x2*)(p.H + (size_t)(row0 + r) * DM + col) = pk;
        }
      }
    }
  }
}

__global__ void __launch_bounds__(256, 2) fwd_megakernel(Params p_unused) {
  const Params& p = *(const Params*)__builtin_amdgcn_kernarg_segment_ptr();
  __shared__ __attribute__((aligned(16))) unsigned char smem[SMEM_BYTES];
  __shared__ uint4 xb_words;
  cg::grid_group grid = cg::this_grid();
  if (threadIdx.x == 0) xb_words = make_uint4(0u, 0u, 0u, 0u);
  __syncthreads();
  XcdBarrier xb = xcd_barrier_post(p.bar, (volatile LAS unsigned*)&xb_words);

#define LP (*launder_(&p))
  phase_prep(LP, smem);
  if (xb_ld(&p.bar[XB_TMO]) == 0xFFFFFFFFu) grid.sync();
  if (threadIdx.x == 0) {
    XB_SPIN(xb_ld(&p.bar[64]) < 192u, p.bar);
    __builtin_amdgcn_fence(__ATOMIC_ACQUIRE, "agent");
    asm volatile("s_waitcnt vmcnt(0)" ::: "memory");
  }
  __syncthreads();

  for (int l = 0; l < 2; ++l) {
    const bool last = (l == 1);
    if (!last) { phase_router_prep(LP); phase_combine_modulate<false, true>(LP, 0, 0, p.x, p.ctx, nullptr, nullptr, TT); }
    else phase_combine_modulate<true, true>(LP, 0, 1, p.out, p.XC, p.out, p.XC, TT);
    xcd_barrier(xb);
    phase_in_gemm(LP, l, smem);
    xcd_barrier(xb);
    phase_mix_a(LP, l, last, smem);
    xcd_barrier(xb);
    phase_mix_b(LP, l, last, smem);
    xcd_barrier(xb);
    phase_attn(LP, l, last, smem);
    xcd_barrier(xb);
    phase_out_gemm(LP, l, last, last ? p.out : p.x, last ? p.XC : p.ctx, p.out, p.XC, smem);
    xcd_barrier(xb);
    phase_router(LP, l, p.out, p.XC, last ? T_LAT : TT);
    xcd_barrier(xb);
    phase_topk(LP, last, smem);
    phase_modulate<4>(LP, l, p.out, p.XC, last ? T_LAT : TT, 3, last ? 32 : 64);
    xcd_barrier(xb);
    phase_moe_up(LP, l, last, smem);
    xcd_barrier(xb);
    phase_moe_down(LP, l, last, smem);
    xcd_barrier(xb);
  }
  phase_combine_modulate<true, false>(LP, 1, 1, p.out, p.XC, p.out, p.XC, T_LAT);
#undef LP
}

extern "C" void kernel_launch(void* const* d_in, const int* in_sizes, int n_in, void* d_out, int out_size, void* d_ws,
                              size_t ws_size, hipStream_t stream) {
  static int grid_blocks = 0;
  if (!grid_blocks) {
    int dev = 0, cus = 0, per_cu = 0;
    hipGetDevice(&dev);
    hipDeviceGetAttribute(&cus, hipDeviceAttributeMultiprocessorCount, dev);
    hipOccupancyMaxActiveBlocksPerMultiprocessor(&per_cu, fwd_megakernel, 256, 0);
    if (per_cu > 2) per_cu = 2;
    if (per_cu < 1) per_cu = 1;
    grid_blocks = (cus * per_cu) & ~7;
    if (grid_blocks < 8) grid_blocks = 8;
  }
  Params p{};
  const float* const* in = (const float* const*)d_in;
  p.x = in[0]; p.c = in[1]; p.ctx = in[2]; p.c_ctx = in[3]; p.w_ada = in[4]; p.b_ada = in[5]; p.w_in = in[6];
  p.sgu_norm = in[7]; p.w_sgu = in[8]; p.b_sgu = in[9]; p.q_lora_norm = in[10]; p.w_uq = in[11]; p.kv_lora_norm = in[12];
  p.w_ukv = in[13]; p.q_norm = in[14]; p.k_norm = in[15]; p.w_out = in[16]; p.w_router = in[17]; p.w_gate = in[18];
  p.w_up = in[19]; p.w_down = in[20];
  p.out = (float*)d_out;
  unsigned char* base = (unsigned char*)d_ws;
  size_t off = 0;
  auto alloc = [&](size_t bytes) { void* r = base + off; off += (bytes + 255) & ~(size_t)255; return r; };
  p.bar = (unsigned*)alloc(16384);
  p.mada = (float*)alloc((size_t)2 * 3 * 6144 * 4);
  p.WinT = (u16*)alloc((size_t)2 * 1536 * 1024 * 2);
  p.WuqT = (u16*)alloc((size_t)2 * 768 * 256 * 2);
  p.WukvT = (u16*)alloc((size_t)2 * 1024 * 128 * 2);
  p.WoutT = (u16*)alloc((size_t)2 * 1024 * 1024 * 2);
  p.WguT = (u16*)alloc((size_t)2 * 16 * 1024 * 1024 * 2);
  p.WdT = (u16*)alloc((size_t)2 * 16 * 1024 * 512 * 2);
  p.Wsgu = (u16*)alloc((size_t)2 * 4 * 128 * 128 * 2);
  p.M1 = (u16*)alloc((size_t)128 * 128 * 128 * 2);
  p.M2 = (u16*)alloc((size_t)128 * 256 * 2);
  p.Mc = (u16*)alloc((size_t)256 * 512 * 2);
  p.XC = (float*)alloc((size_t)T_CTX * DM * 4);
  p.AFFT = (float*)alloc((size_t)(32 * SEQ + 32 * CTX) * 4);
  p.GATE = (float*)alloc((size_t)64 * 1024 * 4);
  p.IDXG = (int*)alloc((size_t)64 * 1024 * 4);
  p.INV = (int*)alloc((size_t)TT * 16 * 4);
  p.WR2 = (float*)alloc((size_t)2 * 3 * 16384 * 4);
  p.CE = (float*)alloc((size_t)96 * 4);
  p.GDc = (u16*)alloc((size_t)2 * 2 * CTX * 256 * 2);
  unsigned char* RH = (unsigned char*)alloc((size_t)TT * 1024 * 2);
  p.H = (u16*)RH;
  p.PF = (u16*)RH;
  p.KN = (u16*)(RH + (size_t)2 * 64 * 2 * 128 * 256 * 2);
  p.PX = (u16*)alloc((size_t)TT * 1024 * 2);
  p.YM = (u16*)alloc((size_t)TT * 1024 * 2);
  unsigned char* RA = (unsigned char*)alloc((size_t)2 * 4 * NPOS * 192 * 2);
  unsigned char* RB = (unsigned char*)alloc((size_t)2 * 4 * NPOS * 192 * 2);
  p.GD = (u16*)RA;
  p.Qall = (u16*)RA;
  p.Kb = (u16*)RB;
  p.QR = (u16*)alloc((size_t)TT * 768 * 2);
  p.HID = p.QR;
  p.YB = p.PX;
  p.Vt = (u16*)alloc((size_t)2 * 4 * 128 * NPOS * 2);
  if (off > ws_size) fprintf(stderr, "workspace too small: need %zu have %zu\n", off, ws_size);

  hipMemsetAsync(p.bar, 0, 16384, stream);
  void* args[] = {&p};
  hipError_t e = hipLaunchCooperativeKernel((void*)fwd_megakernel, dim3(grid_blocks), dim3(256), args, 0, stream);
  if (e != hipSuccess) fprintf(stderr, "cooperative launch failed: %s (grid %d)\n", hipGetErrorString(e), grid_blocks);
}
```

```cpp
#include <hip/hip_runtime.h>
#include <hip/hip_cooperative_groups.h>
#include <stdint.h>
#include <stdio.h>
namespace cg = cooperative_groups;

typedef unsigned short u16;
typedef __attribute__((ext_vector_type(8))) short bf16x8;
typedef __attribute__((ext_vector_type(4))) float f32x4;
typedef unsigned __attribute__((ext_vector_type(4))) u32x4;
typedef unsigned __attribute__((ext_vector_type(2))) u32x2;

constexpr int DM = 1024;
constexpr int SEQ = 8192, CTX = 256;
constexpr int T_LAT = 2 * SEQ, T_CTX = 2 * CTX, TT = T_LAT + T_CTX;
constexpr int NPOS = SEQ + CTX;
constexpr int SMEM_BYTES = 71680;

struct Params {
  const float *x, *c, *ctx, *c_ctx, *w_ada, *b_ada, *w_in, *sgu_norm, *w_sgu, *b_sgu, *q_lora_norm, *w_uq,
      *kv_lora_norm, *w_ukv, *q_norm, *k_norm, *w_out, *w_router, *w_gate, *w_up, *w_down;
  float* out;
  unsigned* bar;
  float* mada;
  u16 *WinT, *WuqT, *WukvT, *WoutT, *WguT, *WdT, *Wsgu, *M1, *M2, *Mc;
  float* XC;
  u16 *H, *PX, *YM, *GD, *GDc, *PF, *QR, *KN, *Vt, *Qall, *Kb, *HID;
  float *AFFT, *GATE, *WR2, *CE;
  int *IDXG, *INV;
  u16* YB;
};

typedef float f32x2_t __attribute__((ext_vector_type(2)));
typedef __bf16 bf16x2_t __attribute__((ext_vector_type(2)));
__device__ __forceinline__ unsigned pack2(float a, float b) {
  f32x2_t v = {a, b};
  bf16x2_t r = __builtin_convertvector(v, bf16x2_t);
  return __builtin_bit_cast(unsigned, r);
}
__device__ __forceinline__ u16 f2bf(float f) { return (u16)(pack2(f, 0.f) & 0xffffu); }
__device__ __forceinline__ float bf2f(u16 b) { return __uint_as_float(((unsigned)b) << 16); }
__device__ __forceinline__ float wave_sum(float v) {
#pragma unroll
  for (int o = 32; o; o >>= 1) v += __shfl_xor(v, o);
  return v;
}
__device__ __forceinline__ int tid_() { int t = threadIdx.x; asm volatile("" : "+v"(t)); return t; }
__device__ __forceinline__ const struct Params* launder_(const struct Params* q) { asm volatile("" : "+s"(q)); return q; }
__device__ __forceinline__ int bid_() { int b = blockIdx.x; asm volatile("" : "+s"(b)); return b; }
__device__ __forceinline__ float gelu_tanh(float x) {
  float y = 0.7978845608028654f * (x + 0.044715f * x * x * x);
  return x / (1.f + __expf(-2.f * y));
}
__device__ __forceinline__ float silu_f(float x) { return x / (1.f + __expf(-x)); }

#define XB_TMO 128
#define XB_XCNT(j) (256 + 64 * (j))
#define XB_XSUB(j) (1280 + 64 * (j))
#define XB_XGEN(j) (2304 + 64 * (j))
#define XB_TOP 3328
#define XB_TOPGEN 3392
#define XCD_BAR_WORDS 3456
#define XB_SPIN_CAP (1u << 22)
#define LAS __attribute__((address_space(3)))

__device__ __forceinline__ unsigned xb_ld(unsigned* p) { return __hip_atomic_load(p, __ATOMIC_RELAXED, __HIP_MEMORY_SCOPE_AGENT); }
__device__ __forceinline__ unsigned xb_add(unsigned* p, unsigned v) { return __hip_atomic_fetch_add(p, v, __ATOMIC_RELAXED, __HIP_MEMORY_SCOPE_AGENT); }
__device__ __forceinline__ unsigned xb_xcc_id() { return (unsigned)__builtin_amdgcn_s_getreg((3 << 11) | 20) & 0xFu; }
#define XB_SPIN(cond, bar)                                            \
  do {                                                                \
    unsigned _sp = 0;                                                 \
    while (cond) {                                                    \
      __builtin_amdgcn_s_sleep(1);                                    \
      if ((++_sp & 255u) == 0u) {                                     \
        if (xb_ld(&(bar)[XB_TMO])) break;                             \
        if (_sp > XB_SPIN_CAP) { atomicAdd(&(bar)[XB_TMO], 1u); break; } \
      }                                                               \
    }                                                                 \
  } while (0)

struct XcdBarrier {
  unsigned* bar;
  unsigned x;
  volatile LAS unsigned* st;
};
__device__ __forceinline__ XcdBarrier xcd_barrier_post(unsigned* bar, volatile LAS unsigned* st) {
  XcdBarrier b;
  b.bar = bar;
  b.x = xb_xcc_id();
  b.st = st;
  if (threadIdx.x == 0) (void)xb_add(&bar[XB_XCNT(b.x)], 1u);
  return b;
}
__device__ __forceinline__ void xcd_barrier_complete(unsigned* bar, unsigned x, unsigned& nloc, unsigned& nx) {
  const unsigned G = gridDim.x * gridDim.y * gridDim.z;
  unsigned sum, cnt, mine, sp = 0u;
  for (;;) {
    sum = 0u; cnt = 0u; mine = 0u;
#pragma unroll
    for (unsigned j = 0; j < 16; ++j) {
      const unsigned c = xb_ld(&bar[XB_XCNT(j)]);
      sum += c; cnt += (c > 0u) ? 1u : 0u; mine = (j == x) ? c : mine;
    }
    if (sum == G) break;
    __builtin_amdgcn_s_sleep(1);
    if ((++sp & 255u) == 0u) {
      if (xb_ld(&bar[XB_TMO])) break;
      if (sp > XB_SPIN_CAP) { atomicAdd(&bar[XB_TMO], 1u); break; }
    }
  }
  nloc = mine > 0u ? mine : 1u;
  nx = cnt > 0u ? cnt : 1u;
}
__device__ __forceinline__ void xcd_barrier(const XcdBarrier& b) {
  asm volatile("s_waitcnt vmcnt(0)" ::: "memory");
  __syncthreads();
  if (threadIdx.x == 0) {
    unsigned* bar = b.bar;
    __builtin_amdgcn_s_waitcnt(0);
    unsigned nloc = b.st[0], nx = b.st[1];
    if (nloc == 0u) { xcd_barrier_complete(bar, b.x, nloc, nx); b.st[0] = nloc; b.st[1] = nx; }
    const unsigned old = xb_add(&bar[XB_XSUB(b.x)], 1u);
    const unsigned gen = old / nloc;
    if (old + 1u == (gen + 1u) * nloc) {
      __builtin_amdgcn_fence(__ATOMIC_RELEASE, "agent");
      asm volatile("s_waitcnt vmcnt(0)" ::: "memory");
      const unsigned og = xb_add(&bar[XB_TOP], 1u);
      const unsigned tg = og / nx;
      if (og + 1u == (tg + 1u) * nx) xb_add(&bar[XB_TOPGEN], 1u);
      else XB_SPIN(xb_ld(&bar[XB_TOPGEN]) == tg, bar);
      __builtin_amdgcn_fence(__ATOMIC_ACQUIRE, "agent");
      xb_add(&bar[XB_XGEN(b.x)], 1u);
      asm volatile("s_waitcnt vmcnt(0)" ::: "memory");
    } else {
      XB_SPIN(xb_ld(&bar[XB_XGEN(b.x)]) == gen, bar);
      __builtin_amdgcn_fence(__ATOMIC_ACQUIRE, "agent");
      asm volatile("s_waitcnt vmcnt(0)" ::: "memory");
    }
  }
  __syncthreads();
}

#define XCD_FOR(u, T)                                                                                         \
  for (int _x = bid_() & 7, _gb = gridDim.x >> 3, _hi = (int)(((long)(_x + 1) * (T)) >> 3),                    \
           u = (int)(((long)_x * (T)) >> 3) + (bid_() >> 3);                                                  \
       u < _hi; u += _gb)

template <int NT, bool BKN, bool MASK = false, bool ROWSS = false, class Epi>
__device__ __forceinline__ void gemm_tile(const u16* __restrict__ A, int lda, const int* __restrict__ arows, int mvalid,
                                          const u16* __restrict__ B, int ldb, int K, unsigned char* smem, Epi epi,
                                          const float* ascale = nullptr) {
  constexpr int BN = NT * 32;
  constexpr int CPR = BN / 8;
  u16* S0 = (u16*)smem;
  const int t = tid_(), lane = t & 63, wid = t >> 6, wr = wid >> 1, wc = wid & 1, l16 = lane & 15, quad = lane >> 4;
  const u16* ap[4];
  const u16* bp[NT];
  unsigned amask = 0u;
#pragma unroll
  for (int i = 0; i < 4; ++i) {
    const int row = (t >> 3) + 32 * i;
    const bool v = MASK ? (row < mvalid) : true;
    amask |= v ? (1u << i) : 0u;
    int r = v ? row : 0;
    if (arows) r = arows[r];
    ap[i] = A + (size_t)r * lda + (t & 7) * 8;
  }
#pragma unroll
  for (int i = 0; i < NT; ++i) {
    if (!BKN) bp[i] = B + (size_t)((t >> 3) + 32 * i) * ldb + (t & 7) * 8;
    else { const int c = t + 256 * i; bp[i] = B + (size_t)(c / CPR) * ldb + (c % CPR) * 8; }
  }
  const size_t bstep = BKN ? (size_t)64 * ldb : (size_t)64;
  int nmi = 4;
  if (MASK) { nmi = (mvalid - wr * 64 + 15) >> 4; nmi = nmi < 0 ? 0 : (nmi > 4 ? 4 : nmi); nmi = __builtin_amdgcn_readfirstlane(nmi); }
  u32x4 ra0[4], rb0[NT], ra1[4], rb1[NT];
#define GEMM_LOAD(RA, RB, kt_)                                                                      \
  {                                                                                                 \
    _Pragma("unroll") for (int i = 0; i < 4; ++i) {                                                 \
      RA[i] = *(const u32x4*)(ap[i] + (size_t)(kt_) * 64);                                          \
      if (MASK && !((amask >> i) & 1u)) RA[i] = (u32x4){0u, 0u, 0u, 0u};                            \
    }                                                                                               \
    _Pragma("unroll") for (int i = 0; i < NT; ++i) RB[i] = *(const u32x4*)(bp[i] + (size_t)(kt_) * bstep); \
  }
#define GEMM_STORE(RA, RB, st_)                                                                     \
  {                                                                                                 \
    u16* As_ = S0 + (st_) * 16384;                                                                  \
    u16* Bs_ = As_ + 8192;                                                                          \
    if (ROWSS) {                                                                                    \
      _Pragma("unroll") for (int i = 0; i < 4; ++i) {                                               \
        const u32x4 w_ = RA[i];                                                                     \
        const float a0 = __uint_as_float(w_.x << 16), a1 = __uint_as_float(w_.x & 0xffff0000u);     \
        const float a2 = __uint_as_float(w_.y << 16), a3 = __uint_as_float(w_.y & 0xffff0000u);     \
        const float a4 = __uint_as_float(w_.z << 16), a5 = __uint_as_float(w_.z & 0xffff0000u);     \
        const float a6 = __uint_as_float(w_.w << 16), a7 = __uint_as_float(w_.w & 0xffff0000u);     \
        ss_[i] += (a0 * a0 + a1 * a1) + (a2 * a2 + a3 * a3) + (a4 * a4 + a5 * a5) + (a6 * a6 + a7 * a7); \
      }                                                                                             \
    }                                                                                               \
    if (ascale) {                                                                                   \
      const float* sc_ = ascale + stk_ * 64 + (t & 7) * 8;                                          \
      const float4 s0_ = *(const float4*)(sc_), s1_ = *(const float4*)(sc_ + 4);                    \
      _Pragma("unroll") for (int i = 0; i < 4; ++i) {                                               \
        u32x4 w_ = RA[i];                                                                           \
        w_.x = pack2(__uint_as_float(w_.x << 16) * s0_.x, __uint_as_float(w_.x & 0xffff0000u) * s0_.y); \
        w_.y = pack2(__uint_as_float(w_.y << 16) * s0_.z, __uint_as_float(w_.y & 0xffff0000u) * s0_.w); \
        w_.z = pack2(__uint_as_float(w_.z << 16) * s1_.x, __uint_as_float(w_.z & 0xffff0000u) * s1_.y); \
        w_.w = pack2(__uint_as_float(w_.w << 16) * s1_.z, __uint_as_float(w_.w & 0xffff0000u) * s1_.w); \
        RA[i] = w_;                                                                                 \
      }                                                                                             \
    }                                                                                               \
    ++stk_;                                                                                         \
    _Pragma("unroll") for (int i = 0; i < 4; ++i) {                                                 \
      const int row = (t >> 3) + 32 * i;                                                            \
      *(u32x4*)(As_ + row * 64 + (((t & 7) ^ ((row >> 1) & 7)) << 3)) = RA[i];                      \
    }                                                                                               \
    if (!BKN) {                                                                                     \
      _Pragma("unroll") for (int i = 0; i < NT; ++i) {                                              \
        const int row = (t >> 3) + 32 * i;                                                          \
        *(u32x4*)(Bs_ + row * 64 + (((t & 7) ^ ((row >> 1) & 7)) << 3)) = RB[i];                    \
      }                                                                                             \
    } else {                                                                                        \
      _Pragma("unroll") for (int i = 0; i < NT; ++i) {                                              \
        const int c = t + 256 * i;                                                                  \
        const int k = c / CPR, n8 = (c % CPR) * 8;                                                  \
        const u32x4 w = RB[i];                                                                      \
        const unsigned e[8] = {w.x & 0xffffu, w.x >> 16, w.y & 0xffffu, w.y >> 16, w.z & 0xffffu, w.z >> 16, w.w & 0xffffu, w.w >> 16}; \
        _Pragma("unroll") for (int j = 0; j < 8; ++j) {                                             \
          const int n = n8 + j;                                                                     \
          Bs_[n * 64 + ((((k >> 3) ^ ((n >> 1) & 7))) << 3) + (k & 7)] = (u16)e[j];                 \
        }                                                                                           \
      }                                                                                             \
    }                                                                                               \
  }
#define GEMM_COMPUTE(st_)                                                                           \
  {                                                                                                 \
    const u16* As_ = S0 + (st_) * 16384;                                                            \
    const u16* Bs_ = As_ + 8192;                                                                    \
    _Pragma("unroll") for (int ks = 0; ks < 2; ++ks) {                                              \
      bf16x8 af[4], bfr[NT];                                                                        \
      _Pragma("unroll") for (int mi = 0; mi < 4; ++mi) {                                            \
        const int row = wr * 64 + mi * 16 + l16;                                                    \
        af[mi] = *(const bf16x8*)(As_ + row * 64 + (((ks * 4 + quad) ^ ((row >> 1) & 7)) << 3));    \
      }                                                                                             \
      _Pragma("unroll") for (int ni = 0; ni < NT; ++ni) {                                           \
        const int row = wc * (BN / 2) + ni * 16 + l16;                                              \
        bfr[ni] = *(const bf16x8*)(Bs_ + row * 64 + (((ks * 4 + quad) ^ ((row >> 1) & 7)) << 3));   \
      }                                                                                             \
      _Pragma("unroll") for (int mi = 0; mi < 4; ++mi)                                              \
        if (!MASK || mi < nmi)                                                                      \
        _Pragma("unroll") for (int ni = 0; ni < NT; ++ni) acc[mi][ni] = __builtin_amdgcn_mfma_f32_16x16x32_bf16(af[mi], bfr[ni], acc[mi][ni], 0, 0, 0); \
    }                                                                                               \
  }
  float ss_[4] = {0.f, 0.f, 0.f, 0.f};
  int stk_ = 0;
  f32x4 acc[4][NT];
#pragma unroll
  for (int i = 0; i < 4; ++i)
#pragma unroll
    for (int j = 0; j < NT; ++j) acc[i][j] = (f32x4){0.f, 0.f, 0.f, 0.f};
  const int nk = K >> 6;
  const int nkm1 = nk - 1;
  __syncthreads();
  GEMM_LOAD(ra0, rb0, 0);
  GEMM_LOAD(ra1, rb1, 1);
  GEMM_STORE(ra0, rb0, 0);
  GEMM_LOAD(ra0, rb0, (2 < nkm1 ? 2 : nkm1));
  __syncthreads();
  for (int kt = 0; kt < nk - 2; kt += 2) {
    GEMM_COMPUTE(0);
    GEMM_STORE(ra1, rb1, 1);
    GEMM_LOAD(ra1, rb1, kt + 3);
    __syncthreads();
    GEMM_COMPUTE(1);
    GEMM_STORE(ra0, rb0, 0);
    GEMM_LOAD(ra0, rb0, (kt + 4 < nkm1 ? kt + 4 : nkm1));
    __syncthreads();
  }
  GEMM_COMPUTE(0);
  GEMM_STORE(ra1, rb1, 1);
  __syncthreads();
  GEMM_COMPUTE(1);
#undef GEMM_LOAD
#undef GEMM_STORE
#undef GEMM_COMPUTE
  if (ROWSS) {
    float* rs = (float*)(smem + 65536);
#pragma unroll
    for (int i = 0; i < 4; ++i) {
      float s = ss_[i];
      s += __shfl_xor(s, 1); s += __shfl_xor(s, 2); s += __shfl_xor(s, 4);
      if ((t & 7) == 0) rs[(t >> 3) + 32 * i] = rsqrtf(s / (float)K + 1e-6f);
    }
    __syncthreads();
  }
  epi(acc, wr * 64 + quad * 4, wc * (BN / 2) + l16);
}

template <int NT, class VF, class RP>
__device__ __forceinline__ void epi_staged_bf16(f32x4 (&acc)[4][NT], int r0, int c0, unsigned char* smem, VF vf, RP rowptr) {
  constexpr int BN = NT * 32, PITCH = BN + 8, CPR = BN / 8;
  u16* Ts = (u16*)smem;
  const int t = tid_();
  __syncthreads();
#pragma unroll
  for (int mi = 0; mi < 4; ++mi)
#pragma unroll
    for (int ni = 0; ni < NT; ++ni)
#pragma unroll
      for (int j = 0; j < 4; ++j) {
        const int r = r0 + mi * 16 + j, c = c0 + ni * 16;
        Ts[r * PITCH + c] = f2bf(vf(r, c, acc[mi][ni][j]));
      }
  __syncthreads();
#pragma unroll
  for (int i = 0; i < CPR / 2; ++i) {
    const int c = t + 256 * i, row = c / CPR, ch = c % CPR;
    u16* d = rowptr(row);
    if (d) *(u32x4*)(d + ch * 8) = *(const u32x4*)(Ts + row * PITCH + ch * 8);
  }
}

template <class RP>
__device__ __forceinline__ void epi_staged_bf16_T(f32x4 (&acc)[4][4], int r0, int c0, unsigned char* smem, RP colptr) {
  constexpr int PITCH = 136;
  u16* Ts = (u16*)smem;
  const int t = tid_();
  __syncthreads();
#pragma unroll
  for (int mi = 0; mi < 4; ++mi)
#pragma unroll
    for (int ni = 0; ni < 4; ++ni) {
      u32x2 pk;
      pk.x = pack2(acc[mi][ni][0], acc[mi][ni][1]);
      pk.y = pack2(acc[mi][ni][2], acc[mi][ni][3]);
      *(u32x2*)(Ts + (c0 + ni * 16) * PITCH + r0 + mi * 16) = pk;
    }
  __syncthreads();
#pragma unroll
  for (int i = 0; i < 8; ++i) {
    const int c = t + 256 * i, col = c >> 4, ch = c & 15;
    *(u32x4*)(colptr(col) + ch * 8) = *(const u32x4*)(Ts + col * PITCH + ch * 8);
  }
}

__device__ __forceinline__ void epi_staged_residual(f32x4 (&acc)[4][4], int r0, int c0, unsigned char* smem, const float* __restrict__ g,
                                                    const float* __restrict__ xs, float* __restrict__ xd) {
  constexpr int PITCH = 132;
  float* Ts = (float*)smem;
  const int t = tid_();
  const int wr = r0 >> 6;
#pragma unroll
  for (int pass = 0; pass < 2; ++pass) {
    __syncthreads();
    if (wr == pass) {
#pragma unroll
      for (int mi = 0; mi < 4; ++mi)
#pragma unroll
        for (int ni = 0; ni < 4; ++ni)
#pragma unroll
          for (int j = 0; j < 4; ++j) Ts[((r0 & 63) + mi * 16 + j) * PITCH + c0 + ni * 16] = acc[mi][ni][j];
    }
    __syncthreads();
#pragma unroll
    for (int i = 0; i < 8; ++i) {
      const int c = t + 256 * i, row = c >> 5, ch = c & 31;
      const float4 a = *(const float4*)(Ts + row * PITCH + ch * 4);
      const float4 gg = *(const float4*)(g + ch * 4);
      const size_t o = (size_t)(pass * 64 + row) * DM + ch * 4;
      float4 x = *(const float4*)(xs + o);
      x.x += gg.x * a.x; x.y += gg.y * a.y; x.z += gg.z * a.z; x.w += gg.w * a.w;
      *(float4*)(xd + o) = x;
    }
  }
}

__device__ __forceinline__ void ada_item(const Params& p, int it, unsigned char* smem) {
  float* sc = (float*)smem;
  float* red = sc + 3072;
  const int t = tid_(), lane = t & 63, wid = t >> 6;
  const int l = it / 96, jc = it % 96;
#pragma unroll
  for (int i = 0; i < 12; ++i) {
    const int idx = t + 256 * i, r = idx >> 10, k = idx & 1023;
    const float cv = r < 2 ? p.c[r * 1024 + k] : p.c_ctx[k];
    sc[idx] = silu_f(cv);
  }
  __syncthreads();
  const float* w = p.w_ada + (size_t)l * 1024 * 6144 + jc * 64 + lane;
  float a0 = 0.f, a1 = 0.f, a2 = 0.f;
  const int kb = wid * 256;
#pragma unroll 8
  for (int k = 0; k < 256; ++k) {
    const float wv = w[(size_t)(kb + k) * 6144];
    a0 += sc[kb + k] * wv;
    a1 += sc[1024 + kb + k] * wv;
    a2 += sc[2048 + kb + k] * wv;
  }
  red[(wid * 3 + 0) * 64 + lane] = a0;
  red[(wid * 3 + 1) * 64 + lane] = a1;
  red[(wid * 3 + 2) * 64 + lane] = a2;
  __syncthreads();
  if (t < 192) {
    const int r = t >> 6, ln = t & 63;
    float s = 0.f;
#pragma unroll
    for (int w4 = 0; w4 < 4; ++w4) s += red[(w4 * 3 + r) * 64 + ln];
    s += p.b_ada[l * 6144 + jc * 64 + ln];
    p.mada[(l * 3 + r) * 6144 + jc * 64 + ln] = s;
  }
  asm volatile("s_waitcnt vmcnt(0)" ::: "memory");
  __syncthreads();
  if (t == 0) {
    __builtin_amdgcn_fence(__ATOMIC_RELEASE, "agent");
    asm volatile("s_waitcnt vmcnt(0)" ::: "memory");
    (void)xb_add(&p.bar[64], 1u);
  }
}

__device__ __forceinline__ void fold_item(const Params& p, int it, unsigned char* smem) {
  float* tile = (float*)smem;
  float* ct = tile + 64 * 65;
  const int t = tid_();
  const int l = it >> 6, rem = it & 63, g = rem >> 4, k0 = (rem & 15) * 64;
#pragma unroll
  for (int i = 0; i < 16; ++i) {
    const int kk = i * 4 + (t >> 6), d = t & 63;
    tile[kk * 65 + d] = p.w_in[(size_t)(l * 1024 + k0 + kk) * 1216 + 512 + g * 64 + d];
  }
  if (t < 64) ct[t] = cospif((float)t / 32.f);
  __syncthreads();
  const int k = t & 63, jg = t >> 6;
  u16* dst = p.WinT + (size_t)l * 1536 * 1024;
  for (int jj = 0; jj < 16; ++jj) {
    const int j = jg + 4 * jj;
    float sr = 0.f, si = 0.f;
#pragma unroll 8
    for (int d = 0; d < 64; ++d) {
      const float v = tile[k * 65 + d];
      const int m = (j * d) & 63;
      sr += v * ct[m];
      si += v * ct[(m - 16) & 63];
    }
    dst[(size_t)(512 + g * 64 + j) * 1024 + k0 + k] = f2bf(sr);
    dst[(size_t)(768 + g * 64 + j) * 1024 + k0 + k] = f2bf(-si);
  }
  __syncthreads();
}

__device__ __forceinline__ void convT_tile(const float* __restrict__ src, int lds, int k0, int c0, u16* __restrict__ dst, int Kd,
                                           int rbase, int mode, int which, unsigned char* smem, const float* __restrict__ kscale = nullptr) {
  float* tile = (float*)smem;
  const int t = tid_();
  float4 v4[4];
#pragma unroll
  for (int i = 0; i < 4; ++i) v4[i] = *(const float4*)(src + (size_t)(k0 + i * 16 + (t >> 4)) * lds + c0 + (t & 15) * 4);
#pragma unroll
  for (int i = 0; i < 4; ++i) {
    const int kk = i * 16 + (t >> 4), cc = (t & 15) * 4;
    const float sc = kscale ? kscale[k0 + kk] : 1.f;
    tile[kk * 65 + cc + 0] = v4[i].x * sc; tile[kk * 65 + cc + 1] = v4[i].y * sc;
    tile[kk * 65 + cc + 2] = v4[i].z * sc; tile[kk * 65 + cc + 3] = v4[i].w * sc;
  }
  __syncthreads();
#pragma unroll
  for (int i = 0; i < 16; ++i) {
    const int cc = i * 4 + (t >> 6), kk = t & 63;
    int row;
    if (mode == 0) row = rbase + cc;
    else { const int f = c0 + cc; row = (((f >> 4) * 2 + which) << 4) + (f & 15); }
    dst[(size_t)row * Kd + k0 + kk] = f2bf(tile[kk * 65 + cc]);
  }
  __syncthreads();
}

__device__ __forceinline__ void conv_item(const Params& p, int it, unsigned char* smem) {
  const int l = it / 6720;
  int r = it % 6720;
  if (r < 240) {
    const int ct = r >> 4, kt = r & 15;
    const int c0 = (ct < 8 ? ct : ct + 4) * 64;
    const int n0 = c0 + (c0 >= 768 ? 256 : 0);
    convT_tile(p.w_in + (size_t)l * 1024 * 1216, 1216, kt * 64, c0, p.WinT + (size_t)l * 1536 * 1024, 1024, n0, 0, 0, smem);
    return;
  }
  r -= 240;
  if (r < 48) {
    const int ct = r >> 2, kt = r & 3;
    convT_tile(p.w_uq + (size_t)l * 256 * 768, 768, kt * 64, ct * 64, p.WuqT + (size_t)l * 768 * 256, 256, ct * 64, 0, 0, smem, p.q_lora_norm + l * 256);
    return;
  }
  r -= 48;
  if (r < 32) {
    const int ct = r >> 1, kt = r & 1;
    convT_tile(p.w_ukv + (size_t)l * 128 * 1024, 1024, kt * 64, ct * 64, p.WukvT + (size_t)l * 1024 * 128, 128, ct * 64, 0, 0, smem, p.kv_lora_norm + l * 128);
    return;
  }
  r -= 32;
  if (r < 256) {
    const int ct = r >> 4, kt = r & 15;
    convT_tile(p.w_out + (size_t)l * 1024 * 1024, 1024, kt * 64, ct * 64, p.WoutT + (size_t)l * 1024 * 1024, 1024, ct * 64, 0, 0, smem);
    return;
  }
  r -= 256;
  if (r < 4096) {
    const int which = r >> 11, r2 = r & 2047, e = r2 >> 7, r3 = r2 & 127, ct = r3 >> 4, kt = r3 & 15;
    const float* src = (which ? p.w_up : p.w_gate) + (size_t)(l * 16 + e) * 1024 * 512;
    convT_tile(src, 512, kt * 64, ct * 64, p.WguT + (size_t)(l * 16 + e) * 1024 * 1024, 1024, 0, 1, which, smem);
    return;
  }
  r -= 4096;
  {
    const int e = r >> 7, r3 = r & 127, ct = r3 >> 3, kt = r3 & 7;
    convT_tile(p.w_down + (size_t)(l * 16 + e) * 512 * 1024, 1024, kt * 64, ct * 64, p.WdT + (size_t)(l * 16 + e) * 1024 * 512, 512, ct * 64, 0, 0, smem);
  }
}

__device__ __forceinline__ void elem_item(const Params& p, int it) {
  const int t = tid_();
  if (it < 128) {
#pragma unroll
    for (int i = 0; i < 4; ++i) { const int idx = it * 1024 + i * 256 + t; p.Wsgu[idx] = f2bf(p.w_sgu[idx]); }
    return;
  }
  it -= 128;
  if (it < 2048) {
#pragma unroll
    for (int i = 0; i < 4; ++i) {
      const int idx = it * 1024 + i * 256 + t;
      const int n1 = idx >> 14, m = (idx >> 7) & 127, kk = idx & 127;
      const int rip = m >> 6, k2 = m & 63, ri = kk >> 6, n2 = kk & 63;
      const int n = n1 + 128 * n2;
      const int ph = (k2 * n) & 8191;
      const float xx = (float)ph / 4096.f;
      const float cs = cospif(xx), sn = sinpif(xx);
      const float v = rip == 0 ? (ri == 0 ? cs : sn) : (ri == 0 ? -sn : cs);
      p.M1[idx] = f2bf(v);
    }
    return;
  }
  it -= 2048;
  if (it < 32) {
#pragma unroll
    for (int i = 0; i < 4; ++i) {
      const int idx = it * 1024 + i * 256 + t;
      const int k1 = idx >> 8, kk = idx & 255, ri = kk >> 7, n1 = kk & 127;
      const int ph = (k1 * n1) & 127;
      const float xx = (float)ph / 64.f;
      p.M2[idx] = f2bf(ri ? sinpif(xx) : cospif(xx));
    }
    return;
  }
  it -= 32;
  {
#pragma unroll
    for (int i = 0; i < 4; ++i) {
      const int idx = it * 1024 + i * 256 + t;
      const int k = idx >> 9, kk = idx & 511, ri = kk >> 8, n = kk & 255;
      const int ph = (k * n) & 255;
      const float xx = (float)ph / 128.f;
      p.Mc[idx] = f2bf(ri ? sinpif(xx) : cospif(xx));
    }
  }
}

__device__ __forceinline__ void phase_prep(const Params& p, unsigned char* smem) {
  const int G = gridDim.x;
  int t = bid_();
  for (; t < 192; t += G) ada_item(p, t, smem);
  t -= 192;
  for (; t < 128; t += G) fold_item(p, t, smem);
  t -= 128;
  for (; t < 13440; t += G) conv_item(p, t, smem);
  t -= 13440;
  for (; t < 2336; t += G) elem_item(p, t);
}

__device__ __forceinline__ int row_cond(int row) { return row < T_LAT ? (row >> 13) : 2; }
__device__ __forceinline__ int row_batch(int row) { return row < T_LAT ? (row >> 13) : ((row - T_LAT) >> 8); }
__device__ __forceinline__ int row_pos(int row) { return row < T_LAT ? (CTX + (row & (SEQ - 1))) : ((row - T_LAT) & (CTX - 1)); }

template <int R>
__device__ __forceinline__ void phase_modulate(const Params& p, int l, const float* xlat, const float* xctx, int nrows, int chunk, int bskip) {
  const int t = tid_(), lane = t & 63, wid = t >> 6;
  const int bb = bid_() - bskip;
  if (bb < 0) return;
  const int gw = bb * 4 + wid, nw = ((int)gridDim.x - bskip) * 4;
  for (int row0 = gw * R; row0 < nrows; row0 += nw * R) {
    const float* xr = row0 < T_LAT ? xlat + (size_t)row0 * DM : xctx + (size_t)(row0 - T_LAT) * DM;
    const float* sh = p.mada + (size_t)(l * 3 + row_cond(row0)) * 6144 + chunk * 1024;
    const float* sc = sh + 1024;
    float4 v[R][4];
#pragma unroll
    for (int r = 0; r < R; ++r)
#pragma unroll
      for (int i = 0; i < 4; ++i) v[r][i] = *(const float4*)(xr + (size_t)r * DM + i * 256 + lane * 4);
    float rstd[R];
#pragma unroll
    for (int r = 0; r < R; ++r) {
      float ss = 0.f;
#pragma unroll
      for (int i = 0; i < 4; ++i) ss += v[r][i].x * v[r][i].x + v[r][i].y * v[r][i].y + v[r][i].z * v[r][i].z + v[r][i].w * v[r][i].w;
      ss = wave_sum(ss);
      rstd[r] = rsqrtf(ss * (1.f / 1024.f) + 1e-6f);
    }
#pragma unroll
    for (int i = 0; i < 4; ++i) {
      const int col = i * 256 + lane * 4;
      const float4 s4 = *(const float4*)(sc + col);
      const float4 h4 = *(const float4*)(sh + col);
#pragma unroll
      for (int r = 0; r < R; ++r) {
        u32x2 pk;
        pk.x = pack2(v[r][i].x * rstd[r] * (1.f + s4.x) + h4.x, v[r][i].y * rstd[r] * (1.f + s4.y) + h4.y);
        pk.y = pack2(v[r][i].z * rstd[r] * (1.f + s4.z) + h4.z, v[r][i].w * rstd[r] * (1.f + s4.w) + h4.w);
        *(u32x2*)(p.H + (size_t)(row0 + r) * DM + col) = pk;
      }
    }
  }
}

__device__ __forceinline__ void phase_router_prep(const Params& p) {
  const int t = tid_(), lane = t & 63, wid = t >> 6;
  for (int i = bid_() * 256 + t; i < 2 * 3 * 16384; i += gridDim.x * 256) {
    const int lc = i >> 14, k = (i >> 4) & 1023, e = i & 15, l = lc / 3;
    p.WR2[i] = (1.f + p.mada[(size_t)lc * 6144 + 4 * 1024 + k]) * p.w_router[(size_t)l * 16384 + k * 16 + e];
  }
  for (int o = bid_() * 4 + wid; o < 96; o += gridDim.x * 4) {
    const int lc = o >> 4, e = o & 15, l = lc / 3;
    float s = 0.f;
    for (int k = lane; k < 1024; k += 64) s += p.mada[(size_t)lc * 6144 + 3 * 1024 + k] * p.w_router[(size_t)l * 16384 + k * 16 + e];
    s = wave_sum(s);
    if (lane == 0) p.CE[o] = s;
  }
}

__device__ __forceinline__ void phase_router(const Params& p, int l, const float* xlat, const float* xctx, int nrows) {
  const int t = tid_(), lane = t & 63, wid = t >> 6, l16 = lane & 15, quad = lane >> 4;
  const int gw = bid_() * 4 + wid, nw = gridDim.x * 4;
  const int ntile = nrows >> 4;
  for (int tile = gw; tile < ntile; tile += nw) {
    const int row0 = tile * 16;
    const int cond = row_cond(row0);
    const float* xr = (row0 < T_LAT ? xlat + (size_t)(row0 + l16) * DM : xctx + (size_t)(row0 - T_LAT + l16) * DM) + quad * 4;
    const float* wp = p.WR2 + (size_t)(l * 3 + cond) * 16384 + quad * 64 + l16;
    f32x4 acc = (f32x4){0.f, 0.f, 0.f, 0.f};
    float ss = 0.f;
#pragma unroll 4
    for (int s = 0; s < 64; ++s) {
      const float4 a = *(const float4*)(xr + s * 16);
      const float b0 = wp[s * 256], b1 = wp[s * 256 + 16], b2 = wp[s * 256 + 32], b3 = wp[s * 256 + 48];
      ss += a.x * a.x + a.y * a.y + a.z * a.z + a.w * a.w;
      acc = __builtin_amdgcn_mfma_f32_16x16x4f32(a.x, b0, acc, 0, 0, 0);
      acc = __builtin_amdgcn_mfma_f32_16x16x4f32(a.y, b1, acc, 0, 0, 0);
      acc = __builtin_amdgcn_mfma_f32_16x16x4f32(a.z, b2, acc, 0, 0, 0);
      acc = __builtin_amdgcn_mfma_f32_16x16x4f32(a.w, b3, acc, 0, 0, 0);
    }
    ss += __shfl_xor(ss, 16);
    ss += __shfl_xor(ss, 32);
    const float rstd = rsqrtf(ss * (1.f / 1024.f) + 1e-6f);
    const float ce = p.CE[(l * 3 + cond) * 16 + l16];
#pragma unroll
    for (int j = 0; j < 4; ++j) {
      const int tk = quad * 4 + j;
      const float r = __shfl(rstd, tk);
      const float lg = acc[j] * r + ce;
      float mx = lg;
#pragma unroll
      for (int o = 8; o; o >>= 1) mx = fmaxf(mx, __shfl_xor(mx, o));
      const float ex = __expf(lg - mx);
      float sm = ex;
#pragma unroll
      for (int o = 8; o; o >>= 1) sm += __shfl_xor(sm, o);
      const float aff = ex / sm;
      const int row = row0 + tk;
      if (row < T_LAT) p.AFFT[(size_t)((row >> 13) * 16 + l16) * SEQ + (row & (SEQ - 1))] = aff;
      else { const int rc = row - T_LAT; p.AFFT[(size_t)32 * SEQ + ((rc >> 8) * 16 + l16) * CTX + (rc & 255)] = aff; }
    }
  }
}

__device__ __forceinline__ void phase_in_gemm(const Params& p, int l, unsigned char* smem) {
  const u16* W = p.WinT + (size_t)l * 1536 * 1024;
  XCD_FOR(t, 132 * 11) {
    const int mt = t / 11, nt = t % 11;
    const int row_base = mt * 128;
    auto epi = [&](f32x4(&acc)[4][4], int r0, int c0) {
      const bool act = nt < 4;
      auto vf = [&](int, int, float v) { return act ? gelu_tanh(v) : v; };
      auto rp = [&](int r) -> u16* {
        const int row = row_base + r;
        if (nt < 4) return p.PX + (size_t)row * 1024 + nt * 128;
        if (nt >= 8) return p.PX + (size_t)row * 1024 + 512 + (nt - 8) * 128;
        const int ri = (nt - 4) >> 1, jx = ((nt - 4) & 1) * 128;
        if (row < T_LAT) return p.GD + ((size_t)((row >> 13) * 2 + ri) * SEQ + (row & (SEQ - 1))) * 256 + jx;
        const int rc = row - T_LAT;
        return p.GDc + ((size_t)((rc >> 8) * 2 + ri) * CTX + (rc & 255)) * 256 + jx;
      };
      epi_staged_bf16<4>(acc, r0, c0, smem, vf, rp);
    };
    gemm_tile<4, false>(p.H + (size_t)row_base * 1024, 1024, nullptr, 128, W + (size_t)nt * 128 * 1024, 1024, 1024, smem, epi);
  }
  XCD_FOR(t, 132) {
    const int row_base = t * 128;
    auto epi = [&](f32x4(&acc)[4][2], int r0, int c0) {
      auto vf = [&](int, int, float v) { return v; };
      auto rp = [&](int r) -> u16* { return p.PX + (size_t)(row_base + r) * 1024 + 896; };
      epi_staged_bf16<2>(acc, r0, c0, smem, vf, rp);
    };
    gemm_tile<2, false>(p.H + (size_t)row_base * 1024, 1024, nullptr, 128, W + (size_t)11 * 128 * 1024, 1024, 1024, smem, epi);
  }
}

__device__ __forceinline__ void phase_rownorm(const Params& p, int l) {
  constexpr int R = 4;
  const int t = tid_(), lane = t & 63, wid = t >> 6;
  const int gw = bid_() * 4 + wid, nw = gridDim.x * 4;
  const float* nv = p.sgu_norm + l * 256 + lane * 4;
  const float* nq = p.q_lora_norm + l * 256 + lane * 4;
  const float* nk = p.kv_lora_norm + l * 128 + lane * 2;
  for (int row0 = gw * R; row0 < TT; row0 += nw * R) {
    u16* px = p.PX + (size_t)row0 * 1024;
    u32x2 rv[R], rq[R];
    unsigned rk[R];
#pragma unroll
    for (int r = 0; r < R; ++r) {
      rv[r] = *(const u32x2*)(px + r * 1024 + 256 + lane * 4);
      rq[r] = *(const u32x2*)(px + r * 1024 + 512 + lane * 4);
      rk[r] = *(const unsigned*)(px + r * 1024 + 768 + lane * 2);
    }
#pragma unroll
    for (int r = 0; r < R; ++r) {
      {
        const float a = bf2f((u16)(rv[r].x & 0xffff)), b = bf2f((u16)(rv[r].x >> 16)), c = bf2f((u16)(rv[r].y & 0xffff)), d = bf2f((u16)(rv[r].y >> 16));
        const float rstd = rsqrtf(wave_sum(a * a + b * b + c * c + d * d) * (1.f / 256.f) + 1e-6f);
        u32x2 o;
        o.x = pack2(a * rstd * nv[0], b * rstd * nv[1]);
        o.y = pack2(c * rstd * nv[2], d * rstd * nv[3]);
        *(u32x2*)(px + r * 1024 + 256 + lane * 4) = o;
      }
      {
        const float a = bf2f((u16)(rq[r].x & 0xffff)), b = bf2f((u16)(rq[r].x >> 16)), c = bf2f((u16)(rq[r].y & 0xffff)), d = bf2f((u16)(rq[r].y >> 16));
        const float rstd = rsqrtf(wave_sum(a * a + b * b + c * c + d * d) * (1.f / 256.f) + 1e-6f);
        u32x2 o;
        o.x = pack2(a * rstd * nq[0], b * rstd * nq[1]);
        o.y = pack2(c * rstd * nq[2], d * rstd * nq[3]);
        *(u32x2*)(px + r * 1024 + 512 + lane * 4) = o;
      }
      {
        const float a = bf2f((u16)(rk[r] & 0xffff)), b = bf2f((u16)(rk[r] >> 16));
        const float rstd = rsqrtf(wave_sum(a * a + b * b) * (1.f / 128.f) + 1e-6f);
        *(unsigned*)(px + r * 1024 + 768 + lane * 2) = pack2(a * rstd * nk[0], b * rstd * nk[1]);
      }
    }
  }
}

__device__ __forceinline__ void phase_mix_a(const Params& p, int l, bool last, unsigned char* smem) {
  {
    const u16* W = p.WuqT + (size_t)l * 768 * 256;
    XCD_FOR(t, 132 * 6) {
      const int mt = t / 6, nt = t % 6, row_base = mt * 128;
      auto epi = [&](f32x4(&acc)[4][4], int r0, int c0) {
        const float* rs = (const float*)(smem + 65536);
        auto vf = [&](int r, int, float v) { return v * rs[r]; };
        auto rp = [&](int r) -> u16* { return p.QR + (size_t)(row_base + r) * 768 + nt * 128; };
        epi_staged_bf16<4>(acc, r0, c0, smem, vf, rp);
      };
      gemm_tile<4, false, false, true>(p.PX + (size_t)row_base * 1024 + 512, 1024, nullptr, 128, W + (size_t)nt * 128 * 256, 256, 256, smem, epi);
    }
  }
  {
    const u16* W = p.WukvT + (size_t)l * 1024 * 128;
    XCD_FOR(t, 132 * 8) {
      const int mt = t >> 3, nt = t & 7, row_base = mt * 128, h = nt >> 1;
      const int b = row_batch(row_base), pos_base = row_pos(row_base);
      auto epi = [&](f32x4(&acc)[4][4], int r0, int c0) {
#pragma unroll
        for (int mi = 0; mi < 4; ++mi)
#pragma unroll
          for (int ni = 0; ni < 4; ++ni) {
            const int col = c0 + ni * 16;
            if ((nt & 1) == 0) {
            } else {
              u32x2 pk;
              pk.x = pack2(acc[mi][ni][0], acc[mi][ni][1]);
              pk.y = pack2(acc[mi][ni][2], acc[mi][ni][3]);
              *(u32x2*)(p.Vt + ((size_t)(b * 4 + h) * 128 + col) * NPOS + pos_base + r0 + mi * 16) = pk;
            }
          }
      };
      auto epi2 = [&](f32x4(&acc)[4][4], int r0, int c0) {
        const float* rs = (const float*)(smem + 65536);
        if ((nt & 1) == 0) {
          auto vf = [&](int r, int, float v) { return v * rs[r]; };
          auto rp = [&](int r) -> u16* { return p.KN + (size_t)(row_base + r) * 512 + h * 128; };
          epi_staged_bf16<4>(acc, r0, c0, smem, vf, rp);
        } else {
#pragma unroll
          for (int mi = 0; mi < 4; ++mi)
#pragma unroll
            for (int j = 0; j < 4; ++j) {
              const float sc = rs[r0 + mi * 16 + j];
#pragma unroll
              for (int ni = 0; ni < 4; ++ni) acc[mi][ni][j] *= sc;
            }
          auto cp = [&](int c) -> u16* { return p.Vt + ((size_t)(b * 4 + h) * 128 + c) * NPOS + pos_base; };
          epi_staged_bf16_T(acc, r0, c0, smem, cp);
        }
      };
      gemm_tile<4, false, false, true>(p.PX + (size_t)row_base * 1024 + 768, 1024, nullptr, 128, W + (size_t)nt * 128 * 128, 128, 128, smem, epi2);
    }
  }
  {
    const int nch = last ? 128 : 132;
    XCD_FOR(t, nch * 4) {
      const int ch = t >> 2, h = t & 3, row_base = ch * 128;
      const float* bs = p.b_sgu + (l * 4 + h) * 128;
      const float* sgn = p.sgu_norm + l * 256 + h * 64;
      float* rsv = (float*)(smem + 65536 + 512);
      {
        const int t3 = tid_(), q = t3 >> 1, half = t3 & 1;
        const u16* vp = p.PX + (size_t)(row_base + q) * 1024 + 256 + half * 128;
        float s = 0.f;
#pragma unroll
        for (int i = 0; i < 16; ++i) {
          const u32x4 w = *(const u32x4*)(vp + i * 8);
          const float a0 = __uint_as_float(w.x << 16), a1 = __uint_as_float(w.x & 0xffff0000u), a2 = __uint_as_float(w.y << 16), a3 = __uint_as_float(w.y & 0xffff0000u);
          const float a4 = __uint_as_float(w.z << 16), a5 = __uint_as_float(w.z & 0xffff0000u), a6 = __uint_as_float(w.w << 16), a7 = __uint_as_float(w.w & 0xffff0000u);
          s += (a0 * a0 + a1 * a1) + (a2 * a2 + a3 * a3) + (a4 * a4 + a5 * a5) + (a6 * a6 + a7 * a7);
        }
        s += __shfl_xor(s, 1);
        __syncthreads();
        if (half == 0) rsv[q] = rsqrtf(s * (1.f / 256.f) + 1e-6f);
      }
      auto epi = [&](f32x4(&acc)[4][2], int r0, int c0) {
        float* Ts = (float*)smem;
        const int t2 = tid_();
        __syncthreads();
#pragma unroll
        for (int mi = 0; mi < 4; ++mi)
#pragma unroll
          for (int ni = 0; ni < 2; ++ni)
#pragma unroll
            for (int j = 0; j < 4; ++j) {
              const int pr = r0 + mi * 16 + j;
              Ts[pr * 68 + c0 + ni * 16] = acc[mi][ni][j] * sgn[c0 + ni * 16] + bs[pr];
            }
        __syncthreads();
#pragma unroll
        for (int i = 0; i < 4; ++i) {
          const int c = t2 + 256 * i, pr = c >> 3, ch = c & 7;
          const size_t o = (size_t)(row_base + pr) * 1024 + h * 64 + ch * 8;
          const u32x4 u = *(const u32x4*)(p.PX + o);
          const float4 z0 = *(const float4*)(Ts + pr * 68 + ch * 8), z1 = *(const float4*)(Ts + pr * 68 + ch * 8 + 4);
          u32x4 r;
          r.x = pack2(bf2f((u16)(u.x & 0xffffu)) * z0.x, bf2f((u16)(u.x >> 16)) * z0.y);
          r.y = pack2(bf2f((u16)(u.y & 0xffffu)) * z0.z, bf2f((u16)(u.y >> 16)) * z0.w);
          r.z = pack2(bf2f((u16)(u.z & 0xffffu)) * z1.x, bf2f((u16)(u.z >> 16)) * z1.y);
          r.w = pack2(bf2f((u16)(u.w & 0xffffu)) * z1.z, bf2f((u16)(u.w >> 16)) * z1.w);
          *(u32x4*)(p.YM + o) = r;
        }
      };
      gemm_tile<2, true>(p.Wsgu + (size_t)(l * 4 + h) * 16384, 128, nullptr, 128, p.PX + (size_t)row_base * 1024 + 256 + h * 64, 1024, 128, smem, epi, rsv);
    }
  }
  {
    XCD_FOR(t, 512) {
      const int nh = t & 1, n1 = (t >> 1) & 127, b = t >> 8;
      auto epi = [&](f32x4(&acc)[4][4], int r0, int c0) {
        auto vf = [&](int, int, float v) { return v; };
        auto rp = [&](int m) -> u16* { const int rip = m >> 6, k2 = m & 63; return p.PF + ((size_t)((b * 64 + k2) * 2 + rip) * 128 + n1) * 256 + nh * 128; };
        epi_staged_bf16<4>(acc, r0, c0, smem, vf, rp);
      };
      gemm_tile<4, true>(p.M1 + (size_t)n1 * 16384, 128, nullptr, 128, p.GD + (size_t)b * 2 * SEQ * 256 + (size_t)n1 * 256 + nh * 128, 128 * 256, 128, smem, epi);
    }
  }
  if (!last) {
    for (int t = bid_(); t < 8; t += gridDim.x) {
      const int nh = t & 1, mt = (t >> 1) & 1, b = t >> 2;
      auto epi = [&](f32x4(&acc)[4][4], int r0, int c0) {
#pragma unroll
        for (int mi = 0; mi < 4; ++mi)
#pragma unroll
          for (int ni = 0; ni < 4; ++ni)
#pragma unroll
            for (int j = 0; j < 4; ++j) {
              const int k = mt * 128 + r0 + mi * 16 + j;
              p.YM[(size_t)(T_LAT + b * CTX + k) * 1024 + 256 + nh * 128 + c0 + ni * 16] = f2bf(acc[mi][ni][j] * (1.f / 128.f));
            }
      };
      gemm_tile<4, true>(p.Mc + (size_t)mt * 128 * 512, 512, nullptr, 128, p.GDc + (size_t)b * 2 * CTX * 256 + nh * 128, 256, 512, smem, epi);
    }
  }
}

__device__ __forceinline__ void phase_mix_b(const Params& p, int l, bool last, unsigned char* smem) {
  XCD_FOR(t, 512) {
    const int nq = t & 3, k2 = (t >> 2) & 63, b = t >> 8;
    auto epi = [&](f32x4(&acc)[4][2], int r0, int c0) {
      auto vf = [&](int, int, float v) { return v * 0.001381067932004976f; };
      auto rp = [&](int k1) -> u16* { return p.YM + (size_t)(b * SEQ + 64 * k1 + k2) * 1024 + 256 + nq * 64; };
      epi_staged_bf16<2>(acc, r0, c0, smem, vf, rp);
    };
    gemm_tile<2, true>(p.M2, 256, nullptr, 128, p.PF + (size_t)(b * 64 + k2) * 2 * 128 * 256 + nq * 64, 256, 256, smem, epi);
  }
  const int tt = tid_(), lane = tt & 63, wid = tt >> 6;
  const int gw = bid_() * 4 + wid, nw = gridDim.x * 4;
  const float QSCALE = 0.07216878364870322f * 1.4426950408889634f;
  for (int row = gw; row < TT; row += nw) {
    const bool lat = row < T_LAT;
    const int b = row_batch(row), pos = row_pos(row);
    float cs = 1.f, sn = 0.f;
    if (lat) {
      const int n = row & (SEQ - 1);
      const int r = lane, sub = r & 31, i = sub & 15;
      const float ps = (r < 32) ? (float)(n >> 6) : (float)(n & 63);
      const float fr = __builtin_amdgcn_exp2f(-(float)i * 0.83048202372184058696f);
      const float ang = ps * fr;
      sn = __sinf(ang);
      cs = __cosf(ang);
    }
    const bool hi = ((lane & 31) >= 16);
    if (lat || !last) {
#pragma unroll
      for (int h = 0; h < 4; ++h) {
        const u16* q = p.QR + (size_t)row * 768 + h * 192;
        float v0 = bf2f(q[lane]), v1 = bf2f(q[lane + 64]), v2 = bf2f(q[lane + 128]);
        const float ss = wave_sum(v0 * v0 + v1 * v1 + v2 * v2);
        const float rstd = rsqrtf(ss * (1.f / 192.f) + 1e-6f);
        const float* qn = p.q_norm + l * 192;
        v0 *= rstd * qn[lane]; v1 *= rstd * qn[lane + 64]; v2 *= rstd * qn[lane + 128];
        if (lat) {
          const float xp = __shfl_xor(v2, 16);
          v2 = hi ? (xp * sn + v2 * cs) : (v2 * cs - xp * sn);
        }
        u16* o = p.Qall + ((size_t)(b * 4 + h) * NPOS + pos) * 192;
        o[lane] = f2bf(v0 * QSCALE); o[lane + 64] = f2bf(v1 * QSCALE); o[lane + 128] = f2bf(v2 * QSCALE);
      }
    }
    {
      const float kr = bf2f(p.PX[(size_t)row * 1024 + 896 + lane]);
#pragma unroll
      for (int h = 0; h < 4; ++h) {
        const u16* kk = p.KN + (size_t)row * 512 + h * 128;
        float v0 = bf2f(kk[lane]), v1 = bf2f(kk[lane + 64]), v2 = kr;
        const float ss = wave_sum(v0 * v0 + v1 * v1 + v2 * v2);
        const float rstd = rsqrtf(ss * (1.f / 192.f) + 1e-6f);
        const float* kn = p.k_norm + l * 192;
        v0 *= rstd * kn[lane]; v1 *= rstd * kn[lane + 64]; v2 *= rstd * kn[lane + 128];
        if (lat) {
          const float xp = __shfl_xor(v2, 16);
          v2 = hi ? (xp * sn + v2 * cs) : (v2 * cs - xp * sn);
        }
        u16* o = p.Kb + ((size_t)(b * 4 + h) * NPOS + pos) * 192;
        o[lane] = f2bf(v0); o[lane + 64] = f2bf(v1); o[lane + 128] = f2bf(v2);
      }
    }
  }
}

__device__ __forceinline__ void attn_item(const Params& p, int b, int h, int qt, float shift, unsigned char* smem) {
  constexpr int STAGE = 32 * 208 + 128 * 40;
  u16* sbase = (u16*)smem;
  const int t = tid_(), lane = t & 63, wid = t >> 6, l16 = lane & 15, quad = lane >> 4;
  const int nkeys = (qt < 2) ? CTX : NPOS;
  const int ntile = nkeys >> 5;
  const u16* Qp = p.Qall + ((size_t)(b * 4 + h) * NPOS + qt * 128 + wid * 32) * 192;
  const u16* kp = p.Kb + (size_t)(b * 4 + h) * NPOS * 192 + t * 8;
  const u16* vp = p.Vt + (size_t)(b * 4 + h) * 128 * NPOS + (size_t)(t >> 2) * NPOS + (t & 3) * 8;
  const u16* qlane = Qp + (size_t)l16 * 192 + quad * 8;
  bf16x8 bq[2][6];
#pragma unroll
  for (int qi = 0; qi < 2; ++qi)
#pragma unroll
    for (int ks = 0; ks < 6; ++ks) bq[qi][ks] = *(const bf16x8*)(qlane + qi * 16 * 192 + ks * 32);
  f32x4 o[8][2];
#pragma unroll
  for (int vt = 0; vt < 8; ++vt)
#pragma unroll
    for (int qi = 0; qi < 2; ++qi) o[vt][qi] = (f32x4){0.f, 0.f, 0.f, 0.f};
  float lrun0 = 0.f, lrun1 = 0.f;
  u32x4 rk[3], rv[2];
  f32x4 sA[2][2], sB[2][2];
#define ATT_LOAD(kt_)                                                                                   \
  {                                                                                                     \
    _Pragma("unroll") for (int i = 0; i < 3; ++i) rk[i] = *(const u32x4*)(kp + (size_t)(kt_) * 6144 + i * 2048); \
    _Pragma("unroll") for (int i = 0; i < 2; ++i) rv[i] = *(const u32x4*)(vp + (size_t)(64 * i) * NPOS + (kt_) * 32); \
  }
#define ATT_STORE(st_)                                                                                  \
  {                                                                                                     \
    u16* kd = sbase + (st_) * STAGE;                                                                    \
    _Pragma("unroll") for (int i = 0; i < 3; ++i) {                                                     \
      const int c = t + 256 * i;                                                                        \
      *(u32x4*)(kd + (c / 24) * 208 + (c % 24) * 8) = rk[i];                                            \
    }                                                                                                   \
    _Pragma("unroll") for (int i = 0; i < 2; ++i) *(u32x4*)(kd + 6656 + ((t >> 2) + 64 * i) * 40 + (t & 3) * 8) = rv[i]; \
  }
#define ATT_S(SX, kst_)                                                                                 \
  {                                                                                                     \
    const u16* Ks = sbase + (kst_) * STAGE;                                                             \
    _Pragma("unroll") for (int a = 0; a < 2; ++a)                                                       \
      _Pragma("unroll") for (int qi = 0; qi < 2; ++qi) SX[a][qi] = (f32x4){0.f, 0.f, 0.f, 0.f};         \
    _Pragma("unroll") for (int ks = 0; ks < 6; ++ks) {                                                  \
      _Pragma("unroll") for (int a = 0; a < 2; ++a) {                                                   \
        const bf16x8 kf = *(const bf16x8*)(Ks + (a * 16 + l16) * 208 + ks * 32 + quad * 8);             \
        _Pragma("unroll") for (int qi = 0; qi < 2; ++qi) SX[a][qi] = __builtin_amdgcn_mfma_f32_16x16x32_bf16(kf, bq[qi][ks], SX[a][qi], 0, 0, 0); \
      }                                                                                                 \
    }                                                                                                   \
  }
#define ATT_VLOAD(vst_, hv_)                                                                            \
  {                                                                                                     \
    const u16* Vs = sbase + (vst_) * STAGE + 6656;                                                      \
    _Pragma("unroll") for (int vt = 0; vt < 4; ++vt) {                                                  \
      const u16* vb = Vs + (((hv_) * 4 + vt) * 16 + l16) * 40 + quad * 4;                               \
      const u32x2 va = *(const u32x2*)(vb);                                                             \
      const u32x2 vc = *(const u32x2*)(vb + 16);                                                        \
      const u32x4 vw = {va.x, va.y, vc.x, vc.y};                                                        \
      vfr[vt] = (bf16x8)vw;                                                                             \
    }                                                                                                   \
  }
#define ATT_FINISH(SX, vst_)                                                                            \
  {                                                                                                     \
    bf16x8 pb[2];                                                                                       \
    _Pragma("unroll") for (int qi = 0; qi < 2; ++qi) {                                                  \
      float psum = 0.f;                                                                                 \
      _Pragma("unroll") for (int a = 0; a < 2; ++a)                                                     \
        _Pragma("unroll") for (int j = 0; j < 4; ++j) {                                                 \
          const float pe = __builtin_amdgcn_exp2f(SX[a][qi][j]);                                        \
          SX[a][qi][j] = pe;                                                                            \
          psum += pe;                                                                                   \
        }                                                                                               \
      if (qi) lrun1 += psum; else lrun0 += psum;                                                        \
      u32x4 pk;                                                                                         \
      pk.x = pack2(SX[0][qi][0], SX[0][qi][1]);                                                         \
      pk.y = pack2(SX[0][qi][2], SX[0][qi][3]);                                                         \
      pk.z = pack2(SX[1][qi][0], SX[1][qi][1]);                                                         \
      pk.w = pack2(SX[1][qi][2], SX[1][qi][3]);                                                         \
      pb[qi] = (bf16x8)pk;                                                                              \
    }                                                                                                   \
    _Pragma("unroll") for (int vt = 0; vt < 4; ++vt)                                                    \
      _Pragma("unroll") for (int qi = 0; qi < 2; ++qi) o[vt][qi] = __builtin_amdgcn_mfma_f32_16x16x32_bf16(vfr[vt], pb[qi], o[vt][qi], 0, 0, 0); \
    ATT_VLOAD(vst_, 1);                                                                                 \
    _Pragma("unroll") for (int vt = 0; vt < 4; ++vt)                                                    \
      _Pragma("unroll") for (int qi = 0; qi < 2; ++qi) o[4 + vt][qi] = __builtin_amdgcn_mfma_f32_16x16x32_bf16(vfr[vt], pb[qi], o[4 + vt][qi], 0, 0, 0); \
  }
#define ATT_SHIFT(SX)                                                                                   \
  if (shift > 0.f) {                                                                                    \
    _Pragma("unroll") for (int a = 0; a < 2; ++a)                                                       \
      _Pragma("unroll") for (int qi = 0; qi < 2; ++qi) {                                                \
        SX[a][qi][0] -= shift; SX[a][qi][1] -= shift; SX[a][qi][2] -= shift; SX[a][qi][3] -= shift;     \
      }                                                                                                 \
  }
#define ATT_STEP(SNEW, SOLD, tt_)                                                                       \
  {                                                                                                     \
    const int tn_ = ((tt_) + 1 < ntile) ? (tt_) + 1 : ntile - 1;                                        \
    ATT_LOAD(tn_);                                                                                      \
    bf16x8 vfr[4];                                                                                      \
    ATT_VLOAD(((tt_) - 1) % 3, 0);                                                                      \
    ATT_SHIFT(SOLD);                                                                                    \
    __builtin_amdgcn_s_setprio(1);                                                                      \
    ATT_S(SNEW, (tt_) % 3);                                                                             \
    ATT_FINISH(SOLD, ((tt_) - 1) % 3);                                                                  \
    __builtin_amdgcn_s_setprio(0);                                                                      \
    ATT_STORE(((tt_) + 1) % 3);                                                                         \
    __syncthreads();                                                                                    \
  }
  __syncthreads();
  ATT_LOAD(0);
  ATT_STORE(0);
  ATT_LOAD(1);
  __syncthreads();
  ATT_S(sA, 0);
  ATT_STORE(1);
  __syncthreads();
#pragma unroll 1
  for (int tt = 1; tt < ntile - 1; tt += 2) {
    ATT_STEP(sB, sA, tt);
    ATT_STEP(sA, sB, tt + 1);
  }
  ATT_STEP(sB, sA, ntile - 1);
  {
    bf16x8 vfr[4];
    ATT_VLOAD((ntile - 1) % 3, 0);
    ATT_SHIFT(sB);
    ATT_FINISH(sB, (ntile - 1) % 3);
  }
  __syncthreads();
#undef ATT_LOAD
#undef ATT_STORE
#undef ATT_S
#undef ATT_VLOAD
#undef ATT_FINISH
#undef ATT_STEP
#undef ATT_SHIFT
#pragma unroll
  for (int qi = 0; qi < 2; ++qi) {
    float ls = qi ? lrun1 : lrun0;
    ls += __shfl_xor(ls, 16);
    ls += __shfl_xor(ls, 32);
    const float inv = 1.f / ls;
    const int pos = qt * 128 + wid * 32 + qi * 16 + l16;
    const int row = (pos < CTX) ? (T_LAT + b * CTX + pos) : (b * SEQ + pos - CTX);
    u16* orow = p.YM + (size_t)row * 1024 + 512 + h * 128 + quad * 4;
#pragma unroll
    for (int vt = 0; vt < 8; ++vt) {
      u32x2 pk;
      pk.x = pack2(o[vt][qi][0] * inv, o[vt][qi][1] * inv);
      pk.y = pack2(o[vt][qi][2] * inv, o[vt][qi][3] * inv);
      *(u32x2*)(orow + vt * 16) = pk;
    }
  }
}

__device__ __forceinline__ void phase_attn(const Params& p, int l, bool last, unsigned char* smem) {
  float shift;
  {
    const int lane = tid_() & 63;
    float mq = 0.f, mk = 0.f;
#pragma unroll
    for (int i = 0; i < 3; ++i) { mq = fmaxf(mq, fabsf(p.q_norm[l * 192 + lane + 64 * i])); mk = fmaxf(mk, fabsf(p.k_norm[l * 192 + lane + 64 * i])); }
#pragma unroll
    for (int o = 32; o; o >>= 1) { mq = fmaxf(mq, __shfl_xor(mq, o)); mk = fmaxf(mk, __shfl_xor(mk, o)); }
    const float bound = 192.f * mq * mk * (0.07216878364870322f * 1.4426950408889634f);
    shift = fmaxf(0.f, bound - 24.f);
  }
  const int x = bid_() & 7, j = bid_() >> 3, gb = gridDim.x >> 3;
  for (int q = j; q < 64; q += gb) attn_item(p, x >> 2, x & 3, 2 + q, shift, smem);
  if (!last)
    for (int q = j; q < 2; q += gb) attn_item(p, x >> 2, x & 3, q, shift, smem);
}

__device__ __forceinline__ void phase_out_gemm(const Params& p, int l, bool last, const float* slat, const float* sctx, float* dlat, float* dctx, unsigned char* smem) {
  const u16* W = p.WoutT + (size_t)l * 1024 * 1024;
  XCD_FOR(t, 128 * 8) {
    const int mt = t >> 3, nt = t & 7, row_base = mt * 128;
    const float* g1 = p.mada + (size_t)(l * 3 + (row_base >> 13)) * 6144 + 2 * 1024 + nt * 128;
    const float* xs = slat + (size_t)row_base * DM;
    float* xd = dlat + (size_t)row_base * DM;
    auto epi = [&](f32x4(&acc)[4][4], int r0, int c0) { epi_staged_residual(acc, r0, c0, smem, g1, xs + nt * 128, xd + nt * 128); };
    gemm_tile<4, false>(p.YM + (size_t)row_base * 1024, 1024, nullptr, 128, W + (size_t)nt * 128 * 1024, 1024, 1024, smem, epi);
  }
  if (!last) {
    XCD_FOR(t, 4 * 32) {
      const int mt = t >> 5, nt = t & 31, row_base = mt * 128;
      const float* g1 = p.mada + (size_t)(l * 3 + 2) * 6144 + 2 * 1024 + nt * 32;
      const float* xs = sctx + (size_t)row_base * DM;
      float* xd = dctx + (size_t)row_base * DM;
      auto epi = [&](f32x4(&acc)[4][1], int r0, int c0) {
#pragma unroll
        for (int mi = 0; mi < 4; ++mi) {
          const float g = g1[c0];
#pragma unroll
          for (int j = 0; j < 4; ++j) {
            const size_t o = (size_t)(r0 + mi * 16 + j) * DM + nt * 32 + c0;
            xd[o] = xs[o] + g * acc[mi][0][j];
          }
        }
      };
      gemm_tile<1, false>(p.YM + (size_t)(T_LAT + row_base) * 1024, 1024, nullptr, 128, W + (size_t)nt * 32 * 1024, 1024, 1024, smem, epi);
    }
  }
}

__device__ __forceinline__ unsigned block_incl_scan(unsigned x, unsigned* wsum, int lane, int wid, unsigned& total) {
  unsigned v = x;
#pragma unroll
  for (int off = 1; off < 64; off <<= 1) {
    const unsigned n = __shfl_up(v, off);
    if (lane >= off) v += n;
  }
  __syncthreads();
  if (lane == 63) wsum[wid] = v;
  __syncthreads();
  const unsigned w0 = wsum[0], w1 = wsum[1], w2 = wsum[2], w3 = wsum[3];
  total = w0 + w1 + w2 + w3;
  const unsigned base = (wid > 0 ? w0 : 0u) + (wid > 1 ? w1 : 0u) + (wid > 2 ? w2 : 0u);
  return base + v;
}

__device__ __forceinline__ void phase_topk(const Params& p, bool last, unsigned char* smem) {
  unsigned* key = (unsigned*)smem;
  unsigned* hist = key + 8192;
  unsigned* wsum = hist + 256;
  unsigned* sh = wsum + 4;
  const int t = tid_(), lane = t & 63, wid = t >> 6;
  const int ninst = last ? 32 : 64;
  for (int inst = bid_(); inst < ninst; inst += gridDim.x) {
    const bool lat = inst < 32;
    const int n = lat ? SEQ : CTX, cap = lat ? 1024 : 32;
    const float* src = lat ? p.AFFT + (size_t)inst * SEQ : p.AFFT + (size_t)32 * SEQ + (inst - 32) * CTX;
    const int rowbase = lat ? (inst >> 4) * SEQ : T_LAT + ((inst - 32) >> 4) * CTX;
    for (int i = t; i < n; i += 256) key[i] = __float_as_uint(src[i]);
    unsigned prefix = 0u, mask = 0u, remaining = (unsigned)cap;
    for (int shift = 24; shift >= 0; shift -= 8) {
      hist[t] = 0u;
      __syncthreads();
      for (int i = t; i < n; i += 256) {
        const unsigned k = key[i];
        if ((k & mask) == prefix) atomicAdd(&hist[(k >> shift) & 255u], 1u);
      }
      __syncthreads();
      const unsigned hc = hist[t];
      unsigned total;
      const unsigned incl = block_incl_scan(hc, wsum, lane, wid, total);
      const unsigned suf = total - incl + hc;
      const unsigned sufn = total - incl;
      if (suf >= remaining && sufn < remaining) { sh[0] = prefix | ((unsigned)t << shift); sh[1] = remaining - sufn; }
      __syncthreads();
      prefix = sh[0];
      remaining = sh[1];
      mask |= (255u << shift);
      __syncthreads();
    }
    const int per = n >> 8;
    unsigned cgt = 0u, ceq = 0u;
    for (int i = 0; i < per; ++i) {
      const unsigned k = key[t * per + i];
      cgt += (k > prefix) ? 1u : 0u;
      ceq += (k == prefix) ? 1u : 0u;
    }
    unsigned ngt, neq;
    unsigned og = block_incl_scan(cgt, wsum, lane, wid, ngt) - cgt;
    unsigned oe = block_incl_scan(ceq, wsum, lane, wid, neq) - ceq;
    int* idx = p.IDXG + (size_t)inst * 1024;
    float* gt = p.GATE + (size_t)inst * 1024;
    int* inv = p.INV + (size_t)rowbase * 16 + (inst & 15);
    for (int i = 0; i < per; ++i) {
      const int e = t * per + i;
      const unsigned k = key[e];
      int slot = -1;
      if (k > prefix) {
        slot = (int)og; ++og;
      } else if (k == prefix) {
        if (oe < remaining) slot = (int)(ngt + oe);
        ++oe;
      }
      if (slot >= 0) { idx[slot] = rowbase + e; gt[slot] = __uint_as_float(k); }
      inv[(size_t)e * 16] = slot;
    }
    __syncthreads();
  }
}

__device__ __forceinline__ void phase_moe_up(const Params& p, int l, bool last, unsigned char* smem) {
  const int npass = last ? 1 : 2;
  for (int pass = 0; pass < npass; ++pass)
  XCD_FOR(t, ((pass == npass - 1) ? 2048 : 256)) {
    int inst, mt, nt, mvalid, hid_row;
    if (pass == npass - 1) { const int e_ = t >> 7, b_ = (t >> 6) & 1; inst = b_ * 16 + e_; mt = (t >> 3) & 7; nt = t & 7; mvalid = 128; hid_row = inst * 1024 + mt * 128; }
    else { const int e_ = t >> 4, b_ = (t >> 3) & 1; inst = 32 + b_ * 16 + e_; mt = 0; nt = t & 7; mvalid = 32; hid_row = 32768 + (inst - 32) * 128; }
    const int e = inst & 15;
    const u16* W = p.WguT + (size_t)(l * 16 + e) * 1024 * 1024 + (size_t)nt * 128 * 1024;
    auto epi = [&](f32x4(&acc)[4][4], int r0, int c0) {
      u16* Ts = (u16*)smem;
      const int t2 = tid_();
      __syncthreads();
#pragma unroll
      for (int mi = 0; mi < 4; ++mi)
#pragma unroll
        for (int n2 = 0; n2 < 2; ++n2)
#pragma unroll
          for (int j = 0; j < 4; ++j) {
            const int m = r0 + mi * 16 + j;
            const int fl = (c0 >> 6) * 32 + n2 * 16 + (c0 & 15);
            Ts[m * 72 + fl] = f2bf(silu_f(acc[mi][2 * n2][j]) * acc[mi][2 * n2 + 1][j]);
          }
      __syncthreads();
#pragma unroll
      for (int i = 0; i < 4; ++i) {
        const int c = t2 + 256 * i, row = c >> 3, ch = c & 7;
        if (row < mvalid) *(u32x4*)(p.HID + (size_t)(hid_row + row) * 512 + nt * 64 + ch * 8) = *(const u32x4*)(Ts + row * 72 + ch * 8);
      }
    };
    if (mvalid == 128) gemm_tile<4, false, false>(p.H, 1024, p.IDXG + (size_t)inst * 1024 + mt * 128, 128, W, 1024, 1024, smem, epi);
    else gemm_tile<4, false, true>(p.H, 1024, p.IDXG + (size_t)inst * 1024 + mt * 128, mvalid, W, 1024, 1024, smem, epi);
  }
}

__device__ __forceinline__ void phase_moe_down(const Params& p, int l, bool last, unsigned char* smem) {
  const int npass = last ? 1 : 2;
  for (int pass = 0; pass < npass; ++pass)
  XCD_FOR(t, ((pass == npass - 1) ? 2048 : 256)) {
    int inst, mt, nt, mvalid, hid_row;
    if (pass == npass - 1) { const int e_ = t >> 7, b_ = (t >> 6) & 1; inst = b_ * 16 + e_; mt = (t >> 3) & 7; nt = t & 7; mvalid = 128; hid_row = inst * 1024 + mt * 128; }
    else { const int e_ = t >> 4, b_ = (t >> 3) & 1; inst = 32 + b_ * 16 + e_; mt = 0; nt = t & 7; mvalid = 32; hid_row = 32768 + (inst - 32) * 128; }
    const int e = inst & 15;
    const float* gate = p.GATE + (size_t)inst * 1024 + mt * 128;
    const u16* W = p.WdT + (size_t)(l * 16 + e) * 1024 * 512 + (size_t)nt * 128 * 512;
    u16* yb = p.YB + (size_t)hid_row * 1024 + nt * 128;
    auto epi = [&](f32x4(&acc)[4][4], int r0, int c0) {
      auto vf = [&](int r, int, float v) { return (r < mvalid ? gate[r] : 0.f) * v; };
      auto rp = [&](int r) -> u16* { return r < mvalid ? yb + (size_t)r * 1024 : nullptr; };
      epi_staged_bf16<4>(acc, r0, c0, smem, vf, rp);
    };
    if (mvalid == 128) gemm_tile<4, false, false>(p.HID + (size_t)hid_row * 512, 512, nullptr, 128, W, 512, 512, smem, epi);
    else gemm_tile<4, false, true>(p.HID + (size_t)hid_row * 512, 512, nullptr, mvalid, W, 512, 512, smem, epi);
  }
}

template <bool COMBINE, bool MOD>
__device__ __forceinline__ void phase_combine_modulate(const Params& p, int lprev, int lnext, const float* xlat, const float* xctx,
                                                       float* olat, float* octx, int nrows) {
  constexpr int R = 2;
  const int t = tid_(), lane = t & 63, wid = t >> 6;
  const int gw = bid_() * 4 + wid, nw = gridDim.x * 4;
  for (int row0 = gw * R; row0 < nrows; row0 += nw * R) {
    const bool lat = row0 < T_LAT;
    const float* xr = lat ? xlat + (size_t)row0 * DM : xctx + (size_t)(row0 - T_LAT) * DM;
    const int cond = row_cond(row0);
    float4 v[R][4];
#pragma unroll
    for (int r = 0; r < R; ++r)
#pragma unroll
      for (int i = 0; i < 4; ++i) v[r][i] = *(const float4*)(xr + (size_t)r * DM + i * 256 + lane * 4);
    if (COMBINE) {
      const int b = row_batch(row0);
      const int myinv = p.INV[(size_t)row0 * 16 + (lane & 31)];
      const float* g2 = p.mada + (size_t)(lprev * 3 + cond) * 6144 + 5 * 1024;
      float* orow = lat ? olat + (size_t)row0 * DM : octx + (size_t)(row0 - T_LAT) * DM;
#pragma unroll
      for (int r = 0; r < R; ++r) {
        float4 s[4];
#pragma unroll
        for (int i = 0; i < 4; ++i) s[i] = make_float4(0.f, 0.f, 0.f, 0.f);
        unsigned mask = (unsigned)((__ballot(myinv >= 0) >> (16 * r)) & 0xFFFFull);
        while (mask) {
          const int e0 = __builtin_ctz(mask);
          mask &= mask - 1;
          const bool two = mask != 0u;
          const int e1 = two ? __builtin_ctz(mask) : e0;
          mask &= mask - 1;
          const int s0 = __shfl(myinv, 16 * r + e0), s1 = __shfl(myinv, 16 * r + e1);
          const size_t y0 = lat ? (size_t)(b * 16 + e0) * 1024 + s0 : (size_t)32768 + (size_t)(b * 16 + e0) * 128 + s0;
          const size_t y1 = lat ? (size_t)(b * 16 + e1) * 1024 + s1 : (size_t)32768 + (size_t)(b * 16 + e1) * 128 + s1;
          u32x2 a0[4], a1[4];
#pragma unroll
          for (int i = 0; i < 4; ++i) { a0[i] = *(const u32x2*)(p.YB + y0 * 1024 + lane * 4 + i * 256); a1[i] = *(const u32x2*)(p.YB + y1 * 1024 + lane * 4 + i * 256); }
          const float w1 = two ? 1.f : 0.f;
#pragma unroll
          for (int i = 0; i < 4; ++i) {
            s[i].x += bf2f((u16)(a0[i].x & 0xffffu)); s[i].y += bf2f((u16)(a0[i].x >> 16));
            s[i].z += bf2f((u16)(a0[i].y & 0xffffu)); s[i].w += bf2f((u16)(a0[i].y >> 16));
            s[i].x += w1 * bf2f((u16)(a1[i].x & 0xffffu)); s[i].y += w1 * bf2f((u16)(a1[i].x >> 16));
            s[i].z += w1 * bf2f((u16)(a1[i].y & 0xffffu)); s[i].w += w1 * bf2f((u16)(a1[i].y >> 16));
          }
        }
#pragma unroll
        for (int i = 0; i < 4; ++i) {
          const int col = i * 256 + lane * 4;
          const float4 g4 = *(const float4*)(g2 + col);
          v[r][i].x += g4.x * s[i].x; v[r][i].y += g4.y * s[i].y; v[r][i].z += g4.z * s[i].z; v[r][i].w += g4.w * s[i].w;
          *(float4*)(orow + (size_t)r * DM + col) = v[r][i];
        }
      }
    }
    if (MOD) {
      const float* sh = p.mada + (size_t)(lnext * 3 + cond) * 6144;
      const float* sc = sh + 1024;
      float rstd[R];
#pragma unroll
      for (int r = 0; r < R; ++r) {
        float ss = 0.f;
#pragma unroll
        for (int i = 0; i < 4; ++i) ss += v[r][i].x * v[r][i].x + v[r][i].y * v[r][i].y + v[r][i].z * v[r][i].z + v[r][i].w * v[r][i].w;
        rstd[r] = rsqrtf(wave_sum(ss) * (1.f / 1024.f) + 1e-6f);
      }
#pragma unroll
      for (int i = 0; i < 4; ++i) {
        const int col = i * 256 + lane * 4;
        const float4 s4 = *(const float4*)(sc + col);
        const float4 h4 = *(const float4*)(sh + col);
#pragma unroll
        for (int r = 0; r < R; ++r) {
          u32x2 pk;
          pk.x = pack2(v[r][i].x * rstd[r] * (1.f + s4.x) + h4.x, v[r][i].y * rstd[r] * (1.f + s4.y) + h4.y);
          pk.y = pack2(v[r][i].z * rstd[r] * (1.f + s4.z) + h4.z, v[r][i].w * rstd[r] * (1.f + s4.w) + h4.w);
          *(u32x2*)(p.H + (size_t)(row0 + r) * DM + col) = pk;
        }
      }
    }
  }
}

__global__ void __launch_bounds__(256, 2) fwd_megakernel(Params p_unused) {
  const Params& p = *(const Params*)__builtin_amdgcn_kernarg_segment_ptr();
  __shared__ __attribute__((aligned(16))) unsigned char smem[SMEM_BYTES];
  __shared__ uint4 xb_words;
  cg::grid_group grid = cg::this_grid();
  if (threadIdx.x == 0) xb_words = make_uint4(0u, 0u, 0u, 0u);
  __syncthreads();
  XcdBarrier xb = xcd_barrier_post(p.bar, (volatile LAS unsigned*)&xb_words);

#define LP (*launder_(&p))
  phase_prep(LP, smem);
  if (xb_ld(&p.bar[XB_TMO]) == 0xFFFFFFFFu) grid.sync();
  if (threadIdx.x == 0) {
    XB_SPIN(xb_ld(&p.bar[64]) < 192u, p.bar);
    __builtin_amdgcn_fence(__ATOMIC_ACQUIRE, "agent");
    asm volatile("s_waitcnt vmcnt(0)" ::: "memory");
  }
  __syncthreads();

  for (int l = 0; l < 2; ++l) {
    const bool last = (l == 1);
    if (!last) { phase_router_prep(LP); phase_combine_modulate<false, true>(LP, 0, 0, p.x, p.ctx, nullptr, nullptr, TT); }
    else phase_combine_modulate<true, true>(LP, 0, 1, p.out, p.XC, p.out, p.XC, TT);
    xcd_barrier(xb);
    phase_in_gemm(LP, l, smem);
    xcd_barrier(xb);
    phase_mix_a(LP, l, last, smem);
    xcd_barrier(xb);
    phase_mix_b(LP, l, last, smem);
    xcd_barrier(xb);
    phase_attn(LP, l, last, smem);
    xcd_barrier(xb);
    phase_out_gemm(LP, l, last, last ? p.out : p.x, last ? p.XC : p.ctx, p.out, p.XC, smem);
    xcd_barrier(xb);
    phase_router(LP, l, p.out, p.XC, last ? T_LAT : TT);
    xcd_barrier(xb);
    phase_topk(LP, last, smem);
    phase_modulate<4>(LP, l, p.out, p.XC, last ? T_LAT : TT, 3, last ? 32 : 64);
    xcd_barrier(xb);
    phase_moe_up(LP, l, last, smem);
    xcd_barrier(xb);
    phase_moe_down(LP, l, last, smem);
    xcd_barrier(xb);
  }
  phase_combine_modulate<true, false>(LP, 1, 1, p.out, p.XC, p.out, p.XC, T_LAT);
#undef LP
}

extern "C" void kernel_launch(void* const* d_in, const int* in_sizes, int n_in, void* d_out, int out_size, void* d_ws,
                              size_t ws_size, hipStream_t stream) {
  static int grid_blocks = 0;
  if (!grid_blocks) {
    int dev = 0, cus = 0, per_cu = 0;
    hipGetDevice(&dev);
    hipDeviceGetAttribute(&cus, hipDeviceAttributeMultiprocessorCount, dev);
    hipOccupancyMaxActiveBlocksPerMultiprocessor(&per_cu, fwd_megakernel, 256, 0);
    if (per_cu > 2) per_cu = 2;
    if (per_cu < 1) per_cu = 1;
    grid_blocks = (cus * per_cu) & ~7;
    if (grid_blocks < 8) grid_blocks = 8;
  }
  Params p{};
  const float* const* in = (const float* const*)d_in;
  p.x = in[0]; p.c = in[1]; p.ctx = in[2]; p.c_ctx = in[3]; p.w_ada = in[4]; p.b_ada = in[5]; p.w_in = in[6];
  p.sgu_norm = in[7]; p.w_sgu = in[8]; p.b_sgu = in[9]; p.q_lora_norm = in[10]; p.w_uq = in[11]; p.kv_lora_norm = in[12];
  p.w_ukv = in[13]; p.q_norm = in[14]; p.k_norm = in[15]; p.w_out = in[16]; p.w_router = in[17]; p.w_gate = in[18];
  p.w_up = in[19]; p.w_down = in[20];
  p.out = (float*)d_out;
  unsigned char* base = (unsigned char*)d_ws;
  size_t off = 0;
  auto alloc = [&](size_t bytes) { void* r = base + off; off += (bytes + 255) & ~(size_t)255; return r; };
  p.bar = (unsigned*)alloc(16384);
  p.mada = (float*)alloc((size_t)2 * 3 * 6144 * 4);
  p.WinT = (u16*)alloc((size_t)2 * 1536 * 1024 * 2);
  p.WuqT = (u16*)alloc((size_t)2 * 768 * 256 * 2);
  p.WukvT = (u16*)alloc((size_t)2 * 1024 * 128 * 2);
  p.WoutT = (u16*)alloc((size_t)2 * 1024 * 1024 * 2);
  p.WguT = (u16*)alloc((size_t)2 * 16 * 1024 * 1024 * 2);
  p.WdT = (u16*)alloc((size_t)2 * 16 * 1024 * 512 * 2);
  p.Wsgu = (u16*)alloc((size_t)2 * 4 * 128 * 128 * 2);
  p.M1 = (u16*)alloc((size_t)128 * 128 * 128 * 2);
  p.M2 = (u16*)alloc((size_t)128 * 256 * 2);
  p.Mc = (u16*)alloc((size_t)256 * 512 * 2);
  p.XC = (float*)alloc((size_t)T_CTX * DM * 4);
  p.AFFT = (float*)alloc((size_t)(32 * SEQ + 32 * CTX) * 4);
  p.GATE = (float*)alloc((size_t)64 * 1024 * 4);
  p.IDXG = (int*)alloc((size_t)64 * 1024 * 4);
  p.INV = (int*)alloc((size_t)TT * 16 * 4);
  p.WR2 = (float*)alloc((size_t)2 * 3 * 16384 * 4);
  p.CE = (float*)alloc((size_t)96 * 4);
  p.GDc = (u16*)alloc((size_t)2 * 2 * CTX * 256 * 2);
  unsigned char* RH = (unsigned char*)alloc((size_t)TT * 1024 * 2);
  p.H = (u16*)RH;
  p.PF = (u16*)RH;
  p.KN = (u16*)(RH + (size_t)2 * 64 * 2 * 128 * 256 * 2);
  p.PX = (u16*)alloc((size_t)TT * 1024 * 2);
  p.YM = (u16*)alloc((size_t)TT * 1024 * 2);
  unsigned char* RA = (unsigned char*)alloc((size_t)2 * 4 * NPOS * 192 * 2);
  unsigned char* RB = (unsigned char*)alloc((size_t)2 * 4 * NPOS * 192 * 2);
  p.GD = (u16*)RA;
  p.Qall = (u16*)RA;
  p.Kb = (u16*)RB;
  p.QR = (u16*)alloc((size_t)TT * 768 * 2);
  p.HID = p.QR;
  p.YB = p.PX;
  p.Vt = (u16*)alloc((size_t)2 * 4 * 128 * NPOS * 2);
  if (off > ws_size) fprintf(stderr, "workspace too small: need %zu have %zu\n", off, ws_size);

  hipMemsetAsync(p.bar, 0, 16384, stream);
  void* args[] = {&p};
  hipError_t e = hipLaunchCooperativeKernel((void*)fwd_megakernel, dim3(grid_blocks), dim3(256), args, 0, stream);
  if (e != hipSuccess) fprintf(stderr, "cooperative launch failed: %s (grid %d)\n", hipGetErrorString(e), grid_blocks);
}
```

```cpp
#include <hip/hip_runtime.h>
#include <hip/hip_cooperative_groups.h>
#include <stdint.h>
#include <stdio.h>
namespace cg = cooperative_groups;

typedef unsigned short u16;
typedef __attribute__((ext_vector_type(8))) short bf16x8;
typedef __attribute__((ext_vector_type(4))) float f32x4;
typedef unsigned __attribute__((ext_vector_type(4))) u32x4;
typedef unsigned __attribute__((ext_vector_type(2))) u32x2;

constexpr int DM = 1024;
constexpr int SEQ = 8192, CTX = 256;
constexpr int T_LAT = 2 * SEQ, T_CTX = 2 * CTX, TT = T_LAT + T_CTX;
constexpr int NPOS = SEQ + CTX;
constexpr int SMEM_BYTES = 71680;

struct Params {
  const float *x, *c, *ctx, *c_ctx, *w_ada, *b_ada, *w_in, *sgu_norm, *w_sgu, *b_sgu, *q_lora_norm, *w_uq,
      *kv_lora_norm, *w_ukv, *q_norm, *k_norm, *w_out, *w_router, *w_gate, *w_up, *w_down;
  float* out;
  unsigned* bar;
  float* mada;
  u16 *WinT, *WuqT, *WukvT, *WoutT, *WguT, *WdT, *Wsgu, *M1, *M2, *Mc;
  float* XC;
  u16 *H, *PX, *YM, *GD, *GDc, *PF, *QR, *KN, *Vt, *Qall, *Kb, *HID;
  float *AFFT, *GATE, *WR2, *CE;
  int *IDXG, *INV;
  u16* YB;
};

typedef float f32x2_t __attribute__((ext_vector_type(2)));
typedef __bf16 bf16x2_t __attribute__((ext_vector_type(2)));
__device__ __forceinline__ unsigned pack2(float a, float b) {
  f32x2_t v = {a, b};
  bf16x2_t r = __builtin_convertvector(v, bf16x2_t);
  return __builtin_bit_cast(unsigned, r);
}
__device__ __forceinline__ u16 f2bf(float f) { return (u16)(pack2(f, 0.f) & 0xffffu); }
__device__ __forceinline__ float bf2f(u16 b) { return __uint_as_float(((unsigned)b) << 16); }
__device__ __forceinline__ float wave_sum(float v) {
#pragma unroll
  for (int o = 32; o; o >>= 1) v += __shfl_xor(v, o);
  return v;
}
__device__ __forceinline__ int tid_() { int t = threadIdx.x; asm volatile("" : "+v"(t)); return t; }
__device__ __forceinline__ const struct Params* launder_(const struct Params* q) { asm volatile("" : "+s"(q)); return q; }
__device__ __forceinline__ int bid_() { int b = blockIdx.x; asm volatile("" : "+s"(b)); return b; }
__device__ __forceinline__ float gelu_tanh(float x) {
  float y = 0.7978845608028654f * (x + 0.044715f * x * x * x);
  return x / (1.f + __expf(-2.f * y));
}
__device__ __forceinline__ float silu_f(float x) { return x / (1.f + __expf(-x)); }

#define XB_TMO 128
#define XB_XCNT(j) (256 + 64 * (j))
#define XB_XSUB(j) (1280 + 64 * (j))
#define XB_XGEN(j) (2304 + 64 * (j))
#define XB_TOP 3328
#define XB_TOPGEN 3392
#define XCD_BAR_WORDS 3456
#define XB_SPIN_CAP (1u << 22)
#define LAS __attribute__((address_space(3)))

__device__ __forceinline__ unsigned xb_ld(unsigned* p) { return __hip_atomic_load(p, __ATOMIC_RELAXED, __HIP_MEMORY_SCOPE_AGENT); }
__device__ __forceinline__ unsigned xb_add(unsigned* p, unsigned v) { return __hip_atomic_fetch_add(p, v, __ATOMIC_RELAXED, __HIP_MEMORY_SCOPE_AGENT); }
__device__ __forceinline__ unsigned xb_xcc_id() { return (unsigned)__builtin_amdgcn_s_getreg((3 << 11) | 20) & 0xFu; }
#define XB_SPIN(cond, bar)                                            \
  do {                                                                \
    unsigned _sp = 0;                                                 \
    while (cond) {                                                    \
      __builtin_amdgcn_s_sleep(1);                                    \
      if ((++_sp & 255u) == 0u) {                                     \
        if (xb_ld(&(bar)[XB_TMO])) break;                             \
        if (_sp > XB_SPIN_CAP) { atomicAdd(&(bar)[XB_TMO], 1u); break; } \
      }                                                               \
    }                                                                 \
  } while (0)

struct XcdBarrier {
  unsigned* bar;
  unsigned x;
  volatile LAS unsigned* st;
};
__device__ __forceinline__ XcdBarrier xcd_barrier_post(unsigned* bar, volatile LAS unsigned* st) {
  XcdBarrier b;
  b.bar = bar;
  b.x = xb_xcc_id();
  b.st = st;
  if (threadIdx.x == 0) (void)xb_add(&bar[XB_XCNT(b.x)], 1u);
  return b;
}
__device__ __forceinline__ void xcd_barrier_complete(unsigned* bar, unsigned x, unsigned& nloc, unsigned& nx) {
  const unsigned G = gridDim.x * gridDim.y * gridDim.z;
  unsigned sum, cnt, mine, sp = 0u;
  for (;;) {
    sum = 0u; cnt = 0u; mine = 0u;
#pragma unroll
    for (unsigned j = 0; j < 16; ++j) {
      const unsigned c = xb_ld(&bar[XB_XCNT(j)]);
      sum += c; cnt += (c > 0u) ? 1u : 0u; mine = (j == x) ? c : mine;
    }
    if (sum == G) break;
    __builtin_amdgcn_s_sleep(1);
    if ((++sp & 255u) == 0u) {
      if (xb_ld(&bar[XB_TMO])) break;
      if (sp > XB_SPIN_CAP) { atomicAdd(&bar[XB_TMO], 1u); break; }
    }
  }
  nloc = mine > 0u ? mine : 1u;
  nx = cnt > 0u ? cnt : 1u;
}
__device__ __forceinline__ void xcd_barrier(const XcdBarrier& b) {
  asm volatile("s_waitcnt vmcnt(0)" ::: "memory");
  __syncthreads();
  if (threadIdx.x == 0) {
    unsigned* bar = b.bar;
    __builtin_amdgcn_s_waitcnt(0);
    unsigned nloc = b.st[0], nx = b.st[1];
    if (nloc == 0u) { xcd_barrier_complete(bar, b.x, nloc, nx); b.st[0] = nloc; b.st[1] = nx; }
    const unsigned old = xb_add(&bar[XB_XSUB(b.x)], 1u);
    const unsigned gen = old / nloc;
    if (old + 1u == (gen + 1u) * nloc) {
      __builtin_amdgcn_fence(__ATOMIC_RELEASE, "agent");
      asm volatile("s_waitcnt vmcnt(0)" ::: "memory");
      const unsigned og = xb_add(&bar[XB_TOP], 1u);
      const unsigned tg = og / nx;
      if (og + 1u == (tg + 1u) * nx) xb_add(&bar[XB_TOPGEN], 1u);
      else XB_SPIN(xb_ld(&bar[XB_TOPGEN]) == tg, bar);
      __builtin_amdgcn_fence(__ATOMIC_ACQUIRE, "agent");
      xb_add(&bar[XB_XGEN(b.x)], 1u);
      asm volatile("s_waitcnt vmcnt(0)" ::: "memory");
    } else {
      XB_SPIN(xb_ld(&bar[XB_XGEN(b.x)]) == gen, bar);
      __builtin_amdgcn_fence(__ATOMIC_ACQUIRE, "agent");
      asm volatile("s_waitcnt vmcnt(0)" ::: "memory");
    }
  }
  __syncthreads();
}

#define XCD_FOR(u, T)                                                                                         \
  for (int _x = bid_() & 7, _gb = gridDim.x >> 3, _hi = (int)(((long)(_x + 1) * (T)) >> 3),                    \
           u = (int)(((long)_x * (T)) >> 3) + (bid_() >> 3);                                                  \
       u < _hi; u += _gb)

template <int NT, bool BKN, bool MASK = false, bool ROWSS = false, class Epi>
__device__ __forceinline__ void gemm_tile(const u16* __restrict__ A, int lda, const int* __restrict__ arows, int mvalid,
                                          const u16* __restrict__ B, int ldb, int K, unsigned char* smem, Epi epi,
                                          const float* ascale = nullptr) {
  constexpr int BN = NT * 32;
  constexpr int CPR = BN / 8;
  u16* S0 = (u16*)smem;
  const int t = tid_(), lane = t & 63, wid = t >> 6, wr = wid >> 1, wc = wid & 1, l16 = lane & 15, quad = lane >> 4;
  const u16* ap[4];
  const u16* bp[NT];
  unsigned amask = 0u;
#pragma unroll
  for (int i = 0; i < 4; ++i) {
    const int row = (t >> 3) + 32 * i;
    const bool v = MASK ? (row < mvalid) : true;
    amask |= v ? (1u << i) : 0u;
    int r = v ? row : 0;
    if (arows) r = arows[r];
    ap[i] = A + (size_t)r * lda + (t & 7) * 8;
  }
#pragma unroll
  for (int i = 0; i < NT; ++i) {
    if (!BKN) bp[i] = B + (size_t)((t >> 3) + 32 * i) * ldb + (t & 7) * 8;
    else { const int c = t + 256 * i; bp[i] = B + (size_t)(c / CPR) * ldb + (c % CPR) * 8; }
  }
  const size_t bstep = BKN ? (size_t)64 * ldb : (size_t)64;
  int nmi = 4;
  if (MASK) { nmi = (mvalid - wr * 64 + 15) >> 4; nmi = nmi < 0 ? 0 : (nmi > 4 ? 4 : nmi); nmi = __builtin_amdgcn_readfirstlane(nmi); }
  u32x4 ra0[4], rb0[NT], ra1[4], rb1[NT];
#define GEMM_LOAD(RA, RB, kt_)                                                                      \
  {                                                                                                 \
    _Pragma("unroll") for (int i = 0; i < 4; ++i) {                                                 \
      RA[i] = *(const u32x4*)(ap[i] + (size_t)(kt_) * 64);                                          \
      if (MASK && !((amask >> i) & 1u)) RA[i] = (u32x4){0u, 0u, 0u, 0u};                            \
    }                                                                                               \
    _Pragma("unroll") for (int i = 0; i < NT; ++i) RB[i] = *(const u32x4*)(bp[i] + (size_t)(kt_) * bstep); \
  }
#define GEMM_STORE(RA, RB, st_)                                                                     \
  {                                                                                                 \
    u16* As_ = S0 + (st_) * 16384;                                                                  \
    u16* Bs_ = As_ + 8192;                                                                          \
    if (ROWSS) {                                                                                    \
      _Pragma("unroll") for (int i = 0; i < 4; ++i) {                                               \
        const u32x4 w_ = RA[i];                                                                     \
        const float a0 = __uint_as_float(w_.x << 16), a1 = __uint_as_float(w_.x & 0xffff0000u);     \
        const float a2 = __uint_as_float(w_.y << 16), a3 = __uint_as_float(w_.y & 0xffff0000u);     \
        const float a4 = __uint_as_float(w_.z << 16), a5 = __uint_as_float(w_.z & 0xffff0000u);     \
        const float a6 = __uint_as_float(w_.w << 16), a7 = __uint_as_float(w_.w & 0xffff0000u);     \
        ss_[i] += (a0 * a0 + a1 * a1) + (a2 * a2 + a3 * a3) + (a4 * a4 + a5 * a5) + (a6 * a6 + a7 * a7); \
      }                                                                                             \
    }                                                                                               \
    if (ascale) {                                                                                   \
      const float* sc_ = ascale + stk_ * 64 + (t & 7) * 8;                                          \
      const float4 s0_ = *(const float4*)(sc_), s1_ = *(const float4*)(sc_ + 4);                    \
      _Pragma("unroll") for (int i = 0; i < 4; ++i) {                                               \
        u32x4 w_ = RA[i];                                                                           \
        w_.x = pack2(__uint_as_float(w_.x << 16) * s0_.x, __uint_as_float(w_.x & 0xffff0000u) * s0_.y); \
        w_.y = pack2(__uint_as_float(w_.y << 16) * s0_.z, __uint_as_float(w_.y & 0xffff0000u) * s0_.w); \
        w_.z = pack2(__uint_as_float(w_.z << 16) * s1_.x, __uint_as_float(w_.z & 0xffff0000u) * s1_.y); \
        w_.w = pack2(__uint_as_float(w_.w << 16) * s1_.z, __uint_as_float(w_.w & 0xffff0000u) * s1_.w); \
        RA[i] = w_;                                                                                 \
      }                                                                                             \
    }                                                                                               \
    ++stk_;                                                                                         \
    _Pragma("unroll") for (int i = 0; i < 4; ++i) {                                                 \
      const int row = (t >> 3) + 32 * i;                                                            \
      *(u32x4*)(As_ + row * 64 + (((t & 7) ^ ((row >> 1) & 7)) << 3)) = RA[i];                      \
    }                                                                                               \
    if (!BKN) {                                                                                     \
      _Pragma("unroll") for (int i = 0; i < NT; ++i) {                                              \
        const int row = (t >> 3) + 32 * i;                                                          \
        *(u32x4*)(Bs_ + row * 64 + (((t & 7) ^ ((row >> 1) & 7)) << 3)) = RB[i];                    \
      }                                                                                             \
    } else {                                                                                        \
      _Pragma("unroll") for (int i = 0; i < NT; ++i) {                                              \
        const int c = t + 256 * i;                                                                  \
        const int k = c / CPR, n8 = (c % CPR) * 8;                                                  \
        const u32x4 w = RB[i];                                                                      \
        const unsigned e[8] = {w.x & 0xffffu, w.x >> 16, w.y & 0xffffu, w.y >> 16, w.z & 0xffffu, w.z >> 16, w.w & 0xffffu, w.w >> 16}; \
        _Pragma("unroll") for (int j = 0; j < 8; ++j) {                                             \
          const int n = n8 + j;                                                                     \
          Bs_[n * 64 + ((((k >> 3) ^ ((n >> 1) & 7))) << 3) + (k & 7)] = (u16)e[j];                 \
        }                                                                                           \
      }                                                                                             \
    }                                                                                               \
  }
#define GEMM_COMPUTE(st_)                                                                           \
  {                                                                                                 \
    const u16* As_ = S0 + (st_) * 16384;                                                            \
    const u16* Bs_ = As_ + 8192;                                                                    \
    _Pragma("unroll") for (int ks = 0; ks < 2; ++ks) {                                              \
      bf16x8 af[4], bfr[NT];                                                                        \
      _Pragma("unroll") for (int mi = 0; mi < 4; ++mi) {                                            \
        const int row = wr * 64 + mi * 16 + l16;                                                    \
        af[mi] = *(const bf16x8*)(As_ + row * 64 + (((ks * 4 + quad) ^ ((row >> 1) & 7)) << 3));    \
      }                                                                                             \
      _Pragma("unroll") for (int ni = 0; ni < NT; ++ni) {                                           \
        const int row = wc * (BN / 2) + ni * 16 + l16;                                              \
        bfr[ni] = *(const bf16x8*)(Bs_ + row * 64 + (((ks * 4 + quad) ^ ((row >> 1) & 7)) << 3));   \
      }                                                                                             \
      _Pragma("unroll") for (int mi = 0; mi < 4; ++mi)                                              \
        if (!MASK || mi < nmi)                                                                      \
        _Pragma("unroll") for (int ni = 0; ni < NT; ++ni) acc[mi][ni] = __builtin_amdgcn_mfma_f32_16x16x32_bf16(af[mi], bfr[ni], acc[mi][ni], 0, 0, 0); \
    }                                                                                               \
  }
  float ss_[4] = {0.f, 0.f, 0.f, 0.f};
  int stk_ = 0;
  f32x4 acc[4][NT];
#pragma unroll
  for (int i = 0; i < 4; ++i)
#pragma unroll
    for (int j = 0; j < NT; ++j) acc[i][j] = (f32x4){0.f, 0.f, 0.f, 0.f};
  const int nk = K >> 6;
  const int nkm1 = nk - 1;
  __syncthreads();
  GEMM_LOAD(ra0, rb0, 0);
  GEMM_LOAD(ra1, rb1, 1);
  GEMM_STORE(ra0, rb0, 0);
  GEMM_LOAD(ra0, rb0, (2 < nkm1 ? 2 : nkm1));
  __syncthreads();
  for (int kt = 0; kt < nk - 2; kt += 2) {
    GEMM_COMPUTE(0);
    GEMM_STORE(ra1, rb1, 1);
    GEMM_LOAD(ra1, rb1, kt + 3);
    __syncthreads();
    GEMM_COMPUTE(1);
    GEMM_STORE(ra0, rb0, 0);
    GEMM_LOAD(ra0, rb0, (kt + 4 < nkm1 ? kt + 4 : nkm1));
    __syncthreads();
  }
  GEMM_COMPUTE(0);
  GEMM_STORE(ra1, rb1, 1);
  __syncthreads();
  GEMM_COMPUTE(1);
#undef GEMM_LOAD
#undef GEMM_STORE
#undef GEMM_COMPUTE
  if (ROWSS) {
    float* rs = (float*)(smem + 65536);
#pragma unroll
    for (int i = 0; i < 4; ++i) {
      float s = ss_[i];
      s += __shfl_xor(s, 1); s += __shfl_xor(s, 2); s += __shfl_xor(s, 4);
      if ((t & 7) == 0) rs[(t >> 3) + 32 * i] = rsqrtf(s / (float)K + 1e-6f);
    }
    __syncthreads();
  }
  epi(acc, wr * 64 + quad * 4, wc * (BN / 2) + l16);
}

template <int NT, class VF, class RP>
__device__ __forceinline__ void epi_staged_bf16(f32x4 (&acc)[4][NT], int r0, int c0, unsigned char* smem, VF vf, RP rowptr) {
  constexpr int BN = NT * 32, PITCH = BN + 8, CPR = BN / 8;
  u16* Ts = (u16*)smem;
  const int t = tid_();
  __syncthreads();
#pragma unroll
  for (int mi = 0; mi < 4; ++mi)
#pragma unroll
    for (int ni = 0; ni < NT; ++ni)
#pragma unroll
      for (int j = 0; j < 4; ++j) {
        const int r = r0 + mi * 16 + j, c = c0 + ni * 16;
        Ts[r * PITCH + c] = f2bf(vf(r, c, acc[mi][ni][j]));
      }
  __syncthreads();
#pragma unroll
  for (int i = 0; i < CPR / 2; ++i) {
    const int c = t + 256 * i, row = c / CPR, ch = c % CPR;
    u16* d = rowptr(row);
    if (d) *(u32x4*)(d + ch * 8) = *(const u32x4*)(Ts + row * PITCH + ch * 8);
  }
}

template <class RP>
__device__ __forceinline__ void epi_staged_bf16_T(f32x4 (&acc)[4][4], int r0, int c0, unsigned char* smem, RP colptr) {
  constexpr int PITCH = 136;
  u16* Ts = (u16*)smem;
  const int t = tid_();
  __syncthreads();
#pragma unroll
  for (int mi = 0; mi < 4; ++mi)
#pragma unroll
    for (int ni = 0; ni < 4; ++ni) {
      u32x2 pk;
      pk.x = pack2(acc[mi][ni][0], acc[mi][ni][1]);
      pk.y = pack2(acc[mi][ni][2], acc[mi][ni][3]);
      *(u32x2*)(Ts + (c0 + ni * 16) * PITCH + r0 + mi * 16) = pk;
    }
  __syncthreads();
#pragma unroll
  for (int i = 0; i < 8; ++i) {
    const int c = t + 256 * i, col = c >> 4, ch = c & 15;
    *(u32x4*)(colptr(col) + ch * 8) = *(const u32x4*)(Ts + col * PITCH + ch * 8);
  }
}

__device__ __forceinline__ void epi_staged_residual(f32x4 (&acc)[4][4], int r0, int c0, unsigned char* smem, const float* __restrict__ g,
                                                    const float* __restrict__ xs, float* __restrict__ xd) {
  constexpr int PITCH = 132;
  float* Ts = (float*)smem;
  const int t = tid_();
  const int wr = r0 >> 6;
#pragma unroll
  for (int pass = 0; pass < 2; ++pass) {
    __syncthreads();
    if (wr == pass) {
#pragma unroll
      for (int mi = 0; mi < 4; ++mi)
#pragma unroll
        for (int ni = 0; ni < 4; ++ni)
#pragma unroll
          for (int j = 0; j < 4; ++j) Ts[((r0 & 63) + mi * 16 + j) * PITCH + c0 + ni * 16] = acc[mi][ni][j];
    }
    __syncthreads();
#pragma unroll
    for (int i = 0; i < 8; ++i) {
      const int c = t + 256 * i, row = c >> 5, ch = c & 31;
      const float4 a = *(const float4*)(Ts + row * PITCH + ch * 4);
      const float4 gg = *(const float4*)(g + ch * 4);
      const size_t o = (size_t)(pass * 64 + row) * DM + ch * 4;
      float4 x = *(const float4*)(xs + o);
      x.x += gg.x * a.x; x.y += gg.y * a.y; x.z += gg.z * a.z; x.w += gg.w * a.w;
      *(float4*)(xd + o) = x;
    }
  }
}

__device__ __forceinline__ void ada_item(const Params& p, int it, unsigned char* smem) {
  float* sc = (float*)smem;
  float* red = sc + 3072;
  const int t = tid_(), lane = t & 63, wid = t >> 6;
  const int l = it / 96, jc = it % 96;
#pragma unroll
  for (int i = 0; i < 12; ++i) {
    const int idx = t + 256 * i, r = idx >> 10, k = idx & 1023;
    const float cv = r < 2 ? p.c[r * 1024 + k] : p.c_ctx[k];
    sc[idx] = silu_f(cv);
  }
  __syncthreads();
  const float* w = p.w_ada + (size_t)l * 1024 * 6144 + jc * 64 + lane;
  float a0 = 0.f, a1 = 0.f, a2 = 0.f;
  const int kb = wid * 256;
#pragma unroll 8
  for (int k = 0; k < 256; ++k) {
    const float wv = w[(size_t)(kb + k) * 6144];
    a0 += sc[kb + k] * wv;
    a1 += sc[1024 + kb + k] * wv;
    a2 += sc[2048 + kb + k] * wv;
  }
  red[(wid * 3 + 0) * 64 + lane] = a0;
  red[(wid * 3 + 1) * 64 + lane] = a1;
  red[(wid * 3 + 2) * 64 + lane] = a2;
  __syncthreads();
  if (t < 192) {
    const int r = t >> 6, ln = t & 63;
    float s = 0.f;
#pragma unroll
    for (int w4 = 0; w4 < 4; ++w4) s += red[(w4 * 3 + r) * 64 + ln];
    s += p.b_ada[l * 6144 + jc * 64 + ln];
    p.mada[(l * 3 + r) * 6144 + jc * 64 + ln] = s;
  }
  asm volatile("s_waitcnt vmcnt(0)" ::: "memory");
  __syncthreads();
  if (t == 0) {
    __builtin_amdgcn_fence(__ATOMIC_RELEASE, "agent");
    asm volatile("s_waitcnt vmcnt(0)" ::: "memory");
    (void)xb_add(&p.bar[64], 1u);
  }
}

__device__ __forceinline__ void fold_item(const Params& p, int it, unsigned char* smem) {
  float* tile = (float*)smem;
  float* ct = tile + 64 * 65;
  const int t = tid_();
  const int l = it >> 6, rem = it & 63, g = rem >> 4, k0 = (rem & 15) * 64;
#pragma unroll
  for (int i = 0; i < 16; ++i) {
    const int kk = i * 4 + (t >> 6), d = t & 63;
    tile[kk * 65 + d] = p.w_in[(size_t)(l * 1024 + k0 + kk) * 1216 + 512 + g * 64 + d];
  }
  if (t < 64) ct[t] = cospif((float)t / 32.f);
  __syncthreads();
  const int k = t & 63, jg = t >> 6;
  u16* dst = p.WinT + (size_t)l * 1536 * 1024;
  for (int jj = 0; jj < 16; ++jj) {
    const int j = jg + 4 * jj;
    float sr = 0.f, si = 0.f;
#pragma unroll 8
    for (int d = 0; d < 64; ++d) {
      const float v = tile[k * 65 + d];
      const int m = (j * d) & 63;
      sr += v * ct[m];
      si += v * ct[(m - 16) & 63];
    }
    dst[(size_t)(512 + g * 64 + j) * 1024 + k0 + k] = f2bf(sr);
    dst[(size_t)(768 + g * 64 + j) * 1024 + k0 + k] = f2bf(-si);
  }
  __syncthreads();
}

__device__ __forceinline__ void convT_tile(const float* __restrict__ src, int lds, int k0, int c0, u16* __restrict__ dst, int Kd,
                                           int rbase, int mode, int which, unsigned char* smem, const float* __restrict__ kscale = nullptr) {
  float* tile = (float*)smem;
  const int t = tid_();
  float4 v4[4];
#pragma unroll
  for (int i = 0; i < 4; ++i) {
    const f32x4 w_ = __builtin_nontemporal_load((const f32x4*)(src + (size_t)(k0 + i * 16 + (t >> 4)) * lds + c0 + (t & 15) * 4));
    v4[i] = make_float4(w_[0], w_[1], w_[2], w_[3]);
  }
#pragma unroll
  for (int i = 0; i < 4; ++i) {
    const int kk = i * 16 + (t >> 4), cc = (t & 15) * 4;
    const float sc = kscale ? kscale[k0 + kk] : 1.f;
    tile[kk * 65 + cc + 0] = v4[i].x * sc; tile[kk * 65 + cc + 1] = v4[i].y * sc;
    tile[kk * 65 + cc + 2] = v4[i].z * sc; tile[kk * 65 + cc + 3] = v4[i].w * sc;
  }
  __syncthreads();
#pragma unroll
  for (int i = 0; i < 16; ++i) {
    const int cc = i * 4 + (t >> 6), kk = t & 63;
    int row;
    if (mode == 0) row = rbase + cc;
    else { const int f = c0 + cc; row = (((f >> 4) * 2 + which) << 4) + (f & 15); }
    dst[(size_t)row * Kd + k0 + kk] = f2bf(tile[kk * 65 + cc]);
  }
  __syncthreads();
}

__device__ __forceinline__ void conv_item(const Params& p, int it, unsigned char* smem) {
  const int l = it / 6720;
  int r = it % 6720;
  if (r < 240) {
    const int ct = r >> 4, kt = r & 15;
    const int c0 = (ct < 8 ? ct : ct + 4) * 64;
    const int n0 = c0 + (c0 >= 768 ? 256 : 0);
    convT_tile(p.w_in + (size_t)l * 1024 * 1216, 1216, kt * 64, c0, p.WinT + (size_t)l * 1536 * 1024, 1024, n0, 0, 0, smem);
    return;
  }
  r -= 240;
  if (r < 48) {
    const int ct = r >> 2, kt = r & 3;
    convT_tile(p.w_uq + (size_t)l * 256 * 768, 768, kt * 64, ct * 64, p.WuqT + (size_t)l * 768 * 256, 256, ct * 64, 0, 0, smem, p.q_lora_norm + l * 256);
    return;
  }
  r -= 48;
  if (r < 32) {
    const int ct = r >> 1, kt = r & 1;
    convT_tile(p.w_ukv + (size_t)l * 128 * 1024, 1024, kt * 64, ct * 64, p.WukvT + (size_t)l * 1024 * 128, 128, ct * 64, 0, 0, smem, p.kv_lora_norm + l * 128);
    return;
  }
  r -= 32;
  if (r < 256) {
    const int ct = r >> 4, kt = r & 15;
    convT_tile(p.w_out + (size_t)l * 1024 * 1024, 1024, kt * 64, ct * 64, p.WoutT + (size_t)l * 1024 * 1024, 1024, ct * 64, 0, 0, smem);
    return;
  }
  r -= 256;
  if (r < 4096) {
    const int which = r >> 11, r2 = r & 2047, e = r2 >> 7, r3 = r2 & 127, ct = r3 >> 4, kt = r3 & 15;
    const float* src = (which ? p.w_up : p.w_gate) + (size_t)(l * 16 + e) * 1024 * 512;
    convT_tile(src, 512, kt * 64, ct * 64, p.WguT + (size_t)(l * 16 + e) * 1024 * 1024, 1024, 0, 1, which, smem);
    return;
  }
  r -= 4096;
  {
    const int e = r >> 7, r3 = r & 127, ct = r3 >> 3, kt = r3 & 7;
    convT_tile(p.w_down + (size_t)(l * 16 + e) * 512 * 1024, 1024, kt * 64, ct * 64, p.WdT + (size_t)(l * 16 + e) * 1024 * 512, 512, ct * 64, 0, 0, smem);
  }
}

__device__ __forceinline__ void elem_item(const Params& p, int it) {
  const int t = tid_();
  if (it < 128) {
#pragma unroll
    for (int i = 0; i < 4; ++i) { const int idx = it * 1024 + i * 256 + t; p.Wsgu[idx] = f2bf(p.w_sgu[idx]); }
    return;
  }
  it -= 128;
  if (it < 2048) {
#pragma unroll
    for (int i = 0; i < 4; ++i) {
      const int idx = it * 1024 + i * 256 + t;
      const int n1 = idx >> 14, m = (idx >> 7) & 127, kk = idx & 127;
      const int rip = m >> 6, k2 = m & 63, ri = kk >> 6, n2 = kk & 63;
      const int n = n1 + 128 * n2;
      const int ph = (k2 * n) & 8191;
      const float xx = (float)ph / 4096.f;
      const float cs = cospif(xx), sn = sinpif(xx);
      const float v = rip == 0 ? (ri == 0 ? cs : sn) : (ri == 0 ? -sn : cs);
      p.M1[idx] = f2bf(v);
    }
    return;
  }
  it -= 2048;
  if (it < 32) {
#pragma unroll
    for (int i = 0; i < 4; ++i) {
      const int idx = it * 1024 + i * 256 + t;
      const int k1 = idx >> 8, kk = idx & 255, ri = kk >> 7, n1 = kk & 127;
      const int ph = (k1 * n1) & 127;
      const float xx = (float)ph / 64.f;
      p.M2[idx] = f2bf(ri ? sinpif(xx) : cospif(xx));
    }
    return;
  }
  it -= 32;
  {
#pragma unroll
    for (int i = 0; i < 4; ++i) {
      const int idx = it * 1024 + i * 256 + t;
      const int k = idx >> 9, kk = idx & 511, ri = kk >> 8, n = kk & 255;
      const int ph = (k * n) & 255;
      const float xx = (float)ph / 128.f;
      p.Mc[idx] = f2bf(ri ? sinpif(xx) : cospif(xx));
    }
  }
}

__device__ __forceinline__ void phase_prep(const Params& p, unsigned char* smem) {
  const int G = gridDim.x;
  int t = bid_();
  for (; t < 192; t += G) ada_item(p, t, smem);
  t -= 192;
  for (; t < 128; t += G) fold_item(p, t, smem);
  t -= 128;
  for (; t < 13440; t += G) conv_item(p, t, smem);
  t -= 13440;
  for (; t < 2336; t += G) elem_item(p, t);
}

__device__ __forceinline__ int row_cond(int row) { return row < T_LAT ? (row >> 13) : 2; }
__device__ __forceinline__ int row_batch(int row) { return row < T_LAT ? (row >> 13) : ((row - T_LAT) >> 8); }
__device__ __forceinline__ int row_pos(int row) { return row < T_LAT ? (CTX + (row & (SEQ - 1))) : ((row - T_LAT) & (CTX - 1)); }

template <int R>
__device__ __forceinline__ void phase_modulate(const Params& p, int l, const float* xlat, const float* xctx, int nrows, int chunk, int bskip) {
  const int t = tid_(), lane = t & 63, wid = t >> 6;
  const int bb = bid_() - bskip;
  if (bb < 0) return;
  const int gw = bb * 4 + wid, nw = ((int)gridDim.x - bskip) * 4;
  for (int row0 = gw * R; row0 < nrows; row0 += nw * R) {
    const float* xr = row0 < T_LAT ? xlat + (size_t)row0 * DM : xctx + (size_t)(row0 - T_LAT) * DM;
    const float* sh = p.mada + (size_t)(l * 3 + row_cond(row0)) * 6144 + chunk * 1024;
    const float* sc = sh + 1024;
    float4 v[R][4];
#pragma unroll
    for (int r = 0; r < R; ++r)
#pragma unroll
      for (int i = 0; i < 4; ++i) v[r][i] = *(const float4*)(xr + (size_t)r * DM + i * 256 + lane * 4);
    float rstd[R];
#pragma unroll
    for (int r = 0; r < R; ++r) {
      float ss = 0.f;
#pragma unroll
      for (int i = 0; i < 4; ++i) ss += v[r][i].x * v[r][i].x + v[r][i].y * v[r][i].y + v[r][i].z * v[r][i].z + v[r][i].w * v[r][i].w;
      ss = wave_sum(ss);
      rstd[r] = rsqrtf(ss * (1.f / 1024.f) + 1e-6f);
    }
#pragma unroll
    for (int i = 0; i < 4; ++i) {
      const int col = i * 256 + lane * 4;
      const float4 s4 = *(const float4*)(sc + col);
      const float4 h4 = *(const float4*)(sh + col);
#pragma unroll
      for (int r = 0; r < R; ++r) {
        u32x2 pk;
        pk.x = pack2(v[r][i].x * rstd[r] * (1.f + s4.x) + h4.x, v[r][i].y * rstd[r] * (1.f + s4.y) + h4.y);
        pk.y = pack2(v[r][i].z * rstd[r] * (1.f + s4.z) + h4.z, v[r][i].w * rstd[r] * (1.f + s4.w) + h4.w);
        *(u32x2*)(p.H + (size_t)(row0 + r) * DM + col) = pk;
      }
    }
  }
}

__device__ __forceinline__ void phase_router_prep(const Params& p) {
  const int t = tid_(), lane = t & 63, wid = t >> 6;
  for (int i = bid_() * 256 + t; i < 2 * 3 * 16384; i += gridDim.x * 256) {
    const int lc = i >> 14, k = (i >> 4) & 1023, e = i & 15, l = lc / 3;
    p.WR2[i] = (1.f + p.mada[(size_t)lc * 6144 + 4 * 1024 + k]) * p.w_router[(size_t)l * 16384 + k * 16 + e];
  }
  for (int o = bid_() * 4 + wid; o < 96; o += gridDim.x * 4) {
    const int lc = o >> 4, e = o & 15, l = lc / 3;
    float s = 0.f;
    for (int k = lane; k < 1024; k += 64) s += p.mada[(size_t)lc * 6144 + 3 * 1024 + k] * p.w_router[(size_t)l * 16384 + k * 16 + e];
    s = wave_sum(s);
    if (lane == 0) p.CE[o] = s;
  }
}

__device__ __forceinline__ void phase_router(const Params& p, int l, const float* xlat, const float* xctx, int nrows) {
  const int t = tid_(), lane = t & 63, wid = t >> 6, l16 = lane & 15, quad = lane >> 4;
  const int gw = bid_() * 4 + wid, nw = gridDim.x * 4;
  const int ntile = nrows >> 4;
  for (int tile = gw; tile < ntile; tile += nw) {
    const int row0 = tile * 16;
    const int cond = row_cond(row0);
    const float* xr = (row0 < T_LAT ? xlat + (size_t)(row0 + l16) * DM : xctx + (size_t)(row0 - T_LAT + l16) * DM) + quad * 4;
    const float* wp = p.WR2 + (size_t)(l * 3 + cond) * 16384 + quad * 64 + l16;
    f32x4 acc = (f32x4){0.f, 0.f, 0.f, 0.f};
    float ss = 0.f;
#pragma unroll 4
    for (int s = 0; s < 64; ++s) {
      const float4 a = *(const float4*)(xr + s * 16);
      const float b0 = wp[s * 256], b1 = wp[s * 256 + 16], b2 = wp[s * 256 + 32], b3 = wp[s * 256 + 48];
      ss += a.x * a.x + a.y * a.y + a.z * a.z + a.w * a.w;
      acc = __builtin_amdgcn_mfma_f32_16x16x4f32(a.x, b0, acc, 0, 0, 0);
      acc = __builtin_amdgcn_mfma_f32_16x16x4f32(a.y, b1, acc, 0, 0, 0);
      acc = __builtin_amdgcn_mfma_f32_16x16x4f32(a.z, b2, acc, 0, 0, 0);
      acc = __builtin_amdgcn_mfma_f32_16x16x4f32(a.w, b3, acc, 0, 0, 0);
    }
    ss += __shfl_xor(ss, 16);
    ss += __shfl_xor(ss, 32);
    const float rstd = rsqrtf(ss * (1.f / 1024.f) + 1e-6f);
    const float ce = p.CE[(l * 3 + cond) * 16 + l16];
#pragma unroll
    for (int j = 0; j < 4; ++j) {
      const int tk = quad * 4 + j;
      const float r = __shfl(rstd, tk);
      const float lg = acc[j] * r + ce;
      float mx = lg;
#pragma unroll
      for (int o = 8; o; o >>= 1) mx = fmaxf(mx, __shfl_xor(mx, o));
      const float ex = __expf(lg - mx);
      float sm = ex;
#pragma unroll
      for (int o = 8; o; o >>= 1) sm += __shfl_xor(sm, o);
      const float aff = ex / sm;
      const int row = row0 + tk;
      if (row < T_LAT) p.AFFT[(size_t)((row >> 13) * 16 + l16) * SEQ + (row & (SEQ - 1))] = aff;
      else { const int rc = row - T_LAT; p.AFFT[(size_t)32 * SEQ + ((rc >> 8) * 16 + l16) * CTX + (rc & 255)] = aff; }
    }
  }
}

__device__ __forceinline__ void phase_in_gemm(const Params& p, int l, unsigned char* smem) {
  const u16* W = p.WinT + (size_t)l * 1536 * 1024;
  XCD_FOR(t, 132 * 11) {
    const int mt = t / 11, nt = t % 11;
    const int row_base = mt * 128;
    auto epi = [&](f32x4(&acc)[4][4], int r0, int c0) {
      const bool act = nt < 4;
      auto vf = [&](int, int, float v) { return act ? gelu_tanh(v) : v; };
      auto rp = [&](int r) -> u16* {
        const int row = row_base + r;
        if (nt < 4) return p.PX + (size_t)row * 1024 + nt * 128;
        if (nt >= 8) return p.PX + (size_t)row * 1024 + 512 + (nt - 8) * 128;
        const int ri = (nt - 4) >> 1, jx = ((nt - 4) & 1) * 128;
        if (row < T_LAT) return p.GD + ((size_t)((row >> 13) * 2 + ri) * SEQ + (row & (SEQ - 1))) * 256 + jx;
        const int rc = row - T_LAT;
        return p.GDc + ((size_t)((rc >> 8) * 2 + ri) * CTX + (rc & 255)) * 256 + jx;
      };
      epi_staged_bf16<4>(acc, r0, c0, smem, vf, rp);
    };
    gemm_tile<4, false>(p.H + (size_t)row_base * 1024, 1024, nullptr, 128, W + (size_t)nt * 128 * 1024, 1024, 1024, smem, epi);
  }
  XCD_FOR(t, 132) {
    const int row_base = t * 128;
    auto epi = [&](f32x4(&acc)[4][2], int r0, int c0) {
      auto vf = [&](int, int, float v) { return v; };
      auto rp = [&](int r) -> u16* { return p.PX + (size_t)(row_base + r) * 1024 + 896; };
      epi_staged_bf16<2>(acc, r0, c0, smem, vf, rp);
    };
    gemm_tile<2, false>(p.H + (size_t)row_base * 1024, 1024, nullptr, 128, W + (size_t)11 * 128 * 1024, 1024, 1024, smem, epi);
  }
}

__device__ __forceinline__ void phase_rownorm(const Params& p, int l) {
  constexpr int R = 4;
  const int t = tid_(), lane = t & 63, wid = t >> 6;
  const int gw = bid_() * 4 + wid, nw = gridDim.x * 4;
  const float* nv = p.sgu_norm + l * 256 + lane * 4;
  const float* nq = p.q_lora_norm + l * 256 + lane * 4;
  const float* nk = p.kv_lora_norm + l * 128 + lane * 2;
  for (int row0 = gw * R; row0 < TT; row0 += nw * R) {
    u16* px = p.PX + (size_t)row0 * 1024;
    u32x2 rv[R], rq[R];
    unsigned rk[R];
#pragma unroll
    for (int r = 0; r < R; ++r) {
      rv[r] = *(const u32x2*)(px + r * 1024 + 256 + lane * 4);
      rq[r] = *(const u32x2*)(px + r * 1024 + 512 + lane * 4);
      rk[r] = *(const unsigned*)(px + r * 1024 + 768 + lane * 2);
    }
#pragma unroll
    for (int r = 0; r < R; ++r) {
      {
        const float a = bf2f((u16)(rv[r].x & 0xffff)), b = bf2f((u16)(rv[r].x >> 16)), c = bf2f((u16)(rv[r].y & 0xffff)), d = bf2f((u16)(rv[r].y >> 16));
        const float rstd = rsqrtf(wave_sum(a * a + b * b + c * c + d * d) * (1.f / 256.f) + 1e-6f);
        u32x2 o;
        o.x = pack2(a * rstd * nv[0], b * rstd * nv[1]);
        o.y = pack2(c * rstd * nv[2], d * rstd * nv[3]);
        *(u32x2*)(px + r * 1024 + 256 + lane * 4) = o;
      }
      {
        const float a = bf2f((u16)(rq[r].x & 0xffff)), b = bf2f((u16)(rq[r].x >> 16)), c = bf2f((u16)(rq[r].y & 0xffff)), d = bf2f((u16)(rq[r].y >> 16));
        const float rstd = rsqrtf(wave_sum(a * a + b * b + c * c + d * d) * (1.f / 256.f) + 1e-6f);
        u32x2 o;
        o.x = pack2(a * rstd * nq[0], b * rstd * nq[1]);
        o.y = pack2(c * rstd * nq[2], d * rstd * nq[3]);
        *(u32x2*)(px + r * 1024 + 512 + lane * 4) = o;
      }
      {
        const float a = bf2f((u16)(rk[r] & 0xffff)), b = bf2f((u16)(rk[r] >> 16));
        const float rstd = rsqrtf(wave_sum(a * a + b * b) * (1.f / 128.f) + 1e-6f);
        *(unsigned*)(px + r * 1024 + 768 + lane * 2) = pack2(a * rstd * nk[0], b * rstd * nk[1]);
      }
    }
  }
}

__device__ __forceinline__ void phase_mix_a(const Params& p, int l, bool last, unsigned char* smem) {
  {
    const u16* W = p.WuqT + (size_t)l * 768 * 256;
    XCD_FOR(t, 132 * 6) {
      const int mt = t / 6, nt = t % 6, row_base = mt * 128;
      auto epi = [&](f32x4(&acc)[4][4], int r0, int c0) {
        const float* rs = (const float*)(smem + 65536);
        auto vf = [&](int r, int, float v) { return v * rs[r]; };
        auto rp = [&](int r) -> u16* { return p.QR + (size_t)(row_base + r) * 768 + nt * 128; };
        epi_staged_bf16<4>(acc, r0, c0, smem, vf, rp);
      };
      gemm_tile<4, false, false, true>(p.PX + (size_t)row_base * 1024 + 512, 1024, nullptr, 128, W + (size_t)nt * 128 * 256, 256, 256, smem, epi);
    }
  }
  {
    const u16* W = p.WukvT + (size_t)l * 1024 * 128;
    XCD_FOR(t, 132 * 8) {
      const int mt = t >> 3, nt = t & 7, row_base = mt * 128, h = nt >> 1;
      const int b = row_batch(row_base), pos_base = row_pos(row_base);
      auto epi = [&](f32x4(&acc)[4][4], int r0, int c0) {
#pragma unroll
        for (int mi = 0; mi < 4; ++mi)
#pragma unroll
          for (int ni = 0; ni < 4; ++ni) {
            const int col = c0 + ni * 16;
            if ((nt & 1) == 0) {
            } else {
              u32x2 pk;
              pk.x = pack2(acc[mi][ni][0], acc[mi][ni][1]);
              pk.y = pack2(acc[mi][ni][2], acc[mi][ni][3]);
              *(u32x2*)(p.Vt + ((size_t)(b * 4 + h) * 128 + col) * NPOS + pos_base + r0 + mi * 16) = pk;
            }
          }
      };
      auto epi2 = [&](f32x4(&acc)[4][4], int r0, int c0) {
        const float* rs = (const float*)(smem + 65536);
        if ((nt & 1) == 0) {
          auto vf = [&](int r, int, float v) { return v * rs[r]; };
          auto rp = [&](int r) -> u16* { return p.KN + (size_t)(row_base + r) * 512 + h * 128; };
          epi_staged_bf16<4>(acc, r0, c0, smem, vf, rp);
        } else {
#pragma unroll
          for (int mi = 0; mi < 4; ++mi)
#pragma unroll
            for (int j = 0; j < 4; ++j) {
              const float sc = rs[r0 + mi * 16 + j];
#pragma unroll
              for (int ni = 0; ni < 4; ++ni) acc[mi][ni][j] *= sc;
            }
          auto cp = [&](int c) -> u16* { return p.Vt + ((size_t)(b * 4 + h) * 128 + c) * NPOS + pos_base; };
          epi_staged_bf16_T(acc, r0, c0, smem, cp);
        }
      };
      gemm_tile<4, false, false, true>(p.PX + (size_t)row_base * 1024 + 768, 1024, nullptr, 128, W + (size_t)nt * 128 * 128, 128, 128, smem, epi2);
    }
  }
  {
    const int nch = last ? 128 : 132;
    XCD_FOR(t, nch * 4) {
      const int ch = t >> 2, h = t & 3, row_base = ch * 128;
      const float* bs = p.b_sgu + (l * 4 + h) * 128;
      const float* sgn = p.sgu_norm + l * 256 + h * 64;
      float* rsv = (float*)(smem + 65536 + 512);
      {
        const int t3 = tid_(), q = t3 >> 1, half = t3 & 1;
        const u16* vp = p.PX + (size_t)(row_base + q) * 1024 + 256 + half * 128;
        float s = 0.f;
#pragma unroll
        for (int i = 0; i < 16; ++i) {
          const u32x4 w = *(const u32x4*)(vp + i * 8);
          const float a0 = __uint_as_float(w.x << 16), a1 = __uint_as_float(w.x & 0xffff0000u), a2 = __uint_as_float(w.y << 16), a3 = __uint_as_float(w.y & 0xffff0000u);
          const float a4 = __uint_as_float(w.z << 16), a5 = __uint_as_float(w.z & 0xffff0000u), a6 = __uint_as_float(w.w << 16), a7 = __uint_as_float(w.w & 0xffff0000u);
          s += (a0 * a0 + a1 * a1) + (a2 * a2 + a3 * a3) + (a4 * a4 + a5 * a5) + (a6 * a6 + a7 * a7);
        }
        s += __shfl_xor(s, 1);
        __syncthreads();
        if (half == 0) rsv[q] = rsqrtf(s * (1.f / 256.f) + 1e-6f);
      }
      auto epi = [&](f32x4(&acc)[4][2], int r0, int c0) {
        float* Ts = (float*)smem;
        const int t2 = tid_();
        __syncthreads();
#pragma unroll
        for (int mi = 0; mi < 4; ++mi)
#pragma unroll
          for (int ni = 0; ni < 2; ++ni)
#pragma unroll
            for (int j = 0; j < 4; ++j) {
              const int pr = r0 + mi * 16 + j;
              Ts[pr * 68 + c0 + ni * 16] = acc[mi][ni][j] * sgn[c0 + ni * 16] + bs[pr];
            }
        __syncthreads();
#pragma unroll
        for (int i = 0; i < 4; ++i) {
          const int c = t2 + 256 * i, pr = c >> 3, ch = c & 7;
          const size_t o = (size_t)(row_base + pr) * 1024 + h * 64 + ch * 8;
          const u32x4 u = *(const u32x4*)(p.PX + o);
          const float4 z0 = *(const float4*)(Ts + pr * 68 + ch * 8), z1 = *(const float4*)(Ts + pr * 68 + ch * 8 + 4);
          u32x4 r;
          r.x = pack2(bf2f((u16)(u.x & 0xffffu)) * z0.x, bf2f((u16)(u.x >> 16)) * z0.y);
          r.y = pack2(bf2f((u16)(u.y & 0xffffu)) * z0.z, bf2f((u16)(u.y >> 16)) * z0.w);
          r.z = pack2(bf2f((u16)(u.z & 0xffffu)) * z1.x, bf2f((u16)(u.z >> 16)) * z1.y);
          r.w = pack2(bf2f((u16)(u.w & 0xffffu)) * z1.z, bf2f((u16)(u.w >> 16)) * z1.w);
          *(u32x4*)(p.YM + o) = r;
        }
      };
      gemm_tile<2, true>(p.Wsgu + (size_t)(l * 4 + h) * 16384, 128, nullptr, 128, p.PX + (size_t)row_base * 1024 + 256 + h * 64, 1024, 128, smem, epi, rsv);
    }
  }
  {
    XCD_FOR(t, 512) {
      const int nh = t & 1, n1 = (t >> 1) & 127, b = t >> 8;
      auto epi = [&](f32x4(&acc)[4][4], int r0, int c0) {
        auto vf = [&](int, int, float v) { return v; };
        auto rp = [&](int m) -> u16* { const int rip = m >> 6, k2 = m & 63; return p.PF + ((size_t)((b * 64 + k2) * 2 + rip) * 128 + n1) * 256 + nh * 128; };
        epi_staged_bf16<4>(acc, r0, c0, smem, vf, rp);
      };
      gemm_tile<4, true>(p.M1 + (size_t)n1 * 16384, 128, nullptr, 128, p.GD + (size_t)b * 2 * SEQ * 256 + (size_t)n1 * 256 + nh * 128, 128 * 256, 128, smem, epi);
    }
  }
  if (!last) {
    for (int t = bid_(); t < 8; t += gridDim.x) {
      const int nh = t & 1, mt = (t >> 1) & 1, b = t >> 2;
      auto epi = [&](f32x4(&acc)[4][4], int r0, int c0) {
#pragma unroll
        for (int mi = 0; mi < 4; ++mi)
#pragma unroll
          for (int ni = 0; ni < 4; ++ni)
#pragma unroll
            for (int j = 0; j < 4; ++j) {
              const int k = mt * 128 + r0 + mi * 16 + j;
              p.YM[(size_t)(T_LAT + b * CTX + k) * 1024 + 256 + nh * 128 + c0 + ni * 16] = f2bf(acc[mi][ni][j] * (1.f / 128.f));
            }
      };
      gemm_tile<4, true>(p.Mc + (size_t)mt * 128 * 512, 512, nullptr, 128, p.GDc + (size_t)b * 2 * CTX * 256 + nh * 128, 256, 512, smem, epi);
    }
  }
}

__device__ __forceinline__ void phase_mix_b(const Params& p, int l, bool last, unsigned char* smem) {
  XCD_FOR(t, 512) {
    const int nq = t & 3, k2 = (t >> 2) & 63, b = t >> 8;
    auto epi = [&](f32x4(&acc)[4][2], int r0, int c0) {
      auto vf = [&](int, int, float v) { return v * 0.001381067932004976f; };
      auto rp = [&](int k1) -> u16* { return p.YM + (size_t)(b * SEQ + 64 * k1 + k2) * 1024 + 256 + nq * 64; };
      epi_staged_bf16<2>(acc, r0, c0, smem, vf, rp);
    };
    gemm_tile<2, true>(p.M2, 256, nullptr, 128, p.PF + (size_t)(b * 64 + k2) * 2 * 128 * 256 + nq * 64, 256, 256, smem, epi);
  }
  const int tt = tid_(), lane = tt & 63, wid = tt >> 6;
  const int gw = bid_() * 4 + wid, nw = gridDim.x * 4;
  const float QSCALE = 0.07216878364870322f * 1.4426950408889634f;
  for (int row = gw; row < TT; row += nw) {
    const bool lat = row < T_LAT;
    const int b = row_batch(row), pos = row_pos(row);
    float cs = 1.f, sn = 0.f;
    if (lat) {
      const int n = row & (SEQ - 1);
      const int r = lane, sub = r & 31, i = sub & 15;
      const float ps = (r < 32) ? (float)(n >> 6) : (float)(n & 63);
      const float fr = __builtin_amdgcn_exp2f(-(float)i * 0.83048202372184058696f);
      const float ang = ps * fr;
      sn = __sinf(ang);
      cs = __cosf(ang);
    }
    const bool hi = ((lane & 31) >= 16);
    if (lat || !last) {
#pragma unroll
      for (int h = 0; h < 4; ++h) {
        const u16* q = p.QR + (size_t)row * 768 + h * 192;
        float v0 = bf2f(q[lane]), v1 = bf2f(q[lane + 64]), v2 = bf2f(q[lane + 128]);
        const float ss = wave_sum(v0 * v0 + v1 * v1 + v2 * v2);
        const float rstd = rsqrtf(ss * (1.f / 192.f) + 1e-6f);
        const float* qn = p.q_norm + l * 192;
        v0 *= rstd * qn[lane]; v1 *= rstd * qn[lane + 64]; v2 *= rstd * qn[lane + 128];
        if (lat) {
          const float xp = __shfl_xor(v2, 16);
          v2 = hi ? (xp * sn + v2 * cs) : (v2 * cs - xp * sn);
        }
        u16* o = p.Qall + ((size_t)(b * 4 + h) * NPOS + pos) * 192;
        o[lane] = f2bf(v0 * QSCALE); o[lane + 64] = f2bf(v1 * QSCALE); o[lane + 128] = f2bf(v2 * QSCALE);
      }
    }
    {
      const float kr = bf2f(p.PX[(size_t)row * 1024 + 896 + lane]);
#pragma unroll
      for (int h = 0; h < 4; ++h) {
        const u16* kk = p.KN + (size_t)row * 512 + h * 128;
        float v0 = bf2f(kk[lane]), v1 = bf2f(kk[lane + 64]), v2 = kr;
        const float ss = wave_sum(v0 * v0 + v1 * v1 + v2 * v2);
        const float rstd = rsqrtf(ss * (1.f / 192.f) + 1e-6f);
        const float* kn = p.k_norm + l * 192;
        v0 *= rstd * kn[lane]; v1 *= rstd * kn[lane + 64]; v2 *= rstd * kn[lane + 128];
        if (lat) {
          const float xp = __shfl_xor(v2, 16);
          v2 = hi ? (xp * sn + v2 * cs) : (v2 * cs - xp * sn);
        }
        u16* o = p.Kb + ((size_t)(b * 4 + h) * NPOS + pos) * 192;
        o[lane] = f2bf(v0); o[lane + 64] = f2bf(v1); o[lane + 128] = f2bf(v2);
      }
    }
  }
}

__device__ __forceinline__ void attn_item(const Params& p, int b, int h, int qt, float shift, unsigned char* smem) {
  constexpr int STAGE = 32 * 208 + 128 * 40;
  u16* sbase = (u16*)smem;
  const int t = tid_(), lane = t & 63, wid = t >> 6, l16 = lane & 15, quad = lane >> 4;
  const int nkeys = (qt < 2) ? CTX : NPOS;
  const int ntile = nkeys >> 5;
  const u16* Qp = p.Qall + ((size_t)(b * 4 + h) * NPOS + qt * 128 + wid * 32) * 192;
  const u16* kp = p.Kb + (size_t)(b * 4 + h) * NPOS * 192 + t * 8;
  const u16* vp = p.Vt + (size_t)(b * 4 + h) * 128 * NPOS + (size_t)(t >> 2) * NPOS + (t & 3) * 8;
  const u16* qlane = Qp + (size_t)l16 * 192 + quad * 8;
  bf16x8 bq[2][6];
#pragma unroll
  for (int qi = 0; qi < 2; ++qi)
#pragma unroll
    for (int ks = 0; ks < 6; ++ks) bq[qi][ks] = *(const bf16x8*)(qlane + qi * 16 * 192 + ks * 32);
  f32x4 o[8][2];
#pragma unroll
  for (int vt = 0; vt < 8; ++vt)
#pragma unroll
    for (int qi = 0; qi < 2; ++qi) o[vt][qi] = (f32x4){0.f, 0.f, 0.f, 0.f};
  float lrun0 = 0.f, lrun1 = 0.f;
  u32x4 rk[3], rv[2];
  f32x4 sA[2][2], sB[2][2];
#define ATT_LOAD(kt_)                                                                                   \
  {                                                                                                     \
    _Pragma("unroll") for (int i = 0; i < 3; ++i) rk[i] = *(const u32x4*)(kp + (size_t)(kt_) * 6144 + i * 2048); \
    _Pragma("unroll") for (int i = 0; i < 2; ++i) rv[i] = *(const u32x4*)(vp + (size_t)(64 * i) * NPOS + (kt_) * 32); \
  }
#define ATT_STORE(st_)                                                                                  \
  {                                                                                                     \
    u16* kd = sbase + (st_) * STAGE;                                                                    \
    _Pragma("unroll") for (int i = 0; i < 3; ++i) {                                                     \
      const int c = t + 256 * i;                                                                        \
      *(u32x4*)(kd + (c / 24) * 208 + (c % 24) * 8) = rk[i];                                            \
    }                                                                                                   \
    _Pragma("unroll") for (int i = 0; i < 2; ++i) *(u32x4*)(kd + 6656 + ((t >> 2) + 64 * i) * 40 + (t & 3) * 8) = rv[i]; \
  }
#define ATT_S(SX, kst_)                                                                                 \
  {                                                                                                     \
    const u16* Ks = sbase + (kst_) * STAGE;                                                             \
    _Pragma("unroll") for (int a = 0; a < 2; ++a)                                                       \
      _Pragma("unroll") for (int qi = 0; qi < 2; ++qi) SX[a][qi] = (f32x4){0.f, 0.f, 0.f, 0.f};         \
    _Pragma("unroll") for (int ks = 0; ks < 6; ++ks) {                                                  \
      _Pragma("unroll") for (int a = 0; a < 2; ++a) {                                                   \
        const bf16x8 kf = *(const bf16x8*)(Ks + (a * 16 + l16) * 208 + ks * 32 + quad * 8);             \
        _Pragma("unroll") for (int qi = 0; qi < 2; ++qi) SX[a][qi] = __builtin_amdgcn_mfma_f32_16x16x32_bf16(kf, bq[qi][ks], SX[a][qi], 0, 0, 0); \
      }                                                                                                 \
    }                                                                                                   \
  }
#define ATT_VLOAD(vst_, hv_)                                                                            \
  {                                                                                                     \
    const u16* Vs = sbase + (vst_) * STAGE + 6656;                                                      \
    _Pragma("unroll") for (int vt = 0; vt < 4; ++vt) {                                                  \
      const u16* vb = Vs + (((hv_) * 4 + vt) * 16 + l16) * 40 + quad * 4;                               \
      const u32x2 va = *(const u32x2*)(vb);                                                             \
      const u32x2 vc = *(const u32x2*)(vb + 16);                                                        \
      const u32x4 vw = {va.x, va.y, vc.x, vc.y};                                                        \
      vfr[vt] = (bf16x8)vw;                                                                             \
    }                                                                                                   \
  }
#define ATT_FINISH(SX, vst_)                                                                            \
  {                                                                                                     \
    bf16x8 pb[2];                                                                                       \
    _Pragma("unroll") for (int qi = 0; qi < 2; ++qi) {                                                  \
      float psum = 0.f;                                                                                 \
      _Pragma("unroll") for (int a = 0; a < 2; ++a)                                                     \
        _Pragma("unroll") for (int j = 0; j < 4; ++j) {                                                 \
          const float pe = __builtin_amdgcn_exp2f(SX[a][qi][j]);                                        \
          SX[a][qi][j] = pe;                                                                            \
          psum += pe;                                                                                   \
        }                                                                                               \
      if (qi) lrun1 += psum; else lrun0 += psum;                                                        \
      u32x4 pk;                                                                                         \
      pk.x = pack2(SX[0][qi][0], SX[0][qi][1]);                                                         \
      pk.y = pack2(SX[0][qi][2], SX[0][qi][3]);                                                         \
      pk.z = pack2(SX[1][qi][0], SX[1][qi][1]);                                                         \
      pk.w = pack2(SX[1][qi][2], SX[1][qi][3]);                                                         \
      pb[qi] = (bf16x8)pk;                                                                              \
    }                                                                                                   \
    _Pragma("unroll") for (int vt = 0; vt < 4; ++vt)                                                    \
      _Pragma("unroll") for (int qi = 0; qi < 2; ++qi) o[vt][qi] = __builtin_amdgcn_mfma_f32_16x16x32_bf16(vfr[vt], pb[qi], o[vt][qi], 0, 0, 0); \
    ATT_VLOAD(vst_, 1);                                                                                 \
    _Pragma("unroll") for (int vt = 0; vt < 4; ++vt)                                                    \
      _Pragma("unroll") for (int qi = 0; qi < 2; ++qi) o[4 + vt][qi] = __builtin_amdgcn_mfma_f32_16x16x32_bf16(vfr[vt], pb[qi], o[4 + vt][qi], 0, 0, 0); \
  }
#define ATT_SHIFT(SX)                                                                                   \
  if (shift > 0.f) {                                                                                    \
    _Pragma("unroll") for (int a = 0; a < 2; ++a)                                                       \
      _Pragma("unroll") for (int qi = 0; qi < 2; ++qi) {                                                \
        SX[a][qi][0] -= shift; SX[a][qi][1] -= shift; SX[a][qi][2] -= shift; SX[a][qi][3] -= shift;     \
      }                                                                                                 \
  }
#define ATT_STEP(SNEW, SOLD, tt_)                                                                       \
  {                                                                                                     \
    const int tn_ = ((tt_) + 1 < ntile) ? (tt_) + 1 : ntile - 1;                                        \
    ATT_LOAD(tn_);                                                                                      \
    bf16x8 vfr[4];                                                                                      \
    ATT_VLOAD(((tt_) - 1) % 3, 0);                                                                      \
    ATT_SHIFT(SOLD);                                                                                    \
    __builtin_amdgcn_s_setprio(1);                                                                      \
    ATT_S(SNEW, (tt_) % 3);                                                                             \
    ATT_FINISH(SOLD, ((tt_) - 1) % 3);                                                                  \
    __builtin_amdgcn_s_setprio(0);                                                                      \
    ATT_STORE(((tt_) + 1) % 3);                                                                         \
    __syncthreads();                                                                                    \
  }
  __syncthreads();
  ATT_LOAD(0);
  ATT_STORE(0);
  ATT_LOAD(1);
  __syncthreads();
  ATT_S(sA, 0);
  ATT_STORE(1);
  __syncthreads();
#pragma unroll 1
  for (int tt = 1; tt < ntile - 1; tt += 2) {
    ATT_STEP(sB, sA, tt);
    ATT_STEP(sA, sB, tt + 1);
  }
  ATT_STEP(sB, sA, ntile - 1);
  {
    bf16x8 vfr[4];
    ATT_VLOAD((ntile - 1) % 3, 0);
    ATT_SHIFT(sB);
    ATT_FINISH(sB, (ntile - 1) % 3);
  }
  __syncthreads();
#undef ATT_LOAD
#undef ATT_STORE
#undef ATT_S
#undef ATT_VLOAD
#undef ATT_FINISH
#undef ATT_STEP
#undef ATT_SHIFT
#pragma unroll
  for (int qi = 0; qi < 2; ++qi) {
    float ls = qi ? lrun1 : lrun0;
    ls += __shfl_xor(ls, 16);
    ls += __shfl_xor(ls, 32);
    const float inv = 1.f / ls;
    const int pos = qt * 128 + wid * 32 + qi * 16 + l16;
    const int row = (pos < CTX) ? (T_LAT + b * CTX + pos) : (b * SEQ + pos - CTX);
    u16* orow = p.YM + (size_t)row * 1024 + 512 + h * 128 + quad * 4;
#pragma unroll
    for (int vt = 0; vt < 8; ++vt) {
      u32x2 pk;
      pk.x = pack2(o[vt][qi][0] * inv, o[vt][qi][1] * inv);
      pk.y = pack2(o[vt][qi][2] * inv, o[vt][qi][3] * inv);
      *(u32x2*)(orow + vt * 16) = pk;
    }
  }
}

__device__ __forceinline__ void phase_attn(const Params& p, int l, bool last, unsigned char* smem) {
  float shift;
  {
    const int lane = tid_() & 63;
    float mq = 0.f, mk = 0.f;
#pragma unroll
    for (int i = 0; i < 3; ++i) { mq = fmaxf(mq, fabsf(p.q_norm[l * 192 + lane + 64 * i])); mk = fmaxf(mk, fabsf(p.k_norm[l * 192 + lane + 64 * i])); }
#pragma unroll
    for (int o = 32; o; o >>= 1) { mq = fmaxf(mq, __shfl_xor(mq, o)); mk = fmaxf(mk, __shfl_xor(mk, o)); }
    const float bound = 192.f * mq * mk * (0.07216878364870322f * 1.4426950408889634f);
    shift = fmaxf(0.f, bound - 24.f);
  }
  const int x = bid_() & 7, j = bid_() >> 3, gb = gridDim.x >> 3;
  for (int q = j; q < 64; q += gb) attn_item(p, x >> 2, x & 3, 2 + q, shift, smem);
  if (!last)
    for (int q = j; q < 2; q += gb) attn_item(p, x >> 2, x & 3, q, shift, smem);
}

__device__ __forceinline__ void phase_out_gemm(const Params& p, int l, bool last, const float* slat, const float* sctx, float* dlat, float* dctx, unsigned char* smem) {
  const u16* W = p.WoutT + (size_t)l * 1024 * 1024;
  XCD_FOR(t, 128 * 8) {
    const int mt = t >> 3, nt = t & 7, row_base = mt * 128;
    const float* g1 = p.mada + (size_t)(l * 3 + (row_base >> 13)) * 6144 + 2 * 1024 + nt * 128;
    const float* xs = slat + (size_t)row_base * DM;
    float* xd = dlat + (size_t)row_base * DM;
    auto epi = [&](f32x4(&acc)[4][4], int r0, int c0) { epi_staged_residual(acc, r0, c0, smem, g1, xs + nt * 128, xd + nt * 128); };
    gemm_tile<4, false>(p.YM + (size_t)row_base * 1024, 1024, nullptr, 128, W + (size_t)nt * 128 * 1024, 1024, 1024, smem, epi);
  }
  if (!last) {
    XCD_FOR(t, 4 * 32) {
      const int mt = t >> 5, nt = t & 31, row_base = mt * 128;
      const float* g1 = p.mada + (size_t)(l * 3 + 2) * 6144 + 2 * 1024 + nt * 32;
      const float* xs = sctx + (size_t)row_base * DM;
      float* xd = dctx + (size_t)row_base * DM;
      auto epi = [&](f32x4(&acc)[4][1], int r0, int c0) {
#pragma unroll
        for (int mi = 0; mi < 4; ++mi) {
          const float g = g1[c0];
#pragma unroll
          for (int j = 0; j < 4; ++j) {
            const size_t o = (size_t)(r0 + mi * 16 + j) * DM + nt * 32 + c0;
            xd[o] = xs[o] + g * acc[mi][0][j];
          }
        }
      };
      gemm_tile<1, false>(p.YM + (size_t)(T_LAT + row_base) * 1024, 1024, nullptr, 128, W + (size_t)nt * 32 * 1024, 1024, 1024, smem, epi);
    }
  }
}

__device__ __forceinline__ unsigned block_incl_scan(unsigned x, unsigned* wsum, int lane, int wid, unsigned& total) {
  unsigned v = x;
#pragma unroll
  for (int off = 1; off < 64; off <<= 1) {
    const unsigned n = __shfl_up(v, off);
    if (lane >= off) v += n;
  }
  __syncthreads();
  if (lane == 63) wsum[wid] = v;
  __syncthreads();
  const unsigned w0 = wsum[0], w1 = wsum[1], w2 = wsum[2], w3 = wsum[3];
  total = w0 + w1 + w2 + w3;
  const unsigned base = (wid > 0 ? w0 : 0u) + (wid > 1 ? w1 : 0u) + (wid > 2 ? w2 : 0u);
  return base + v;
}

__device__ __forceinline__ void phase_topk(const Params& p, bool last, unsigned char* smem) {
  unsigned* key = (unsigned*)smem;
  unsigned* hist = key + 8192;
  unsigned* wsum = hist + 256;
  unsigned* sh = wsum + 4;
  const int t = tid_(), lane = t & 63, wid = t >> 6;
  const int ninst = last ? 32 : 64;
  for (int inst = bid_(); inst < ninst; inst += gridDim.x) {
    const bool lat = inst < 32;
    const int n = lat ? SEQ : CTX, cap = lat ? 1024 : 32;
    const float* src = lat ? p.AFFT + (size_t)inst * SEQ : p.AFFT + (size_t)32 * SEQ + (inst - 32) * CTX;
    const int rowbase = lat ? (inst >> 4) * SEQ : T_LAT + ((inst - 32) >> 4) * CTX;
    for (int i = t; i < n; i += 256) key[i] = __float_as_uint(src[i]);
    unsigned prefix = 0u, mask = 0u, remaining = (unsigned)cap;
    for (int shift = 24; shift >= 0; shift -= 8) {
      hist[t] = 0u;
      __syncthreads();
      for (int i = t; i < n; i += 256) {
        const unsigned k = key[i];
        if ((k & mask) == prefix) atomicAdd(&hist[(k >> shift) & 255u], 1u);
      }
      __syncthreads();
      const unsigned hc = hist[t];
      unsigned total;
      const unsigned incl = block_incl_scan(hc, wsum, lane, wid, total);
      const unsigned suf = total - incl + hc;
      const unsigned sufn = total - incl;
      if (suf >= remaining && sufn < remaining) { sh[0] = prefix | ((unsigned)t << shift); sh[1] = remaining - sufn; }
      __syncthreads();
      prefix = sh[0];
      remaining = sh[1];
      mask |= (255u << shift);
      __syncthreads();
    }
    const int per = n >> 8;
    unsigned cgt = 0u, ceq = 0u;
    for (int i = 0; i < per; ++i) {
      const unsigned k = key[t * per + i];
      cgt += (k > prefix) ? 1u : 0u;
      ceq += (k == prefix) ? 1u : 0u;
    }
    unsigned ngt, neq;
    unsigned og = block_incl_scan(cgt, wsum, lane, wid, ngt) - cgt;
    unsigned oe = block_incl_scan(ceq, wsum, lane, wid, neq) - ceq;
    int* idx = p.IDXG + (size_t)inst * 1024;
    float* gt = p.GATE + (size_t)inst * 1024;
    int* inv = p.INV + (size_t)rowbase * 16 + (inst & 15);
    for (int i = 0; i < per; ++i) {
      const int e = t * per + i;
      const unsigned k = key[e];
      int slot = -1;
      if (k > prefix) {
        slot = (int)og; ++og;
      } else if (k == prefix) {
        if (oe < remaining) slot = (int)(ngt + oe);
        ++oe;
      }
      if (slot >= 0) { idx[slot] = rowbase + e; gt[slot] = __uint_as_float(k); }
      inv[(size_t)e * 16] = slot;
    }
    __syncthreads();
  }
}

__device__ __forceinline__ void phase_moe_up(const Params& p, int l, bool last, unsigned char* smem) {
  const int npass = last ? 1 : 2;
  for (int pass = 0; pass < npass; ++pass)
  XCD_FOR(t, ((pass == npass - 1) ? 2048 : 256)) {
    int inst, mt, nt, mvalid, hid_row;
    if (pass == npass - 1) { const int e_ = t >> 7, b_ = (t >> 6) & 1; inst = b_ * 16 + e_; mt = (t >> 3) & 7; nt = t & 7; mvalid = 128; hid_row = inst * 1024 + mt * 128; }
    else { const int e_ = t >> 4, b_ = (t >> 3) & 1; inst = 32 + b_ * 16 + e_; mt = 0; nt = t & 7; mvalid = 32; hid_row = 32768 + (inst - 32) * 128; }
    const int e = inst & 15;
    const u16* W = p.WguT + (size_t)(l * 16 + e) * 1024 * 1024 + (size_t)nt * 128 * 1024;
    auto epi = [&](f32x4(&acc)[4][4], int r0, int c0) {
      u16* Ts = (u16*)smem;
      const int t2 = tid_();
      __syncthreads();
#pragma unroll
      for (int mi = 0; mi < 4; ++mi)
#pragma unroll
        for (int n2 = 0; n2 < 2; ++n2)
#pragma unroll
          for (int j = 0; j < 4; ++j) {
            const int m = r0 + mi * 16 + j;
            const int fl = (c0 >> 6) * 32 + n2 * 16 + (c0 & 15);
            Ts[m * 72 + fl] = f2bf(silu_f(acc[mi][2 * n2][j]) * acc[mi][2 * n2 + 1][j]);
          }
      __syncthreads();
#pragma unroll
      for (int i = 0; i < 4; ++i) {
        const int c = t2 + 256 * i, row = c >> 3, ch = c & 7;
        if (row < mvalid) *(u32x4*)(p.HID + (size_t)(hid_row + row) * 512 + nt * 64 + ch * 8) = *(const u32x4*)(Ts + row * 72 + ch * 8);
      }
    };
    if (mvalid == 128) gemm_tile<4, false, false>(p.H, 1024, p.IDXG + (size_t)inst * 1024 + mt * 128, 128, W, 1024, 1024, smem, epi);
    else gemm_tile<4, false, true>(p.H, 1024, p.IDXG + (size_t)inst * 1024 + mt * 128, mvalid, W, 1024, 1024, smem, epi);
  }
}

__device__ __forceinline__ void phase_moe_down(const Params& p, int l, bool last, unsigned char* smem) {
  const int npass = last ? 1 : 2;
  for (int pass = 0; pass < npass; ++pass)
  XCD_FOR(t, ((pass == npass - 1) ? 2048 : 256)) {
    int inst, mt, nt, mvalid, hid_row;
    if (pass == npass - 1) { const int e_ = t >> 7, b_ = (t >> 6) & 1; inst = b_ * 16 + e_; mt = (t >> 3) & 7; nt = t & 7; mvalid = 128; hid_row = inst * 1024 + mt * 128; }
    else { const int e_ = t >> 4, b_ = (t >> 3) & 1; inst = 32 + b_ * 16 + e_; mt = 0; nt = t & 7; mvalid = 32; hid_row = 32768 + (inst - 32) * 128; }
    const int e = inst & 15;
    const float* gate = p.GATE + (size_t)inst * 1024 + mt * 128;
    const u16* W = p.WdT + (size_t)(l * 16 + e) * 1024 * 512 + (size_t)nt * 128 * 512;
    u16* yb = p.YB + (size_t)hid_row * 1024 + nt * 128;
    auto epi = [&](f32x4(&acc)[4][4], int r0, int c0) {
      auto vf = [&](int r, int, float v) { return (r < mvalid ? gate[r] : 0.f) * v; };
      auto rp = [&](int r) -> u16* { return r < mvalid ? yb + (size_t)r * 1024 : nullptr; };
      epi_staged_bf16<4>(acc, r0, c0, smem, vf, rp);
    };
    if (mvalid == 128) gemm_tile<4, false, false>(p.HID + (size_t)hid_row * 512, 512, nullptr, 128, W, 512, 512, smem, epi);
    else gemm_tile<4, false, true>(p.HID + (size_t)hid_row * 512, 512, nullptr, mvalid, W, 512, 512, smem, epi);
  }
}

template <bool COMBINE, bool MOD>
__device__ __forceinline__ void phase_combine_modulate(const Params& p, int lprev, int lnext, const float* xlat, const float* xctx,
                                                       float* olat, float* octx, int nrows) {
  constexpr int R = 2;
  const int t = tid_(), lane = t & 63, wid = t >> 6;
  const int gw = bid_() * 4 + wid, nw = gridDim.x * 4;
  for (int row0 = gw * R; row0 < nrows; row0 += nw * R) {
    const bool lat = row0 < T_LAT;
    const float* xr = lat ? xlat + (size_t)row0 * DM : xctx + (size_t)(row0 - T_LAT) * DM;
    const int cond = row_cond(row0);
    float4 v[R][4];
#pragma unroll
    for (int r = 0; r < R; ++r)
#pragma unroll
      for (int i = 0; i < 4; ++i) v[r][i] = *(const float4*)(xr + (size_t)r * DM + i * 256 + lane * 4);
    if (COMBINE) {
      const int b = row_batch(row0);
      const int myinv = p.INV[(size_t)row0 * 16 + (lane & 31)];
      const float* g2 = p.mada + (size_t)(lprev * 3 + cond) * 6144 + 5 * 1024;
      float* orow = lat ? olat + (size_t)row0 * DM : octx + (size_t)(row0 - T_LAT) * DM;
#pragma unroll
      for (int r = 0; r < R; ++r) {
        float4 s[4];
#pragma unroll
        for (int i = 0; i < 4; ++i) s[i] = make_float4(0.f, 0.f, 0.f, 0.f);
        unsigned mask = (unsigned)((__ballot(myinv >= 0) >> (16 * r)) & 0xFFFFull);
        while (mask) {
          const int e0 = __builtin_ctz(mask);
          mask &= mask - 1;
          const bool two = mask != 0u;
          const int e1 = two ? __builtin_ctz(mask) : e0;
          mask &= mask - 1;
          const int s0 = __shfl(myinv, 16 * r + e0), s1 = __shfl(myinv, 16 * r + e1);
          const size_t y0 = lat ? (size_t)(b * 16 + e0) * 1024 + s0 : (size_t)32768 + (size_t)(b * 16 + e0) * 128 + s0;
          const size_t y1 = lat ? (size_t)(b * 16 + e1) * 1024 + s1 : (size_t)32768 + (size_t)(b * 16 + e1) * 128 + s1;
          u32x2 a0[4], a1[4];
#pragma unroll
          for (int i = 0; i < 4; ++i) { a0[i] = *(const u32x2*)(p.YB + y0 * 1024 + lane * 4 + i * 256); a1[i] = *(const u32x2*)(p.YB + y1 * 1024 + lane * 4 + i * 256); }
          const float w1 = two ? 1.f : 0.f;
#pragma unroll
          for (int i = 0; i < 4; ++i) {
            s[i].x += bf2f((u16)(a0[i].x & 0xffffu)); s[i].y += bf2f((u16)(a0[i].x >> 16));
            s[i].z += bf2f((u16)(a0[i].y & 0xffffu)); s[i].w += bf2f((u16)(a0[i].y >> 16));
            s[i].x += w1 * bf2f((u16)(a1[i].x & 0xffffu)); s[i].y += w1 * bf2f((u16)(a1[i].x >> 16));
            s[i].z += w1 * bf2f((u16)(a1[i].y & 0xffffu)); s[i].w += w1 * bf2f((u16)(a1[i].y >> 16));
          }
        }
#pragma unroll
        for (int i = 0; i < 4; ++i) {
          const int col = i * 256 + lane * 4;
          const float4 g4 = *(const float4*)(g2 + col);
          v[r][i].x += g4.x * s[i].x; v[r][i].y += g4.y * s[i].y; v[r][i].z += g4.z * s[i].z; v[r][i].w += g4.w * s[i].w;
          *(float4*)(orow + (size_t)r * DM + col) = v[r][i];
        }
      }
    }
    if (MOD) {
      const float* sh = p.mada + (size_t)(lnext * 3 + cond) * 6144;
      const float* sc = sh + 1024;
      float rstd[R];
#pragma unroll
      for (int r = 0; r < R; ++r) {
        float ss = 0.f;
#pragma unroll
        for (int i = 0; i < 4; ++i) ss += v[r][i].x * v[r][i].x + v[r][i].y * v[r][i].y + v[r][i].z * v[r][i].z + v[r][i].w * v[r][i].w;
        rstd[r] = rsqrtf(wave_sum(ss) * (1.f / 1024.f) + 1e-6f);
      }
#pragma unroll
      for (int i = 0; i < 4; ++i) {
        const int col = i * 256 + lane * 4;
        const float4 s4 = *(const float4*)(sc + col);
        const float4 h4 = *(const float4*)(sh + col);
#pragma unroll
        for (int r = 0; r < R; ++r) {
          u32x2 pk;
          pk.x = pack2(v[r][i].x * rstd[r] * (1.f + s4.x) + h4.x, v[r][i].y * rstd[r] * (1.f + s4.y) + h4.y);
          pk.y = pack2(v[r][i].z * rstd[r] * (1.f + s4.z) + h4.z, v[r][i].w * rstd[r] * (1.f + s4.w) + h4.w);
          *(u32x2*)(p.H + (size_t)(row0 + r) * DM + col) = pk;
        }
      }
    }
  }
}

__global__ void __launch_bounds__(256, 2) fwd_megakernel(Params p_unused) {
  const Params& p = *(const Params*)__builtin_amdgcn_kernarg_segment_ptr();
  __shared__ __attribute__((aligned(16))) unsigned char smem[SMEM_BYTES];
  __shared__ uint4 xb_words;
  cg::grid_group grid = cg::this_grid();
  if (threadIdx.x == 0) xb_words = make_uint4(0u, 0u, 0u, 0u);
  __syncthreads();
  XcdBarrier xb = xcd_barrier_post(p.bar, (volatile LAS unsigned*)&xb_words);

#define LP (*launder_(&p))
  phase_prep(LP, smem);
  if (xb_ld(&p.bar[XB_TMO]) == 0xFFFFFFFFu) grid.sync();
  if (threadIdx.x == 0) {
    XB_SPIN(xb_ld(&p.bar[64]) < 192u, p.bar);
    __builtin_amdgcn_fence(__ATOMIC_ACQUIRE, "agent");
    asm volatile("s_waitcnt vmcnt(0)" ::: "memory");
  }
  __syncthreads();

  for (int l = 0; l < 2; ++l) {
    const bool last = (l == 1);
    if (!last) { phase_router_prep(LP); phase_combine_modulate<false, true>(LP, 0, 0, p.x, p.ctx, nullptr, nullptr, TT); }
    else phase_combine_modulate<true, true>(LP, 0, 1, p.out, p.XC, p.out, p.XC, TT);
    xcd_barrier(xb);
    phase_in_gemm(LP, l, smem);
    xcd_barrier(xb);
    phase_mix_a(LP, l, last, smem);
    xcd_barrier(xb);
    phase_mix_b(LP, l, last, smem);
    xcd_barrier(xb);
    phase_attn(LP, l, last, smem);
    xcd_barrier(xb);
    phase_out_gemm(LP, l, last, last ? p.out : p.x, last ? p.XC : p.ctx, p.out, p.XC, smem);
    xcd_barrier(xb);
    phase_router(LP, l, p.out, p.XC, last ? T_LAT : TT);
    xcd_barrier(xb);
    phase_topk(LP, last, smem);
    phase_modulate<4>(LP, l, p.out, p.XC, last ? T_LAT : TT, 3, last ? 32 : 64);
    xcd_barrier(xb);
    phase_moe_up(LP, l, last, smem);
    xcd_barrier(xb);
    phase_moe_down(LP, l, last, smem);
    xcd_barrier(xb);
  }
  phase_combine_modulate<true, false>(LP, 1, 1, p.out, p.XC, p.out, p.XC, T_LAT);
#undef LP
}

extern "C" void kernel_launch(void* const* d_in, const int* in_sizes, int n_in, void* d_out, int out_size, void* d_ws,
                              size_t ws_size, hipStream_t stream) {
  static int grid_blocks = 0;
  if (!grid_blocks) {
    int dev = 0, cus = 0, per_cu = 0;
    hipGetDevice(&dev);
    hipDeviceGetAttribute(&cus, hipDeviceAttributeMultiprocessorCount, dev);
    hipOccupancyMaxActiveBlocksPerMultiprocessor(&per_cu, fwd_megakernel, 256, 0);
    if (per_cu > 2) per_cu = 2;
    if (per_cu < 1) per_cu = 1;
    grid_blocks = (cus * per_cu) & ~7;
    if (grid_blocks < 8) grid_blocks = 8;
  }
  Params p{};
  const float* const* in = (const float* const*)d_in;
  p.x = in[0]; p.c = in[1]; p.ctx = in[2]; p.c_ctx = in[3]; p.w_ada = in[4]; p.b_ada = in[5]; p.w_in = in[6];
  p.sgu_norm = in[7]; p.w_sgu = in[8]; p.b_sgu = in[9]; p.q_lora_norm = in[10]; p.w_uq = in[11]; p.kv_lora_norm = in[12];
  p.w_ukv = in[13]; p.q_norm = in[14]; p.k_norm = in[15]; p.w_out = in[16]; p.w_router = in[17]; p.w_gate = in[18];
  p.w_up = in[19]; p.w_down = in[20];
  p.out = (float*)d_out;
  unsigned char* base = (unsigned char*)d_ws;
  size_t off = 0;
  auto alloc = [&](size_t bytes) { void* r = base + off; off += (bytes + 255) & ~(size_t)255; return r; };
  p.bar = (unsigned*)alloc(16384);
  p.mada = (float*)alloc((size_t)2 * 3 * 6144 * 4);
  p.WinT = (u16*)alloc((size_t)2 * 1536 * 1024 * 2);
  p.WuqT = (u16*)alloc((size_t)2 * 768 * 256 * 2);
  p.WukvT = (u16*)alloc((size_t)2 * 1024 * 128 * 2);
  p.WoutT = (u16*)alloc((size_t)2 * 1024 * 1024 * 2);
  p.WguT = (u16*)alloc((size_t)2 * 16 * 1024 * 1024 * 2);
  p.WdT = (u16*)alloc((size_t)2 * 16 * 1024 * 512 * 2);
  p.Wsgu = (u16*)alloc((size_t)2 * 4 * 128 * 128 * 2);
  p.M1 = (u16*)alloc((size_t)128 * 128 * 128 * 2);
  p.M2 = (u16*)alloc((size_t)128 * 256 * 2);
  p.Mc = (u16*)alloc((size_t)256 * 512 * 2);
  p.XC = (float*)alloc((size_t)T_CTX * DM * 4);
  p.AFFT = (float*)alloc((size_t)(32 * SEQ + 32 * CTX) * 4);
  p.GATE = (float*)alloc((size_t)64 * 1024 * 4);
  p.IDXG = (int*)alloc((size_t)64 * 1024 * 4);
  p.INV = (int*)alloc((size_t)TT * 16 * 4);
  p.WR2 = (float*)alloc((size_t)2 * 3 * 16384 * 4);
  p.CE = (float*)alloc((size_t)96 * 4);
  p.GDc = (u16*)alloc((size_t)2 * 2 * CTX * 256 * 2);
  unsigned char* RH = (unsigned char*)alloc((size_t)TT * 1024 * 2);
  p.H = (u16*)RH;
  p.PF = (u16*)RH;
  p.KN = (u16*)(RH + (size_t)2 * 64 * 2 * 128 * 256 * 2);
  p.PX = (u16*)alloc((size_t)TT * 1024 * 2);
  p.YM = (u16*)alloc((size_t)TT * 1024 * 2);
  unsigned char* RA = (unsigned char*)alloc((size_t)2 * 4 * NPOS * 192 * 2);
  unsigned char* RB = (unsigned char*)alloc((size_t)2 * 4 * NPOS * 192 * 2);
  p.GD = (u16*)RA;
  p.Qall = (u16*)RA;
  p.Kb = (u16*)RB;
  p.QR = (u16*)alloc((size_t)TT * 768 * 2);
  p.HID = p.QR;
  p.YB = p.PX;
  p.Vt = (u16*)alloc((size_t)2 * 4 * 128 * NPOS * 2);
  if (off > ws_size) fprintf(stderr, "workspace too small: need %zu have %zu\n", off, ws_size);

  hipMemsetAsync(p.bar, 0, 16384, stream);
  void* args[] = {&p};
  hipError_t e = hipLaunchCooperativeKernel((void*)fwd_megakernel, dim3(grid_blocks), dim3(256), args, 0, stream);
  if (e != hipSuccess) fprintf(stderr, "cooperative launch failed: %s (grid %d)\n", hipGetErrorString(e), grid_blocks);
}
```

```cpp
#include <hip/hip_runtime.h>
#include <hip/hip_cooperative_groups.h>
#include <stdint.h>
#include <stdio.h>
namespace cg = cooperative_groups;

typedef unsigned short u16;
typedef __attribute__((ext_vector_type(8))) short bf16x8;
typedef __attribute__((ext_vector_type(4))) float f32x4;
typedef unsigned __attribute__((ext_vector_type(4))) u32x4;
typedef unsigned __attribute__((ext_vector_type(2))) u32x2;

constexpr int DM = 1024;
constexpr int SEQ = 8192, CTX = 256;
constexpr int T_LAT = 2 * SEQ, T_CTX = 2 * CTX, TT = T_LAT + T_CTX;
constexpr int NPOS = SEQ + CTX;
constexpr int SMEM_BYTES = 71680;

struct Params {
  const float *x, *c, *ctx, *c_ctx, *w_ada, *b_ada, *w_in, *sgu_norm, *w_sgu, *b_sgu, *q_lora_norm, *w_uq,
      *kv_lora_norm, *w_ukv, *q_norm, *k_norm, *w_out, *w_router, *w_gate, *w_up, *w_down;
  float* out;
  unsigned* bar;
  float* mada;
  u16 *WinT, *WuqT, *WukvT, *WoutT, *WguT, *WdT, *Wsgu, *M1, *M2, *Mc;
  float* XC;
  u16 *H, *PX, *YM, *GD, *GDc, *PF, *QR, *KN, *Vt, *Qall, *Kb, *HID;
  float *AFFT, *GATE, *WR2, *CE;
  int *IDXG, *INV;
  u16* YB;
};

typedef float f32x2_t __attribute__((ext_vector_type(2)));
typedef __bf16 bf16x2_t __attribute__((ext_vector_type(2)));
__device__ __forceinline__ unsigned pack2(float a, float b) {
  f32x2_t v = {a, b};
  bf16x2_t r = __builtin_convertvector(v, bf16x2_t);
  return __builtin_bit_cast(unsigned, r);
}
__device__ __forceinline__ u16 f2bf(float f) { return (u16)(pack2(f, 0.f) & 0xffffu); }
__device__ __forceinline__ float bf2f(u16 b) { return __uint_as_float(((unsigned)b) << 16); }
__device__ __forceinline__ float wave_sum(float v) {
#pragma unroll
  for (int o = 32; o; o >>= 1) v += __shfl_xor(v, o);
  return v;
}
__device__ __forceinline__ int tid_() { int t = threadIdx.x; asm volatile("" : "+v"(t)); return t; }
__device__ __forceinline__ const struct Params* launder_(const struct Params* q) { asm volatile("" : "+s"(q)); return q; }
__device__ __forceinline__ int bid_() { int b = blockIdx.x; asm volatile("" : "+s"(b)); return b; }
__device__ __forceinline__ float gelu_tanh(float x) {
  float y = 0.7978845608028654f * (x + 0.044715f * x * x * x);
  return x / (1.f + __expf(-2.f * y));
}
__device__ __forceinline__ float silu_f(float x) { return x / (1.f + __expf(-x)); }

#define XB_TMO 128
#define XB_XCNT(j) (256 + 64 * (j))
#define XB_XSUB(j) (1280 + 64 * (j))
#define XB_XGEN(j) (2304 + 64 * (j))
#define XB_TOP 3328
#define XB_TOPGEN 3392
#define XCD_BAR_WORDS 3456
#define XB_SPIN_CAP (1u << 22)
#define LAS __attribute__((address_space(3)))

__device__ __forceinline__ unsigned xb_ld(unsigned* p) { return __hip_atomic_load(p, __ATOMIC_RELAXED, __HIP_MEMORY_SCOPE_AGENT); }
__device__ __forceinline__ unsigned xb_add(unsigned* p, unsigned v) { return __hip_atomic_fetch_add(p, v, __ATOMIC_RELAXED, __HIP_MEMORY_SCOPE_AGENT); }
__device__ __forceinline__ unsigned xb_xcc_id() { return (unsigned)__builtin_amdgcn_s_getreg((3 << 11) | 20) & 0xFu; }
#define XB_SPIN(cond, bar)                                            \
  do {                                                                \
    unsigned _sp = 0;                                                 \
    while (cond) {                                                    \
      __builtin_amdgcn_s_sleep(1);                                    \
      if ((++_sp & 255u) == 0u) {                                     \
        if (xb_ld(&(bar)[XB_TMO])) break;                             \
        if (_sp > XB_SPIN_CAP) { atomicAdd(&(bar)[XB_TMO], 1u); break; } \
      }                                                               \
    }                                                                 \
  } while (0)

struct XcdBarrier {
  unsigned* bar;
  unsigned x;
  volatile LAS unsigned* st;
};
__device__ __forceinline__ XcdBarrier xcd_barrier_post(unsigned* bar, volatile LAS unsigned* st) {
  XcdBarrier b;
  b.bar = bar;
  b.x = xb_xcc_id();
  b.st = st;
  if (threadIdx.x == 0) (void)xb_add(&bar[XB_XCNT(b.x)], 1u);
  return b;
}
__device__ __forceinline__ void xcd_barrier_complete(unsigned* bar, unsigned x, unsigned& nloc, unsigned& nx) {
  const unsigned G = gridDim.x * gridDim.y * gridDim.z;
  unsigned sum, cnt, mine, sp = 0u;
  for (;;) {
    sum = 0u; cnt = 0u; mine = 0u;
#pragma unroll
    for (unsigned j = 0; j < 16; ++j) {
      const unsigned c = xb_ld(&bar[XB_XCNT(j)]);
      sum += c; cnt += (c > 0u) ? 1u : 0u; mine = (j == x) ? c : mine;
    }
    if (sum == G) break;
    __builtin_amdgcn_s_sleep(1);
    if ((++sp & 255u) == 0u) {
      if (xb_ld(&bar[XB_TMO])) break;
      if (sp > XB_SPIN_CAP) { atomicAdd(&bar[XB_TMO], 1u); break; }
    }
  }
  nloc = mine > 0u ? mine : 1u;
  nx = cnt > 0u ? cnt : 1u;
}
__device__ __forceinline__ void xcd_barrier(const XcdBarrier& b) {
  asm volatile("s_waitcnt vmcnt(0)" ::: "memory");
  __syncthreads();
  if (threadIdx.x == 0) {
    unsigned* bar = b.bar;
    __builtin_amdgcn_s_waitcnt(0);
    unsigned nloc = b.st[0], nx = b.st[1];
    if (nloc == 0u) { xcd_barrier_complete(bar, b.x, nloc, nx); b.st[0] = nloc; b.st[1] = nx; }
    const unsigned old = xb_add(&bar[XB_XSUB(b.x)], 1u);
    const unsigned gen = old / nloc;
    if (old + 1u == (gen + 1u) * nloc) {
      __builtin_amdgcn_fence(__ATOMIC_RELEASE, "agent");
      asm volatile("s_waitcnt vmcnt(0)" ::: "memory");
      const unsigned og = xb_add(&bar[XB_TOP], 1u);
      const unsigned tg = og / nx;
      if (og + 1u == (tg + 1u) * nx) xb_add(&bar[XB_TOPGEN], 1u);
      else XB_SPIN(xb_ld(&bar[XB_TOPGEN]) == tg, bar);
      __builtin_amdgcn_fence(__ATOMIC_ACQUIRE, "agent");
      xb_add(&bar[XB_XGEN(b.x)], 1u);
      asm volatile("s_waitcnt vmcnt(0)" ::: "memory");
    } else {
      XB_SPIN(xb_ld(&bar[XB_XGEN(b.x)]) == gen, bar);
      __builtin_amdgcn_fence(__ATOMIC_ACQUIRE, "agent");
      asm volatile("s_waitcnt vmcnt(0)" ::: "memory");
    }
  }
  __syncthreads();
}

#define XCD_FOR(u, T)                                                                                         \
  for (int _x = bid_() & 7, _gb = gridDim.x >> 3, _hi = (int)(((long)(_x + 1) * (T)) >> 3),                    \
           u = (int)(((long)_x * (T)) >> 3) + (bid_() >> 3);                                                  \
       u < _hi; u += _gb)

template <int NT, bool BKN, bool MASK = false, bool ROWSS = false, class Epi>
__device__ __forceinline__ void gemm_tile(const u16* __restrict__ A, int lda, const int* __restrict__ arows, int mvalid,
                                          const u16* __restrict__ B, int ldb, int K, unsigned char* smem, Epi epi,
                                          const float* ascale = nullptr) {
  constexpr int BN = NT * 32;
  constexpr int CPR = BN / 8;
  u16* S0 = (u16*)smem;
  const int t = tid_(), lane = t & 63, wid = t >> 6, wr = wid >> 1, wc = wid & 1, l16 = lane & 15, quad = lane >> 4;
  const u16* ap[4];
  const u16* bp[NT];
  unsigned amask = 0u;
#pragma unroll
  for (int i = 0; i < 4; ++i) {
    const int row = (t >> 3) + 32 * i;
    const bool v = MASK ? (row < mvalid) : true;
    amask |= v ? (1u << i) : 0u;
    int r = v ? row : 0;
    if (arows) r = arows[r];
    ap[i] = A + (size_t)r * lda + (t & 7) * 8;
  }
#pragma unroll
  for (int i = 0; i < NT; ++i) {
    if (!BKN) bp[i] = B + (size_t)((t >> 3) + 32 * i) * ldb + (t & 7) * 8;
    else { const int c = t + 256 * i; bp[i] = B + (size_t)(c / CPR) * ldb + (c % CPR) * 8; }
  }
  const size_t bstep = BKN ? (size_t)64 * ldb : (size_t)64;
  int nmi = 4;
  if (MASK) { nmi = (mvalid - wr * 64 + 15) >> 4; nmi = nmi < 0 ? 0 : (nmi > 4 ? 4 : nmi); nmi = __builtin_amdgcn_readfirstlane(nmi); }
  u32x4 ra0[4], rb0[NT], ra1[4], rb1[NT];
#define GEMM_LOAD(RA, RB, kt_)                                                                      \
  {                                                                                                 \
    _Pragma("unroll") for (int i = 0; i < 4; ++i) {                                                 \
      RA[i] = *(const u32x4*)(ap[i] + (size_t)(kt_) * 64);                                          \
      if (MASK && !((amask >> i) & 1u)) RA[i] = (u32x4){0u, 0u, 0u, 0u};                            \
    }                                                                                               \
    _Pragma("unroll") for (int i = 0; i < NT; ++i) RB[i] = *(const u32x4*)(bp[i] + (size_t)(kt_) * bstep); \
  }
#define GEMM_STORE(RA, RB, st_)                                                                     \
  {                                                                                                 \
    u16* As_ = S0 + (st_) * 16384;                                                                  \
    u16* Bs_ = As_ + 8192;                                                                          \
    if (ROWSS) {                                                                                    \
      _Pragma("unroll") for (int i = 0; i < 4; ++i) {                                               \
        const u32x4 w_ = RA[i];                                                                     \
        const float a0 = __uint_as_float(w_.x << 16), a1 = __uint_as_float(w_.x & 0xffff0000u);     \
        const float a2 = __uint_as_float(w_.y << 16), a3 = __uint_as_float(w_.y & 0xffff0000u);     \
        const float a4 = __uint_as_float(w_.z << 16), a5 = __uint_as_float(w_.z & 0xffff0000u);     \
        const float a6 = __uint_as_float(w_.w << 16), a7 = __uint_as_float(w_.w & 0xffff0000u);     \
        ss_[i] += (a0 * a0 + a1 * a1) + (a2 * a2 + a3 * a3) + (a4 * a4 + a5 * a5) + (a6 * a6 + a7 * a7); \
      }                                                                                             \
    }                                                                                               \
    if (ascale) {                                                                                   \
      const float* sc_ = ascale + stk_ * 64 + (t & 7) * 8;                                          \
      const float4 s0_ = *(const float4*)(sc_), s1_ = *(const float4*)(sc_ + 4);                    \
      _Pragma("unroll") for (int i = 0; i < 4; ++i) {                                               \
        u32x4 w_ = RA[i];                                                                           \
        w_.x = pack2(__uint_as_float(w_.x << 16) * s0_.x, __uint_as_float(w_.x & 0xffff0000u) * s0_.y); \
        w_.y = pack2(__uint_as_float(w_.y << 16) * s0_.z, __uint_as_float(w_.y & 0xffff0000u) * s0_.w); \
        w_.z = pack2(__uint_as_float(w_.z << 16) * s1_.x, __uint_as_float(w_.z & 0xffff0000u) * s1_.y); \
        w_.w = pack2(__uint_as_float(w_.w << 16) * s1_.z, __uint_as_float(w_.w & 0xffff0000u) * s1_.w); \
        RA[i] = w_;                                                                                 \
      }                                                                                             \
    }                                                                                               \
    ++stk_;                                                                                         \
    _Pragma("unroll") for (int i = 0; i < 4; ++i) {                                                 \
      const int row = (t >> 3) + 32 * i;                                                            \
      *(u32x4*)(As_ + row * 64 + (((t & 7) ^ ((row >> 1) & 7)) << 3)) = RA[i];                      \
    }                                                                                               \
    if (!BKN) {                                                                                     \
      _Pragma("unroll") for (int i = 0; i < NT; ++i) {                                              \
        const int row = (t >> 3) + 32 * i;                                                          \
        *(u32x4*)(Bs_ + row * 64 + (((t & 7) ^ ((row >> 1) & 7)) << 3)) = RB[i];                    \
      }                                                                                             \
    } else {                                                                                        \
      _Pragma("unroll") for (int i = 0; i < NT; ++i) {                                              \
        const int c = t + 256 * i;                                                                  \
        const int k = c / CPR, n8 = (c % CPR) * 8;                                                  \
        const u32x4 w = RB[i];                                                                      \
        const unsigned e[8] = {w.x & 0xffffu, w.x >> 16, w.y & 0xffffu, w.y >> 16, w.z & 0xffffu, w.z >> 16, w.w & 0xffffu, w.w >> 16}; \
        _Pragma("unroll") for (int j = 0; j < 8; ++j) {                                             \
          const int n = n8 + j;                                                                     \
          Bs_[n * 64 + ((((k >> 3) ^ ((n >> 1) & 7))) << 3) + (k & 7)] = (u16)e[j];                 \
        }                                                                                           \
      }                                                                                             \
    }                                                                                               \
  }
#define GEMM_COMPUTE(st_)                                                                           \
  {                                                                                                 \
    const u16* As_ = S0 + (st_) * 16384;                                                            \
    const u16* Bs_ = As_ + 8192;                                                                    \
    _Pragma("unroll") for (int ks = 0; ks < 2; ++ks) {                                              \
      bf16x8 af[4], bfr[NT];                                                                        \
      _Pragma("unroll") for (int mi = 0; mi < 4; ++mi) {                                            \
        const int row = wr * 64 + mi * 16 + l16;                                                    \
        af[mi] = *(const bf16x8*)(As_ + row * 64 + (((ks * 4 + quad) ^ ((row >> 1) & 7)) << 3));    \
      }                                                                                             \
      _Pragma("unroll") for (int ni = 0; ni < NT; ++ni) {                                           \
        const int row = wc * (BN / 2) + ni * 16 + l16;                                              \
        bfr[ni] = *(const bf16x8*)(Bs_ + row * 64 + (((ks * 4 + quad) ^ ((row >> 1) & 7)) << 3));   \
      }                                                                                             \
      _Pragma("unroll") for (int mi = 0; mi < 4; ++mi)                                              \
        if (!MASK || mi < nmi)                                                                      \
        _Pragma("unroll") for (int ni = 0; ni < NT; ++ni) acc[mi][ni] = __builtin_amdgcn_mfma_f32_16x16x32_bf16(af[mi], bfr[ni], acc[mi][ni], 0, 0, 0); \
    }                                                                                               \
  }
  float ss_[4] = {0.f, 0.f, 0.f, 0.f};
  int stk_ = 0;
  f32x4 acc[4][NT];
#pragma unroll
  for (int i = 0; i < 4; ++i)
#pragma unroll
    for (int j = 0; j < NT; ++j) acc[i][j] = (f32x4){0.f, 0.f, 0.f, 0.f};
  const int nk = K >> 6;
  const int nkm1 = nk - 1;
  __syncthreads();
  GEMM_LOAD(ra0, rb0, 0);
  GEMM_LOAD(ra1, rb1, 1);
  GEMM_STORE(ra0, rb0, 0);
  GEMM_LOAD(ra0, rb0, (2 < nkm1 ? 2 : nkm1));
  __syncthreads();
  for (int kt = 0; kt < nk - 2; kt += 2) {
    GEMM_COMPUTE(0);
    GEMM_STORE(ra1, rb1, 1);
    GEMM_LOAD(ra1, rb1, kt + 3);
    __syncthreads();
    GEMM_COMPUTE(1);
    GEMM_STORE(ra0, rb0, 0);
    GEMM_LOAD(ra0, rb0, (kt + 4 < nkm1 ? kt + 4 : nkm1));
    __syncthreads();
  }
  GEMM_COMPUTE(0);
  GEMM_STORE(ra1, rb1, 1);
  __syncthreads();
  GEMM_COMPUTE(1);
#undef GEMM_LOAD
#undef GEMM_STORE
#undef GEMM_COMPUTE
  if (ROWSS) {
    float* rs = (float*)(smem + 65536);
#pragma unroll
    for (int i = 0; i < 4; ++i) {
      float s = ss_[i];
      s += __shfl_xor(s, 1); s += __shfl_xor(s, 2); s += __shfl_xor(s, 4);
      if ((t & 7) == 0) rs[(t >> 3) + 32 * i] = rsqrtf(s / (float)K + 1e-6f);
    }
    __syncthreads();
  }
  epi(acc, wr * 64 + quad * 4, wc * (BN / 2) + l16);
}

template <int NT, class VF, class RP>
__device__ __forceinline__ void epi_staged_bf16(f32x4 (&acc)[4][NT], int r0, int c0, unsigned char* smem, VF vf, RP rowptr) {
  constexpr int BN = NT * 32, PITCH = BN + 8, CPR = BN / 8;
  u16* Ts = (u16*)smem;
  const int t = tid_();
  __syncthreads();
#pragma unroll
  for (int mi = 0; mi < 4; ++mi)
#pragma unroll
    for (int ni = 0; ni < NT; ++ni)
#pragma unroll
      for (int j = 0; j < 4; ++j) {
        const int r = r0 + mi * 16 + j, c = c0 + ni * 16;
        Ts[r * PITCH + c] = f2bf(vf(r, c, acc[mi][ni][j]));
      }
  __syncthreads();
#pragma unroll
  for (int i = 0; i < CPR / 2; ++i) {
    const int c = t + 256 * i, row = c / CPR, ch = c % CPR;
    u16* d = rowptr(row);
    if (d) *(u32x4*)(d + ch * 8) = *(const u32x4*)(Ts + row * PITCH + ch * 8);
  }
}

template <class RP>
__device__ __forceinline__ void epi_staged_bf16_T(f32x4 (&acc)[4][4], int r0, int c0, unsigned char* smem, RP colptr) {
  constexpr int PITCH = 136;
  u16* Ts = (u16*)smem;
  const int t = tid_();
  __syncthreads();
#pragma unroll
  for (int mi = 0; mi < 4; ++mi)
#pragma unroll
    for (int ni = 0; ni < 4; ++ni) {
      u32x2 pk;
      pk.x = pack2(acc[mi][ni][0], acc[mi][ni][1]);
      pk.y = pack2(acc[mi][ni][2], acc[mi][ni][3]);
      *(u32x2*)(Ts + (c0 + ni * 16) * PITCH + r0 + mi * 16) = pk;
    }
  __syncthreads();
#pragma unroll
  for (int i = 0; i < 8; ++i) {
    const int c = t + 256 * i, col = c >> 4, ch = c & 15;
    *(u32x4*)(colptr(col) + ch * 8) = *(const u32x4*)(Ts + col * PITCH + ch * 8);
  }
}

__device__ __forceinline__ void epi_staged_residual(f32x4 (&acc)[4][4], int r0, int c0, unsigned char* smem, const float* __restrict__ g,
                                                    const float* __restrict__ xs, float* __restrict__ xd) {
  constexpr int PITCH = 132;
  float* Ts = (float*)smem;
  const int t = tid_();
  const int wr = r0 >> 6;
#pragma unroll
  for (int pass = 0; pass < 2; ++pass) {
    __syncthreads();
    if (wr == pass) {
#pragma unroll
      for (int mi = 0; mi < 4; ++mi)
#pragma unroll
        for (int ni = 0; ni < 4; ++ni)
#pragma unroll
          for (int j = 0; j < 4; ++j) Ts[((r0 & 63) + mi * 16 + j) * PITCH + c0 + ni * 16] = acc[mi][ni][j];
    }
    __syncthreads();
#pragma unroll
    for (int i = 0; i < 8; ++i) {
      const int c = t + 256 * i, row = c >> 5, ch = c & 31;
      const float4 a = *(const float4*)(Ts + row * PITCH + ch * 4);
      const float4 gg = *(const float4*)(g + ch * 4);
      const size_t o = (size_t)(pass * 64 + row) * DM + ch * 4;
      float4 x = *(const float4*)(xs + o);
      x.x += gg.x * a.x; x.y += gg.y * a.y; x.z += gg.z * a.z; x.w += gg.w * a.w;
      *(float4*)(xd + o) = x;
    }
  }
}

__device__ __forceinline__ void ada_item(const Params& p, int it, unsigned char* smem) {
  float* sc = (float*)smem;
  float* red = sc + 3072;
  const int t = tid_(), lane = t & 63, wid = t >> 6;
  const int l = it / 96, jc = it % 96;
#pragma unroll
  for (int i = 0; i < 12; ++i) {
    const int idx = t + 256 * i, r = idx >> 10, k = idx & 1023;
    const float cv = r < 2 ? p.c[r * 1024 + k] : p.c_ctx[k];
    sc[idx] = silu_f(cv);
  }
  __syncthreads();
  const float* w = p.w_ada + (size_t)l * 1024 * 6144 + jc * 64 + lane;
  float a0 = 0.f, a1 = 0.f, a2 = 0.f;
  const int kb = wid * 256;
#pragma unroll 8
  for (int k = 0; k < 256; ++k) {
    const float wv = __builtin_nontemporal_load(w + (size_t)(kb + k) * 6144);
    a0 += sc[kb + k] * wv;
    a1 += sc[1024 + kb + k] * wv;
    a2 += sc[2048 + kb + k] * wv;
  }
  red[(wid * 3 + 0) * 64 + lane] = a0;
  red[(wid * 3 + 1) * 64 + lane] = a1;
  red[(wid * 3 + 2) * 64 + lane] = a2;
  __syncthreads();
  if (t < 192) {
    const int r = t >> 6, ln = t & 63;
    float s = 0.f;
#pragma unroll
    for (int w4 = 0; w4 < 4; ++w4) s += red[(w4 * 3 + r) * 64 + ln];
    s += p.b_ada[l * 6144 + jc * 64 + ln];
    p.mada[(l * 3 + r) * 6144 + jc * 64 + ln] = s;
  }
  asm volatile("s_waitcnt vmcnt(0)" ::: "memory");
  __syncthreads();
  if (t == 0) {
    __builtin_amdgcn_fence(__ATOMIC_RELEASE, "agent");
    asm volatile("s_waitcnt vmcnt(0)" ::: "memory");
    (void)xb_add(&p.bar[64], 1u);
  }
}

__device__ __forceinline__ void fold_item(const Params& p, int it, unsigned char* smem) {
  float* tile = (float*)smem;
  float* ct = tile + 64 * 65;
  const int t = tid_();
  const int l = it >> 6, rem = it & 63, g = rem >> 4, k0 = (rem & 15) * 64;
#pragma unroll
  for (int i = 0; i < 16; ++i) {
    const int kk = i * 4 + (t >> 6), d = t & 63;
    tile[kk * 65 + d] = __builtin_nontemporal_load(p.w_in + (size_t)(l * 1024 + k0 + kk) * 1216 + 512 + g * 64 + d);
  }
  if (t < 64) ct[t] = cospif((float)t / 32.f);
  __syncthreads();
  const int k = t & 63, jg = t >> 6;
  u16* dst = p.WinT + (size_t)l * 1536 * 1024;
  for (int jj = 0; jj < 16; ++jj) {
    const int j = jg + 4 * jj;
    float sr = 0.f, si = 0.f;
#pragma unroll 8
    for (int d = 0; d < 64; ++d) {
      const float v = tile[k * 65 + d];
      const int m = (j * d) & 63;
      sr += v * ct[m];
      si += v * ct[(m - 16) & 63];
    }
    dst[(size_t)(512 + g * 64 + j) * 1024 + k0 + k] = f2bf(sr);
    dst[(size_t)(768 + g * 64 + j) * 1024 + k0 + k] = f2bf(-si);
  }
  __syncthreads();
}

__device__ __forceinline__ void convT_tile(const float* __restrict__ src, int lds, int k0, int c0, u16* __restrict__ dst, int Kd,
                                           int rbase, int mode, int which, unsigned char* smem, const float* __restrict__ kscale = nullptr) {
  float* tile = (float*)smem;
  const int t = tid_();
  float4 v4[4];
#pragma unroll
  for (int i = 0; i < 4; ++i) {
    const f32x4 w_ = __builtin_nontemporal_load((const f32x4*)(src + (size_t)(k0 + i * 16 + (t >> 4)) * lds + c0 + (t & 15) * 4));
    v4[i] = make_float4(w_[0], w_[1], w_[2], w_[3]);
  }
#pragma unroll
  for (int i = 0; i < 4; ++i) {
    const int kk = i * 16 + (t >> 4), cc = (t & 15) * 4;
    const float sc = kscale ? kscale[k0 + kk] : 1.f;
    tile[kk * 65 + cc + 0] = v4[i].x * sc; tile[kk * 65 + cc + 1] = v4[i].y * sc;
    tile[kk * 65 + cc + 2] = v4[i].z * sc; tile[kk * 65 + cc + 3] = v4[i].w * sc;
  }
  __syncthreads();
#pragma unroll
  for (int i = 0; i < 16; ++i) {
    const int cc = i * 4 + (t >> 6), kk = t & 63;
    int row;
    if (mode == 0) row = rbase + cc;
    else { const int f = c0 + cc; row = (((f >> 4) * 2 + which) << 4) + (f & 15); }
    dst[(size_t)row * Kd + k0 + kk] = f2bf(tile[kk * 65 + cc]);
  }
  __syncthreads();
}

__device__ __forceinline__ void conv_item(const Params& p, int it, unsigned char* smem) {
  const int l = it / 6720;
  int r = it % 6720;
  if (r < 240) {
    const int ct = r >> 4, kt = r & 15;
    const int c0 = (ct < 8 ? ct : ct + 4) * 64;
    const int n0 = c0 + (c0 >= 768 ? 256 : 0);
    convT_tile(p.w_in + (size_t)l * 1024 * 1216, 1216, kt * 64, c0, p.WinT + (size_t)l * 1536 * 1024, 1024, n0, 0, 0, smem);
    return;
  }
  r -= 240;
  if (r < 48) {
    const int ct = r >> 2, kt = r & 3;
    convT_tile(p.w_uq + (size_t)l * 256 * 768, 768, kt * 64, ct * 64, p.WuqT + (size_t)l * 768 * 256, 256, ct * 64, 0, 0, smem, p.q_lora_norm + l * 256);
    return;
  }
  r -= 48;
  if (r < 32) {
    const int ct = r >> 1, kt = r & 1;
    convT_tile(p.w_ukv + (size_t)l * 128 * 1024, 1024, kt * 64, ct * 64, p.WukvT + (size_t)l * 1024 * 128, 128, ct * 64, 0, 0, smem, p.kv_lora_norm + l * 128);
    return;
  }
  r -= 32;
  if (r < 256) {
    const int ct = r >> 4, kt = r & 15;
    convT_tile(p.w_out + (size_t)l * 1024 * 1024, 1024, kt * 64, ct * 64, p.WoutT + (size_t)l * 1024 * 1024, 1024, ct * 64, 0, 0, smem);
    return;
  }
  r -= 256;
  if (r < 4096) {
    const int which = r >> 11, r2 = r & 2047, e = r2 >> 7, r3 = r2 & 127, ct = r3 >> 4, kt = r3 & 15;
    const float* src = (which ? p.w_up : p.w_gate) + (size_t)(l * 16 + e) * 1024 * 512;
    convT_tile(src, 512, kt * 64, ct * 64, p.WguT + (size_t)(l * 16 + e) * 1024 * 1024, 1024, 0, 1, which, smem);
    return;
  }
  r -= 4096;
  {
    const int e = r >> 7, r3 = r & 127, ct = r3 >> 3, kt = r3 & 7;
    convT_tile(p.w_down + (size_t)(l * 16 + e) * 512 * 1024, 1024, kt * 64, ct * 64, p.WdT + (size_t)(l * 16 + e) * 1024 * 512, 512, ct * 64, 0, 0, smem);
  }
}

__device__ __forceinline__ void elem_item(const Params& p, int it) {
  const int t = tid_();
  if (it < 128) {
#pragma unroll
    for (int i = 0; i < 4; ++i) { const int idx = it * 1024 + i * 256 + t; p.Wsgu[idx] = f2bf(p.w_sgu[idx]); }
    return;
  }
  it -= 128;
  if (it < 2048) {
#pragma unroll
    for (int i = 0; i < 4; ++i) {
      const int idx = it * 1024 + i * 256 + t;
      const int n1 = idx >> 14, m = (idx >> 7) & 127, kk = idx & 127;
      const int rip = m >> 6, k2 = m & 63, ri = kk >> 6, n2 = kk & 63;
      const int n = n1 + 128 * n2;
      const int ph = (k2 * n) & 8191;
      const float xx = (float)ph / 4096.f;
      const float cs = cospif(xx), sn = sinpif(xx);
      const float v = rip == 0 ? (ri == 0 ? cs : sn) : (ri == 0 ? -sn : cs);
      p.M1[idx] = f2bf(v);
    }
    return;
  }
  it -= 2048;
  if (it < 32) {
#pragma unroll
    for (int i = 0; i < 4; ++i) {
      const int idx = it * 1024 + i * 256 + t;
      const int k1 = idx >> 8, kk = idx & 255, ri = kk >> 7, n1 = kk & 127;
      const int ph = (k1 * n1) & 127;
      const float xx = (float)ph / 64.f;
      p.M2[idx] = f2bf(ri ? sinpif(xx) : cospif(xx));
    }
    return;
  }
  it -= 32;
  {
#pragma unroll
    for (int i = 0; i < 4; ++i) {
      const int idx = it * 1024 + i * 256 + t;
      const int k = idx >> 9, kk = idx & 511, ri = kk >> 8, n = kk & 255;
      const int ph = (k * n) & 255;
      const float xx = (float)ph / 128.f;
      p.Mc[idx] = f2bf(ri ? sinpif(xx) : cospif(xx));
    }
  }
}

__device__ __forceinline__ void phase_prep(const Params& p, unsigned char* smem) {
  const int G = gridDim.x;
  int t = bid_();
  for (; t < 192; t += G) ada_item(p, t, smem);
  t -= 192;
  for (; t < 128; t += G) fold_item(p, t, smem);
  t -= 128;
  for (; t < 13440; t += G) conv_item(p, t, smem);
  t -= 13440;
  for (; t < 2336; t += G) elem_item(p, t);
}

__device__ __forceinline__ int row_cond(int row) { return row < T_LAT ? (row >> 13) : 2; }
__device__ __forceinline__ int row_batch(int row) { return row < T_LAT ? (row >> 13) : ((row - T_LAT) >> 8); }
__device__ __forceinline__ int row_pos(int row) { return row < T_LAT ? (CTX + (row & (SEQ - 1))) : ((row - T_LAT) & (CTX - 1)); }

template <int R>
__device__ __forceinline__ void phase_modulate(const Params& p, int l, const float* xlat, const float* xctx, int nrows, int chunk, int bskip) {
  const int t = tid_(), lane = t & 63, wid = t >> 6;
  const int bb = bid_() - bskip;
  if (bb < 0) return;
  const int gw = bb * 4 + wid, nw = ((int)gridDim.x - bskip) * 4;
  for (int row0 = gw * R; row0 < nrows; row0 += nw * R) {
    const float* xr = row0 < T_LAT ? xlat + (size_t)row0 * DM : xctx + (size_t)(row0 - T_LAT) * DM;
    const float* sh = p.mada + (size_t)(l * 3 + row_cond(row0)) * 6144 + chunk * 1024;
    const float* sc = sh + 1024;
    float4 v[R][4];
#pragma unroll
    for (int r = 0; r < R; ++r)
#pragma unroll
      for (int i = 0; i < 4; ++i) v[r][i] = *(const float4*)(xr + (size_t)r * DM + i * 256 + lane * 4);
    float rstd[R];
#pragma unroll
    for (int r = 0; r < R; ++r) {
      float ss = 0.f;
#pragma unroll
      for (int i = 0; i < 4; ++i) ss += v[r][i].x * v[r][i].x + v[r][i].y * v[r][i].y + v[r][i].z * v[r][i].z + v[r][i].w * v[r][i].w;
      ss = wave_sum(ss);
      rstd[r] = rsqrtf(ss * (1.f / 1024.f) + 1e-6f);
    }
#pragma unroll
    for (int i = 0; i < 4; ++i) {
      const int col = i * 256 + lane * 4;
      const float4 s4 = *(const float4*)(sc + col);
      const float4 h4 = *(const float4*)(sh + col);
#pragma unroll
      for (int r = 0; r < R; ++r) {
        u32x2 pk;
        pk.x = pack2(v[r][i].x * rstd[r] * (1.f + s4.x) + h4.x, v[r][i].y * rstd[r] * (1.f + s4.y) + h4.y);
        pk.y = pack2(v[r][i].z * rstd[r] * (1.f + s4.z) + h4.z, v[r][i].w * rstd[r] * (1.f + s4.w) + h4.w);
        *(u32x2*)(p.H + (size_t)(row0 + r) * DM + col) = pk;
      }
    }
  }
}

__device__ __forceinline__ void phase_router_prep(const Params& p) {
  const int t = tid_(), lane = t & 63, wid = t >> 6;
  for (int i = bid_() * 256 + t; i < 2 * 3 * 16384; i += gridDim.x * 256) {
    const int lc = i >> 14, k = (i >> 4) & 1023, e = i & 15, l = lc / 3;
    p.WR2[i] = (1.f + p.mada[(size_t)lc * 6144 + 4 * 1024 + k]) * p.w_router[(size_t)l * 16384 + k * 16 + e];
  }
  for (int o = bid_() * 4 + wid; o < 96; o += gridDim.x * 4) {
    const int lc = o >> 4, e = o & 15, l = lc / 3;
    float s = 0.f;
    for (int k = lane; k < 1024; k += 64) s += p.mada[(size_t)lc * 6144 + 3 * 1024 + k] * p.w_router[(size_t)l * 16384 + k * 16 + e];
    s = wave_sum(s);
    if (lane == 0) p.CE[o] = s;
  }
}

__device__ __forceinline__ void phase_router(const Params& p, int l, const float* xlat, const float* xctx, int nrows) {
  const int t = tid_(), lane = t & 63, wid = t >> 6, l16 = lane & 15, quad = lane >> 4;
  const int gw = bid_() * 4 + wid, nw = gridDim.x * 4;
  const int ntile = nrows >> 4;
  for (int tile = gw; tile < ntile; tile += nw) {
    const int row0 = tile * 16;
    const int cond = row_cond(row0);
    const float* xr = (row0 < T_LAT ? xlat + (size_t)(row0 + l16) * DM : xctx + (size_t)(row0 - T_LAT + l16) * DM) + quad * 4;
    const float* wp = p.WR2 + (size_t)(l * 3 + cond) * 16384 + quad * 64 + l16;
    f32x4 acc = (f32x4){0.f, 0.f, 0.f, 0.f};
    float ss = 0.f;
#pragma unroll 4
    for (int s = 0; s < 64; ++s) {
      const float4 a = *(const float4*)(xr + s * 16);
      const float b0 = wp[s * 256], b1 = wp[s * 256 + 16], b2 = wp[s * 256 + 32], b3 = wp[s * 256 + 48];
      ss += a.x * a.x + a.y * a.y + a.z * a.z + a.w * a.w;
      acc = __builtin_amdgcn_mfma_f32_16x16x4f32(a.x, b0, acc, 0, 0, 0);
      acc = __builtin_amdgcn_mfma_f32_16x16x4f32(a.y, b1, acc, 0, 0, 0);
      acc = __builtin_amdgcn_mfma_f32_16x16x4f32(a.z, b2, acc, 0, 0, 0);
      acc = __builtin_amdgcn_mfma_f32_16x16x4f32(a.w, b3, acc, 0, 0, 0);
    }
    ss += __shfl_xor(ss, 16);
    ss += __shfl_xor(ss, 32);
    const float rstd = rsqrtf(ss * (1.f / 1024.f) + 1e-6f);
    const float ce = p.CE[(l * 3 + cond) * 16 + l16];
#pragma unroll
    for (int j = 0; j < 4; ++j) {
      const int tk = quad * 4 + j;
      const float r = __shfl(rstd, tk);
      const float lg = acc[j] * r + ce;
      float mx = lg;
#pragma unroll
      for (int o = 8; o; o >>= 1) mx = fmaxf(mx, __shfl_xor(mx, o));
      const float ex = __expf(lg - mx);
      float sm = ex;
#pragma unroll
      for (int o = 8; o; o >>= 1) sm += __shfl_xor(sm, o);
      const float aff = ex / sm;
      const int row = row0 + tk;
      if (row < T_LAT) p.AFFT[(size_t)((row >> 13) * 16 + l16) * SEQ + (row & (SEQ - 1))] = aff;
      else { const int rc = row - T_LAT; p.AFFT[(size_t)32 * SEQ + ((rc >> 8) * 16 + l16) * CTX + (rc & 255)] = aff; }
    }
  }
}

__device__ __forceinline__ void phase_in_gemm(const Params& p, int l, unsigned char* smem) {
  const u16* W = p.WinT + (size_t)l * 1536 * 1024;
  XCD_FOR(t, 132 * 11) {
    const int mt = t / 11, nt = t % 11;
    const int row_base = mt * 128;
    auto epi = [&](f32x4(&acc)[4][4], int r0, int c0) {
      const bool act = nt < 4;
      auto vf = [&](int, int, float v) { return act ? gelu_tanh(v) : v; };
      auto rp = [&](int r) -> u16* {
        const int row = row_base + r;
        if (nt < 4) return p.PX + (size_t)row * 1024 + nt * 128;
        if (nt >= 8) return p.PX + (size_t)row * 1024 + 512 + (nt - 8) * 128;
        const int ri = (nt - 4) >> 1, jx = ((nt - 4) & 1) * 128;
        if (row < T_LAT) return p.GD + ((size_t)((row >> 13) * 2 + ri) * SEQ + (row & (SEQ - 1))) * 256 + jx;
        const int rc = row - T_LAT;
        return p.GDc + ((size_t)((rc >> 8) * 2 + ri) * CTX + (rc & 255)) * 256 + jx;
      };
      epi_staged_bf16<4>(acc, r0, c0, smem, vf, rp);
    };
    gemm_tile<4, false>(p.H + (size_t)row_base * 1024, 1024, nullptr, 128, W + (size_t)nt * 128 * 1024, 1024, 1024, smem, epi);
  }
  XCD_FOR(t, 132) {
    const int row_base = t * 128;
    auto epi = [&](f32x4(&acc)[4][2], int r0, int c0) {
      auto vf = [&](int, int, float v) { return v; };
      auto rp = [&](int r) -> u16* { return p.PX + (size_t)(row_base + r) * 1024 + 896; };
      epi_staged_bf16<2>(acc, r0, c0, smem, vf, rp);
    };
    gemm_tile<2, false>(p.H + (size_t)row_base * 1024, 1024, nullptr, 128, W + (size_t)11 * 128 * 1024, 1024, 1024, smem, epi);
  }
}

__device__ __forceinline__ void phase_rownorm(const Params& p, int l) {
  constexpr int R = 4;
  const int t = tid_(), lane = t & 63, wid = t >> 6;
  const int gw = bid_() * 4 + wid, nw = gridDim.x * 4;
  const float* nv = p.sgu_norm + l * 256 + lane * 4;
  const float* nq = p.q_lora_norm + l * 256 + lane * 4;
  const float* nk = p.kv_lora_norm + l * 128 + lane * 2;
  for (int row0 = gw * R; row0 < TT; row0 += nw * R) {
    u16* px = p.PX + (size_t)row0 * 1024;
    u32x2 rv[R], rq[R];
    unsigned rk[R];
#pragma unroll
    for (int r = 0; r < R; ++r) {
      rv[r] = *(const u32x2*)(px + r * 1024 + 256 + lane * 4);
      rq[r] = *(const u32x2*)(px + r * 1024 + 512 + lane * 4);
      rk[r] = *(const unsigned*)(px + r * 1024 + 768 + lane * 2);
    }
#pragma unroll
    for (int r = 0; r < R; ++r) {
      {
        const float a = bf2f((u16)(rv[r].x & 0xffff)), b = bf2f((u16)(rv[r].x >> 16)), c = bf2f((u16)(rv[r].y & 0xffff)), d = bf2f((u16)(rv[r].y >> 16));
        const float rstd = rsqrtf(wave_sum(a * a + b * b + c * c + d * d) * (1.f / 256.f) + 1e-6f);
        u32x2 o;
        o.x = pack2(a * rstd * nv[0], b * rstd * nv[1]);
        o.y = pack2(c * rstd * nv[2], d * rstd * nv[3]);
        *(u32x2*)(px + r * 1024 + 256 + lane * 4) = o;
      }
      {
        const float a = bf2f((u16)(rq[r].x & 0xffff)), b = bf2f((u16)(rq[r].x >> 16)), c = bf2f((u16)(rq[r].y & 0xffff)), d = bf2f((u16)(rq[r].y >> 16));
        const float rstd = rsqrtf(wave_sum(a * a + b * b + c * c + d * d) * (1.f / 256.f) + 1e-6f);
        u32x2 o;
        o.x = pack2(a * rstd * nq[0], b * rstd * nq[1]);
        o.y = pack2(c * rstd * nq[2], d * rstd * nq[3]);
        *(u32x2*)(px + r * 1024 + 512 + lane * 4) = o;
      }
      {
        const float a = bf2f((u16)(rk[r] & 0xffff)), b = bf2f((u16)(rk[r] >> 16));
        const float rstd = rsqrtf(wave_sum(a * a + b * b) * (1.f / 128.f) + 1e-6f);
        *(unsigned*)(px + r * 1024 + 768 + lane * 2) = pack2(a * rstd * nk[0], b * rstd * nk[1]);
      }
    }
  }
}

__device__ __forceinline__ void phase_mix_a(const Params& p, int l, bool last, unsigned char* smem) {
  {
    const u16* W = p.WuqT + (size_t)l * 768 * 256;
    XCD_FOR(t, 132 * 6) {
      const int mt = t / 6, nt = t % 6, row_base = mt * 128;
      auto epi = [&](f32x4(&acc)[4][4], int r0, int c0) {
        const float* rs = (const float*)(smem + 65536);
        auto vf = [&](int r, int, float v) { return v * rs[r]; };
        auto rp = [&](int r) -> u16* { return p.QR + (size_t)(row_base + r) * 768 + nt * 128; };
        epi_staged_bf16<4>(acc, r0, c0, smem, vf, rp);
      };
      gemm_tile<4, false, false, true>(p.PX + (size_t)row_base * 1024 + 512, 1024, nullptr, 128, W + (size_t)nt * 128 * 256, 256, 256, smem, epi);
    }
  }
  {
    const u16* W = p.WukvT + (size_t)l * 1024 * 128;
    XCD_FOR(t, 132 * 8) {
      const int mt = t >> 3, nt = t & 7, row_base = mt * 128, h = nt >> 1;
      const int b = row_batch(row_base), pos_base = row_pos(row_base);
      auto epi = [&](f32x4(&acc)[4][4], int r0, int c0) {
#pragma unroll
        for (int mi = 0; mi < 4; ++mi)
#pragma unroll
          for (int ni = 0; ni < 4; ++ni) {
            const int col = c0 + ni * 16;
            if ((nt & 1) == 0) {
            } else {
              u32x2 pk;
              pk.x = pack2(acc[mi][ni][0], acc[mi][ni][1]);
              pk.y = pack2(acc[mi][ni][2], acc[mi][ni][3]);
              *(u32x2*)(p.Vt + ((size_t)(b * 4 + h) * 128 + col) * NPOS + pos_base + r0 + mi * 16) = pk;
            }
          }
      };
      auto epi2 = [&](f32x4(&acc)[4][4], int r0, int c0) {
        const float* rs = (const float*)(smem + 65536);
        if ((nt & 1) == 0) {
          auto vf = [&](int r, int, float v) { return v * rs[r]; };
          auto rp = [&](int r) -> u16* { return p.KN + (size_t)(row_base + r) * 512 + h * 128; };
          epi_staged_bf16<4>(acc, r0, c0, smem, vf, rp);
        } else {
#pragma unroll
          for (int mi = 0; mi < 4; ++mi)
#pragma unroll
            for (int j = 0; j < 4; ++j) {
              const float sc = rs[r0 + mi * 16 + j];
#pragma unroll
              for (int ni = 0; ni < 4; ++ni) acc[mi][ni][j] *= sc;
            }
          auto cp = [&](int c) -> u16* { return p.Vt + ((size_t)(b * 4 + h) * 128 + c) * NPOS + pos_base; };
          epi_staged_bf16_T(acc, r0, c0, smem, cp);
        }
      };
      gemm_tile<4, false, false, true>(p.PX + (size_t)row_base * 1024 + 768, 1024, nullptr, 128, W + (size_t)nt * 128 * 128, 128, 128, smem, epi2);
    }
  }
  {
    const int nch = last ? 128 : 132;
    XCD_FOR(t, nch * 4) {
      const int ch = t >> 2, h = t & 3, row_base = ch * 128;
      const float* bs = p.b_sgu + (l * 4 + h) * 128;
      const float* sgn = p.sgu_norm + l * 256 + h * 64;
      float* rsv = (float*)(smem + 65536 + 512);
      {
        const int t3 = tid_(), q = t3 >> 1, half = t3 & 1;
        const u16* vp = p.PX + (size_t)(row_base + q) * 1024 + 256 + half * 128;
        float s = 0.f;
#pragma unroll
        for (int i = 0; i < 16; ++i) {
          const u32x4 w = *(const u32x4*)(vp + i * 8);
          const float a0 = __uint_as_float(w.x << 16), a1 = __uint_as_float(w.x & 0xffff0000u), a2 = __uint_as_float(w.y << 16), a3 = __uint_as_float(w.y & 0xffff0000u);
          const float a4 = __uint_as_float(w.z << 16), a5 = __uint_as_float(w.z & 0xffff0000u), a6 = __uint_as_float(w.w << 16), a7 = __uint_as_float(w.w & 0xffff0000u);
          s += (a0 * a0 + a1 * a1) + (a2 * a2 + a3 * a3) + (a4 * a4 + a5 * a5) + (a6 * a6 + a7 * a7);
        }
        s += __shfl_xor(s, 1);
        __syncthreads();
        if (half == 0) rsv[q] = rsqrtf(s * (1.f / 256.f) + 1e-6f);
      }
      auto epi = [&](f32x4(&acc)[4][2], int r0, int c0) {
        float* Ts = (float*)smem;
        const int t2 = tid_();
        __syncthreads();
#pragma unroll
        for (int mi = 0; mi < 4; ++mi)
#pragma unroll
          for (int ni = 0; ni < 2; ++ni)
#pragma unroll
            for (int j = 0; j < 4; ++j) {
              const int pr = r0 + mi * 16 + j;
              Ts[pr * 68 + c0 + ni * 16] = acc[mi][ni][j] * sgn[c0 + ni * 16] + bs[pr];
            }
        __syncthreads();
#pragma unroll
        for (int i = 0; i < 4; ++i) {
          const int c = t2 + 256 * i, pr = c >> 3, ch = c & 7;
          const size_t o = (size_t)(row_base + pr) * 1024 + h * 64 + ch * 8;
          const u32x4 u = *(const u32x4*)(p.PX + o);
          const float4 z0 = *(const float4*)(Ts + pr * 68 + ch * 8), z1 = *(const float4*)(Ts + pr * 68 + ch * 8 + 4);
          u32x4 r;
          r.x = pack2(bf2f((u16)(u.x & 0xffffu)) * z0.x, bf2f((u16)(u.x >> 16)) * z0.y);
          r.y = pack2(bf2f((u16)(u.y & 0xffffu)) * z0.z, bf2f((u16)(u.y >> 16)) * z0.w);
          r.z = pack2(bf2f((u16)(u.z & 0xffffu)) * z1.x, bf2f((u16)(u.z >> 16)) * z1.y);
          r.w = pack2(bf2f((u16)(u.w & 0xffffu)) * z1.z, bf2f((u16)(u.w >> 16)) * z1.w);
          *(u32x4*)(p.YM + o) = r;
        }
      };
      gemm_tile<2, true>(p.Wsgu + (size_t)(l * 4 + h) * 16384, 128, nullptr, 128, p.PX + (size_t)row_base * 1024 + 256 + h * 64, 1024, 128, smem, epi, rsv);
    }
  }
  {
    XCD_FOR(t, 512) {
      const int nh = t & 1, n1 = (t >> 1) & 127, b = t >> 8;
      auto epi = [&](f32x4(&acc)[4][4], int r0, int c0) {
        auto vf = [&](int, int, float v) { return v; };
        auto rp = [&](int m) -> u16* { const int rip = m >> 6, k2 = m & 63; return p.PF + ((size_t)((b * 64 + k2) * 2 + rip) * 128 + n1) * 256 + nh * 128; };
        epi_staged_bf16<4>(acc, r0, c0, smem, vf, rp);
      };
      gemm_tile<4, true>(p.M1 + (size_t)n1 * 16384, 128, nullptr, 128, p.GD + (size_t)b * 2 * SEQ * 256 + (size_t)n1 * 256 + nh * 128, 128 * 256, 128, smem, epi);
    }
  }
  if (!last) {
    for (int t = bid_(); t < 8; t += gridDim.x) {
      const int nh = t & 1, mt = (t >> 1) & 1, b = t >> 2;
      auto epi = [&](f32x4(&acc)[4][4], int r0, int c0) {
#pragma unroll
        for (int mi = 0; mi < 4; ++mi)
#pragma unroll
          for (int ni = 0; ni < 4; ++ni)
#pragma unroll
            for (int j = 0; j < 4; ++j) {
              const int k = mt * 128 + r0 + mi * 16 + j;
              p.YM[(size_t)(T_LAT + b * CTX + k) * 1024 + 256 + nh * 128 + c0 + ni * 16] = f2bf(acc[mi][ni][j] * (1.f / 128.f));
            }
      };
      gemm_tile<4, true>(p.Mc + (size_t)mt * 128 * 512, 512, nullptr, 128, p.GDc + (size_t)b * 2 * CTX * 256 + nh * 128, 256, 512, smem, epi);
    }
  }
}

__device__ __forceinline__ void phase_mix_b(const Params& p, int l, bool last, unsigned char* smem) {
  XCD_FOR(t, 512) {
    const int nq = t & 3, k2 = (t >> 2) & 63, b = t >> 8;
    auto epi = [&](f32x4(&acc)[4][2], int r0, int c0) {
      auto vf = [&](int, int, float v) { return v * 0.001381067932004976f; };
      auto rp = [&](int k1) -> u16* { return p.YM + (size_t)(b * SEQ + 64 * k1 + k2) * 1024 + 256 + nq * 64; };
      epi_staged_bf16<2>(acc, r0, c0, smem, vf, rp);
    };
    gemm_tile<2, true>(p.M2, 256, nullptr, 128, p.PF + (size_t)(b * 64 + k2) * 2 * 128 * 256 + nq * 64, 256, 256, smem, epi);
  }
  const int tt = tid_(), lane = tt & 63, wid = tt >> 6;
  const int gw = bid_() * 4 + wid, nw = gridDim.x * 4;
  const float QSCALE = 0.07216878364870322f * 1.4426950408889634f;
  for (int row = gw; row < TT; row += nw) {
    const bool lat = row < T_LAT;
    const int b = row_batch(row), pos = row_pos(row);
    float cs = 1.f, sn = 0.f;
    if (lat) {
      const int n = row & (SEQ - 1);
      const int r = lane, sub = r & 31, i = sub & 15;
      const float ps = (r < 32) ? (float)(n >> 6) : (float)(n & 63);
      const float fr = __builtin_amdgcn_exp2f(-(float)i * 0.83048202372184058696f);
      const float ang = ps * fr;
      sn = __sinf(ang);
      cs = __cosf(ang);
    }
    const bool hi = ((lane & 31) >= 16);
    if (lat || !last) {
#pragma unroll
      for (int h = 0; h < 4; ++h) {
        const u16* q = p.QR + (size_t)row * 768 + h * 192;
        float v0 = bf2f(q[lane]), v1 = bf2f(q[lane + 64]), v2 = bf2f(q[lane + 128]);
        const float ss = wave_sum(v0 * v0 + v1 * v1 + v2 * v2);
        const float rstd = rsqrtf(ss * (1.f / 192.f) + 1e-6f);
        const float* qn = p.q_norm + l * 192;
        v0 *= rstd * qn[lane]; v1 *= rstd * qn[lane + 64]; v2 *= rstd * qn[lane + 128];
        if (lat) {
          const float xp = __shfl_xor(v2, 16);
          v2 = hi ? (xp * sn + v2 * cs) : (v2 * cs - xp * sn);
        }
        u16* o = p.Qall + ((size_t)(b * 4 + h) * NPOS + pos) * 192;
        o[lane] = f2bf(v0 * QSCALE); o[lane + 64] = f2bf(v1 * QSCALE); o[lane + 128] = f2bf(v2 * QSCALE);
      }
    }
    {
      const float kr = bf2f(p.PX[(size_t)row * 1024 + 896 + lane]);
#pragma unroll
      for (int h = 0; h < 4; ++h) {
        const u16* kk = p.KN + (size_t)row * 512 + h * 128;
        float v0 = bf2f(kk[lane]), v1 = bf2f(kk[lane + 64]), v2 = kr;
        const float ss = wave_sum(v0 * v0 + v1 * v1 + v2 * v2);
        const float rstd = rsqrtf(ss * (1.f / 192.f) + 1e-6f);
        const float* kn = p.k_norm + l * 192;
        v0 *= rstd * kn[lane]; v1 *= rstd * kn[lane + 64]; v2 *= rstd * kn[lane + 128];
        if (lat) {
          const float xp = __shfl_xor(v2, 16);
          v2 = hi ? (xp * sn + v2 * cs) : (v2 * cs - xp * sn);
        }
        u16* o = p.Kb + ((size_t)(b * 4 + h) * NPOS + pos) * 192;
        o[lane] = f2bf(v0); o[lane + 64] = f2bf(v1); o[lane + 128] = f2bf(v2);
      }
    }
  }
}

__device__ __forceinline__ void attn_item(const Params& p, int b, int h, int qt, float shift, unsigned char* smem) {
  constexpr int STAGE = 32 * 208 + 128 * 40;
  u16* sbase = (u16*)smem;
  const int t = tid_(), lane = t & 63, wid = t >> 6, l16 = lane & 15, quad = lane >> 4;
  const int nkeys = (qt < 2) ? CTX : NPOS;
  const int ntile = nkeys >> 5;
  const u16* Qp = p.Qall + ((size_t)(b * 4 + h) * NPOS + qt * 128 + wid * 32) * 192;
  const u16* kp = p.Kb + (size_t)(b * 4 + h) * NPOS * 192 + t * 8;
  const u16* vp = p.Vt + (size_t)(b * 4 + h) * 128 * NPOS + (size_t)(t >> 2) * NPOS + (t & 3) * 8;
  const u16* qlane = Qp + (size_t)l16 * 192 + quad * 8;
  bf16x8 bq[2][6];
#pragma unroll
  for (int qi = 0; qi < 2; ++qi)
#pragma unroll
    for (int ks = 0; ks < 6; ++ks) bq[qi][ks] = *(const bf16x8*)(qlane + qi * 16 * 192 + ks * 32);
  f32x4 o[8][2];
#pragma unroll
  for (int vt = 0; vt < 8; ++vt)
#pragma unroll
    for (int qi = 0; qi < 2; ++qi) o[vt][qi] = (f32x4){0.f, 0.f, 0.f, 0.f};
  float lrun0 = 0.f, lrun1 = 0.f;
  u32x4 rk[3], rv[2];
  f32x4 sA[2][2], sB[2][2];
#define ATT_LOAD(kt_)                                                                                   \
  {                                                                                                     \
    _Pragma("unroll") for (int i = 0; i < 3; ++i) rk[i] = *(const u32x4*)(kp + (size_t)(kt_) * 6144 + i * 2048); \
    _Pragma("unroll") for (int i = 0; i < 2; ++i) rv[i] = *(const u32x4*)(vp + (size_t)(64 * i) * NPOS + (kt_) * 32); \
  }
#define ATT_STORE(st_)                                                                                  \
  {                                                                                                     \
    u16* kd = sbase + (st_) * STAGE;                                                                    \
    _Pragma("unroll") for (int i = 0; i < 3; ++i) {                                                     \
      const int c = t + 256 * i;                                                                        \
      *(u32x4*)(kd + (c / 24) * 208 + (c % 24) * 8) = rk[i];                                            \
    }                                                                                                   \
    _Pragma("unroll") for (int i = 0; i < 2; ++i) *(u32x4*)(kd + 6656 + ((t >> 2) + 64 * i) * 40 + (t & 3) * 8) = rv[i]; \
  }
#define ATT_S(SX, kst_)                                                                                 \
  {                                                                                                     \
    const u16* Ks = sbase + (kst_) * STAGE;                                                             \
    _Pragma("unroll") for (int a = 0; a < 2; ++a)                                                       \
      _Pragma("unroll") for (int qi = 0; qi < 2; ++qi) SX[a][qi] = (f32x4){0.f, 0.f, 0.f, 0.f};         \
    _Pragma("unroll") for (int ks = 0; ks < 6; ++ks) {                                                  \
      _Pragma("unroll") for (int a = 0; a < 2; ++a) {                                                   \
        const bf16x8 kf = *(const bf16x8*)(Ks + (a * 16 + l16) * 208 + ks * 32 + quad * 8);             \
        _Pragma("unroll") for (int qi = 0; qi < 2; ++qi) SX[a][qi] = __builtin_amdgcn_mfma_f32_16x16x32_bf16(kf, bq[qi][ks], SX[a][qi], 0, 0, 0); \
      }                                                                                                 \
    }                                                                                                   \
  }
#define ATT_VLOAD(vst_, hv_)                                                                            \
  {                                                                                                     \
    const u16* Vs = sbase + (vst_) * STAGE + 6656;                                                      \
    _Pragma("unroll") for (int vt = 0; vt < 4; ++vt) {                                                  \
      const u16* vb = Vs + (((hv_) * 4 + vt) * 16 + l16) * 40 + quad * 4;                               \
      const u32x2 va = *(const u32x2*)(vb);                                                             \
      const u32x2 vc = *(const u32x2*)(vb + 16);                                                        \
      const u32x4 vw = {va.x, va.y, vc.x, vc.y};                                                        \
      vfr[vt] = (bf16x8)vw;                                                                             \
    }                                                                                                   \
  }
#define ATT_FINISH(SX, vst_)                                                                            \
  {                                                                                                     \
    bf16x8 pb[2];                                                                                       \
    _Pragma("unroll") for (int qi = 0; qi < 2; ++qi) {                                                  \
      float psum = 0.f;                                                                                 \
      _Pragma("unroll") for (int a = 0; a < 2; ++a)                                                     \
        _Pragma("unroll") for (int j = 0; j < 4; ++j) {                                                 \
          const float pe = __builtin_amdgcn_exp2f(SX[a][qi][j]);                                        \
          SX[a][qi][j] = pe;                                                                            \
          psum += pe;                                                                                   \
        }                                                                                               \
      if (qi) lrun1 += psum; else lrun0 += psum;                                                        \
      u32x4 pk;                                                                                         \
      pk.x = pack2(SX[0][qi][0], SX[0][qi][1]);                                                         \
      pk.y = pack2(SX[0][qi][2], SX[0][qi][3]);                                                         \
      pk.z = pack2(SX[1][qi][0], SX[1][qi][1]);                                                         \
      pk.w = pack2(SX[1][qi][2], SX[1][qi][3]);                                                         \
      pb[qi] = (bf16x8)pk;                                                                              \
    }                                                                                                   \
    _Pragma("unroll") for (int vt = 0; vt < 4; ++vt)                                                    \
      _Pragma("unroll") for (int qi = 0; qi < 2; ++qi) o[vt][qi] = __builtin_amdgcn_mfma_f32_16x16x32_bf16(vfr[vt], pb[qi], o[vt][qi], 0, 0, 0); \
    ATT_VLOAD(vst_, 1);                                                                                 \
    _Pragma("unroll") for (int vt = 0; vt < 4; ++vt)                                                    \
      _Pragma("unroll") for (int qi = 0; qi < 2; ++qi) o[4 + vt][qi] = __builtin_amdgcn_mfma_f32_16x16x32_bf16(vfr[vt], pb[qi], o[4 + vt][qi], 0, 0, 0); \
  }
#define ATT_SHIFT(SX)                                                                                   \
  if (shift > 0.f) {                                                                                    \
    _Pragma("unroll") for (int a = 0; a < 2; ++a)                                                       \
      _Pragma("unroll") for (int qi = 0; qi < 2; ++qi) {                                                \
        SX[a][qi][0] -= shift; SX[a][qi][1] -= shift; SX[a][qi][2] -= shift; SX[a][qi][3] -= shift;     \
      }                                                                                                 \
  }
#define ATT_STEP(SNEW, SOLD, tt_)                                                                       \
  {                                                                                                     \
    const int tn_ = ((tt_) + 1 < ntile) ? (tt_) + 1 : ntile - 1;                                        \
    ATT_LOAD(tn_);                                                                                      \
    bf16x8 vfr[4];                                                                                      \
    ATT_VLOAD(((tt_) - 1) % 3, 0);                                                                      \
    ATT_SHIFT(SOLD);                                                                                    \
    __builtin_amdgcn_s_setprio(1);                                                                      \
    ATT_S(SNEW, (tt_) % 3);                                                                             \
    ATT_FINISH(SOLD, ((tt_) - 1) % 3);                                                                  \
    __builtin_amdgcn_s_setprio(0);                                                                      \
    ATT_STORE(((tt_) + 1) % 3);                                                                         \
    __syncthreads();                                                                                    \
  }
  __syncthreads();
  ATT_LOAD(0);
  ATT_STORE(0);
  ATT_LOAD(1);
  __syncthreads();
  ATT_S(sA, 0);
  ATT_STORE(1);
  __syncthreads();
#pragma unroll 1
  for (int tt = 1; tt < ntile - 1; tt += 2) {
    ATT_STEP(sB, sA, tt);
    ATT_STEP(sA, sB, tt + 1);
  }
  ATT_STEP(sB, sA, ntile - 1);
  {
    bf16x8 vfr[4];
    ATT_VLOAD((ntile - 1) % 3, 0);
    ATT_SHIFT(sB);
    ATT_FINISH(sB, (ntile - 1) % 3);
  }
  __syncthreads();
#undef ATT_LOAD
#undef ATT_STORE
#undef ATT_S
#undef ATT_VLOAD
#undef ATT_FINISH
#undef ATT_STEP
#undef ATT_SHIFT
#pragma unroll
  for (int qi = 0; qi < 2; ++qi) {
    float ls = qi ? lrun1 : lrun0;
    ls += __shfl_xor(ls, 16);
    ls += __shfl_xor(ls, 32);
    const float inv = 1.f / ls;
    const int pos = qt * 128 + wid * 32 + qi * 16 + l16;
    const int row = (pos < CTX) ? (T_LAT + b * CTX + pos) : (b * SEQ + pos - CTX);
    u16* orow = p.YM + (size_t)row * 1024 + 512 + h * 128 + quad * 4;
#pragma unroll
    for (int vt = 0; vt < 8; ++vt) {
      u32x2 pk;
      pk.x = pack2(o[vt][qi][0] * inv, o[vt][qi][1] * inv);
      pk.y = pack2(o[vt][qi][2] * inv, o[vt][qi][3] * inv);
      *(u32x2*)(orow + vt * 16) = pk;
    }
  }
}

__device__ __forceinline__ void phase_attn(const Params& p, int l, bool last, unsigned char* smem) {
  float shift;
  {
    const int lane = tid_() & 63;
    float mq = 0.f, mk = 0.f;
#pragma unroll
    for (int i = 0; i < 3; ++i) { mq = fmaxf(mq, fabsf(p.q_norm[l * 192 + lane + 64 * i])); mk = fmaxf(mk, fabsf(p.k_norm[l * 192 + lane + 64 * i])); }
#pragma unroll
    for (int o = 32; o; o >>= 1) { mq = fmaxf(mq, __shfl_xor(mq, o)); mk = fmaxf(mk, __shfl_xor(mk, o)); }
    const float bound = 192.f * mq * mk * (0.07216878364870322f * 1.4426950408889634f);
    shift = fmaxf(0.f, bound - 24.f);
  }
  const int x = bid_() & 7, j = bid_() >> 3, gb = gridDim.x >> 3;
  for (int q = j; q < 64; q += gb) attn_item(p, x >> 2, x & 3, 2 + q, shift, smem);
  if (!last)
    for (int q = j; q < 2; q += gb) attn_item(p, x >> 2, x & 3, q, shift, smem);
}

__device__ __forceinline__ void phase_out_gemm(const Params& p, int l, bool last, const float* slat, const float* sctx, float* dlat, float* dctx, unsigned char* smem) {
  const u16* W = p.WoutT + (size_t)l * 1024 * 1024;
  XCD_FOR(t, 128 * 8) {
    const int mt = t >> 3, nt = t & 7, row_base = mt * 128;
    const float* g1 = p.mada + (size_t)(l * 3 + (row_base >> 13)) * 6144 + 2 * 1024 + nt * 128;
    const float* xs = slat + (size_t)row_base * DM;
    float* xd = dlat + (size_t)row_base * DM;
    auto epi = [&](f32x4(&acc)[4][4], int r0, int c0) { epi_staged_residual(acc, r0, c0, smem, g1, xs + nt * 128, xd + nt * 128); };
    gemm_tile<4, false>(p.YM + (size_t)row_base * 1024, 1024, nullptr, 128, W + (size_t)nt * 128 * 1024, 1024, 1024, smem, epi);
  }
  if (!last) {
    XCD_FOR(t, 4 * 32) {
      const int mt = t >> 5, nt = t & 31, row_base = mt * 128;
      const float* g1 = p.mada + (size_t)(l * 3 + 2) * 6144 + 2 * 1024 + nt * 32;
      const float* xs = sctx + (size_t)row_base * DM;
      float* xd = dctx + (size_t)row_base * DM;
      auto epi = [&](f32x4(&acc)[4][1], int r0, int c0) {
#pragma unroll
        for (int mi = 0; mi < 4; ++mi) {
          const float g = g1[c0];
#pragma unroll
          for (int j = 0; j < 4; ++j) {
            const size_t o = (size_t)(r0 + mi * 16 + j) * DM + nt * 32 + c0;
            xd[o] = xs[o] + g * acc[mi][0][j];
          }
        }
      };
      gemm_tile<1, false>(p.YM + (size_t)(T_LAT + row_base) * 1024, 1024, nullptr, 128, W + (size_t)nt * 32 * 1024, 1024, 1024, smem, epi);
    }
  }
}

__device__ __forceinline__ unsigned block_incl_scan(unsigned x, unsigned* wsum, int lane, int wid, unsigned& total) {
  unsigned v = x;
#pragma unroll
  for (int off = 1; off < 64; off <<= 1) {
    const unsigned n = __shfl_up(v, off);
    if (lane >= off) v += n;
  }
  __syncthreads();
  if (lane == 63) wsum[wid] = v;
  __syncthreads();
  const unsigned w0 = wsum[0], w1 = wsum[1], w2 = wsum[2], w3 = wsum[3];
  total = w0 + w1 + w2 + w3;
  const unsigned base = (wid > 0 ? w0 : 0u) + (wid > 1 ? w1 : 0u) + (wid > 2 ? w2 : 0u);
  return base + v;
}

__device__ __forceinline__ void phase_topk(const Params& p, bool last, unsigned char* smem) {
  unsigned* key = (unsigned*)smem;
  unsigned* hist = key + 8192;
  unsigned* wsum = hist + 256;
  unsigned* sh = wsum + 4;
  const int t = tid_(), lane = t & 63, wid = t >> 6;
  const int ninst = last ? 32 : 64;
  for (int inst = bid_(); inst < ninst; inst += gridDim.x) {
    const bool lat = inst < 32;
    const int n = lat ? SEQ : CTX, cap = lat ? 1024 : 32;
    const float* src = lat ? p.AFFT + (size_t)inst * SEQ : p.AFFT + (size_t)32 * SEQ + (inst - 32) * CTX;
    const int rowbase = lat ? (inst >> 4) * SEQ : T_LAT + ((inst - 32) >> 4) * CTX;
    for (int i = t; i < n; i += 256) key[i] = __float_as_uint(src[i]);
    unsigned prefix = 0u, mask = 0u, remaining = (unsigned)cap;
    for (int shift = 24; shift >= 0; shift -= 8) {
      hist[t] = 0u;
      __syncthreads();
      for (int i = t; i < n; i += 256) {
        const unsigned k = key[i];
        if ((k & mask) == prefix) atomicAdd(&hist[(k >> shift) & 255u], 1u);
      }
      __syncthreads();
      const unsigned hc = hist[t];
      unsigned total;
      const unsigned incl = block_incl_scan(hc, wsum, lane, wid, total);
      const unsigned suf = total - incl + hc;
      const unsigned sufn = total - incl;
      if (suf >= remaining && sufn < remaining) { sh[0] = prefix | ((unsigned)t << shift); sh[1] = remaining - sufn; }
      __syncthreads();
      prefix = sh[0];
      remaining = sh[1];
      mask |= (255u << shift);
      __syncthreads();
    }
    const int per = n >> 8;
    unsigned cgt = 0u, ceq = 0u;
    for (int i = 0; i < per; ++i) {
      const unsigned k = key[t * per + i];
      cgt += (k > prefix) ? 1u : 0u;
      ceq += (k == prefix) ? 1u : 0u;
    }
    unsigned ngt, neq;
    unsigned og = block_incl_scan(cgt, wsum, lane, wid, ngt) - cgt;
    unsigned oe = block_incl_scan(ceq, wsum, lane, wid, neq) - ceq;
    int* idx = p.IDXG + (size_t)inst * 1024;
    float* gt = p.GATE + (size_t)inst * 1024;
    int* inv = p.INV + (size_t)rowbase * 16 + (inst & 15);
    for (int i = 0; i < per; ++i) {
      const int e = t * per + i;
      const unsigned k = key[e];
      int slot = -1;
      if (k > prefix) {
        slot = (int)og; ++og;
      } else if (k == prefix) {
        if (oe < remaining) slot = (int)(ngt + oe);
        ++oe;
      }
      if (slot >= 0) { idx[slot] = rowbase + e; gt[slot] = __uint_as_float(k); }
      inv[(size_t)e * 16] = slot;
    }
    __syncthreads();
  }
}

__device__ __forceinline__ void phase_moe_up(const Params& p, int l, bool last, unsigned char* smem) {
  const int npass = last ? 1 : 2;
  for (int pass = 0; pass < npass; ++pass)
  XCD_FOR(t, ((pass == npass - 1) ? 2048 : 256)) {
    int inst, mt, nt, mvalid, hid_row;
    if (pass == npass - 1) { const int e_ = t >> 7, b_ = (t >> 6) & 1; inst = b_ * 16 + e_; mt = (t >> 3) & 7; nt = t & 7; mvalid = 128; hid_row = inst * 1024 + mt * 128; }
    else { const int e_ = t >> 4, b_ = (t >> 3) & 1; inst = 32 + b_ * 16 + e_; mt = 0; nt = t & 7; mvalid = 32; hid_row = 32768 + (inst - 32) * 128; }
    const int e = inst & 15;
    const u16* W = p.WguT + (size_t)(l * 16 + e) * 1024 * 1024 + (size_t)nt * 128 * 1024;
    auto epi = [&](f32x4(&acc)[4][4], int r0, int c0) {
      u16* Ts = (u16*)smem;
      const int t2 = tid_();
      __syncthreads();
#pragma unroll
      for (int mi = 0; mi < 4; ++mi)
#pragma unroll
        for (int n2 = 0; n2 < 2; ++n2)
#pragma unroll
          for (int j = 0; j < 4; ++j) {
            const int m = r0 + mi * 16 + j;
            const int fl = (c0 >> 6) * 32 + n2 * 16 + (c0 & 15);
            Ts[m * 72 + fl] = f2bf(silu_f(acc[mi][2 * n2][j]) * acc[mi][2 * n2 + 1][j]);
          }
      __syncthreads();
#pragma unroll
      for (int i = 0; i < 4; ++i) {
        const int c = t2 + 256 * i, row = c >> 3, ch = c & 7;
        if (row < mvalid) *(u32x4*)(p.HID + (size_t)(hid_row + row) * 512 + nt * 64 + ch * 8) = *(const u32x4*)(Ts + row * 72 + ch * 8);
      }
    };
    if (mvalid == 128) gemm_tile<4, false, false>(p.H, 1024, p.IDXG + (size_t)inst * 1024 + mt * 128, 128, W, 1024, 1024, smem, epi);
    else gemm_tile<4, false, true>(p.H, 1024, p.IDXG + (size_t)inst * 1024 + mt * 128, mvalid, W, 1024, 1024, smem, epi);
  }
}

__device__ __forceinline__ void phase_moe_down(const Params& p, int l, bool last, unsigned char* smem) {
  const int npass = last ? 1 : 2;
  for (int pass = 0; pass < npass; ++pass)
  XCD_FOR(t, ((pass == npass - 1) ? 2048 : 256)) {
    int inst, mt, nt, mvalid, hid_row;
    if (pass == npass - 1) { const int e_ = t >> 7, b_ = (t >> 6) & 1; inst = b_ * 16 + e_; mt = (t >> 3) & 7; nt = t & 7; mvalid = 128; hid_row = inst * 1024 + mt * 128; }
    else { const int e_ = t >> 4, b_ = (t >> 3) & 1; inst = 32 + b_ * 16 + e_; mt = 0; nt = t & 7; mvalid = 32; hid_row = 32768 + (inst - 32) * 128; }
    const int e = inst & 15;
    const float* gate = p.GATE + (size_t)inst * 1024 + mt * 128;
    const u16* W = p.WdT + (size_t)(l * 16 + e) * 1024 * 512 + (size_t)nt * 128 * 512;
    u16* yb = p.YB + (size_t)hid_row * 1024 + nt * 128;
    auto epi = [&](f32x4(&acc)[4][4], int r0, int c0) {
      auto vf = [&](int r, int, float v) { return (r < mvalid ? gate[r] : 0.f) * v; };
      auto rp = [&](int r) -> u16* { return r < mvalid ? yb + (size_t)r * 1024 : nullptr; };
      epi_staged_bf16<4>(acc, r0, c0, smem, vf, rp);
    };
    if (mvalid == 128) gemm_tile<4, false, false>(p.HID + (size_t)hid_row * 512, 512, nullptr, 128, W, 512, 512, smem, epi);
    else gemm_tile<4, false, true>(p.HID + (size_t)hid_row * 512, 512, nullptr, mvalid, W, 512, 512, smem, epi);
  }
}

template <bool COMBINE, bool MOD>
__device__ __forceinline__ void phase_combine_modulate(const Params& p, int lprev, int lnext, const float* xlat, const float* xctx,
                                                       float* olat, float* octx, int nrows) {
  constexpr int R = 2;
  const int t = tid_(), lane = t & 63, wid = t >> 6;
  const int gw = bid_() * 4 + wid, nw = gridDim.x * 4;
  for (int row0 = gw * R; row0 < nrows; row0 += nw * R) {
    const bool lat = row0 < T_LAT;
    const float* xr = lat ? xlat + (size_t)row0 * DM : xctx + (size_t)(row0 - T_LAT) * DM;
    const int cond = row_cond(row0);
    float4 v[R][4];
#pragma unroll
    for (int r = 0; r < R; ++r)
#pragma unroll
      for (int i = 0; i < 4; ++i) v[r][i] = *(const float4*)(xr + (size_t)r * DM + i * 256 + lane * 4);
    if (COMBINE) {
      const int b = row_batch(row0);
      const int myinv = p.INV[(size_t)row0 * 16 + (lane & 31)];
      const float* g2 = p.mada + (size_t)(lprev * 3 + cond) * 6144 + 5 * 1024;
      float* orow = lat ? olat + (size_t)row0 * DM : octx + (size_t)(row0 - T_LAT) * DM;
#pragma unroll
      for (int r = 0; r < R; ++r) {
        float4 s[4];
#pragma unroll
        for (int i = 0; i < 4; ++i) s[i] = make_float4(0.f, 0.f, 0.f, 0.f);
        unsigned mask = (unsigned)((__ballot(myinv >= 0) >> (16 * r)) & 0xFFFFull);
        while (mask) {
          const int e0 = __builtin_ctz(mask);
          mask &= mask - 1;
          const bool two = mask != 0u;
          const int e1 = two ? __builtin_ctz(mask) : e0;
          mask &= mask - 1;
          const int s0 = __shfl(myinv, 16 * r + e0), s1 = __shfl(myinv, 16 * r + e1);
          const size_t y0 = lat ? (size_t)(b * 16 + e0) * 1024 + s0 : (size_t)32768 + (size_t)(b * 16 + e0) * 128 + s0;
          const size_t y1 = lat ? (size_t)(b * 16 + e1) * 1024 + s1 : (size_t)32768 + (size_t)(b * 16 + e1) * 128 + s1;
          u32x2 a0[4], a1[4];
#pragma unroll
          for (int i = 0; i < 4; ++i) { a0[i] = *(const u32x2*)(p.YB + y0 * 1024 + lane * 4 + i * 256); a1[i] = *(const u32x2*)(p.YB + y1 * 1024 + lane * 4 + i * 256); }
          const float w1 = two ? 1.f : 0.f;
#pragma unroll
          for (int i = 0; i < 4; ++i) {
            s[i].x += bf2f((u16)(a0[i].x & 0xffffu)); s[i].y += bf2f((u16)(a0[i].x >> 16));
            s[i].z += bf2f((u16)(a0[i].y & 0xffffu)); s[i].w += bf2f((u16)(a0[i].y >> 16));
            s[i].x += w1 * bf2f((u16)(a1[i].x & 0xffffu)); s[i].y += w1 * bf2f((u16)(a1[i].x >> 16));
            s[i].z += w1 * bf2f((u16)(a1[i].y & 0xffffu)); s[i].w += w1 * bf2f((u16)(a1[i].y >> 16));
          }
        }
#pragma unroll
        for (int i = 0; i < 4; ++i) {
          const int col = i * 256 + lane * 4;
          const float4 g4 = *(const float4*)(g2 + col);
          v[r][i].x += g4.x * s[i].x; v[r][i].y += g4.y * s[i].y; v[r][i].z += g4.z * s[i].z; v[r][i].w += g4.w * s[i].w;
          *(float4*)(orow + (size_t)r * DM + col) = v[r][i];
        }
      }
    }
    if (MOD) {
      const float* sh = p.mada + (size_t)(lnext * 3 + cond) * 6144;
      const float* sc = sh + 1024;
      float rstd[R];
#pragma unroll
      for (int r = 0; r < R; ++r) {
        float ss = 0.f;
#pragma unroll
        for (int i = 0; i < 4; ++i) ss += v[r][i].x * v[r][i].x + v[r][i].y * v[r][i].y + v[r][i].z * v[r][i].z + v[r][i].w * v[r][i].w;
        rstd[r] = rsqrtf(wave_sum(ss) * (1.f / 1024.f) + 1e-6f);
      }
#pragma unroll
      for (int i = 0; i < 4; ++i) {
        const int col = i * 256 + lane * 4;
        const float4 s4 = *(const float4*)(sc + col);
        const float4 h4 = *(const float4*)(sh + col);
#pragma unroll
        for (int r = 0; r < R; ++r) {
          u32x2 pk;
          pk.x = pack2(v[r][i].x * rstd[r] * (1.f + s4.x) + h4.x, v[r][i].y * rstd[r] * (1.f + s4.y) + h4.y);
          pk.y = pack2(v[r][i].z * rstd[r] * (1.f + s4.z) + h4.z, v[r][i].w * rstd[r] * (1.f + s4.w) + h4.w);
          *(u32x2*)(p.H + (size_t)(row0 + r) * DM + col) = pk;
        }
      }
    }
  }
}

__global__ void __launch_bounds__(256, 2) fwd_megakernel(Params p_unused) {
  const Params& p = *(const Params*)__builtin_amdgcn_kernarg_segment_ptr();
  __shared__ __attribute__((aligned(16))) unsigned char smem[SMEM_BYTES];
  __shared__ uint4 xb_words;
  cg::grid_group grid = cg::this_grid();
  if (threadIdx.x == 0) xb_words = make_uint4(0u, 0u, 0u, 0u);
  __syncthreads();
  XcdBarrier xb = xcd_barrier_post(p.bar, (volatile LAS unsigned*)&xb_words);

#define LP (*launder_(&p))
  phase_prep(LP, smem);
  if (xb_ld(&p.bar[XB_TMO]) == 0xFFFFFFFFu) grid.sync();
  if (threadIdx.x == 0) {
    XB_SPIN(xb_ld(&p.bar[64]) < 192u, p.bar);
    __builtin_amdgcn_fence(__ATOMIC_ACQUIRE, "agent");
    asm volatile("s_waitcnt vmcnt(0)" ::: "memory");
  }
  __syncthreads();

  for (int l = 0; l < 2; ++l) {
    const bool last = (l == 1);
    if (!last) { phase_router_prep(LP); phase_combine_modulate<false, true>(LP, 0, 0, p.x, p.ctx, nullptr, nullptr, TT); }
    else phase_combine_modulate<true, true>(LP, 0, 1, p.out, p.XC, p.out, p.XC, TT);
    xcd_barrier(xb);
    phase_in_gemm(LP, l, smem);
    xcd_barrier(xb);
    phase_mix_a(LP, l, last, smem);
    xcd_barrier(xb);
    phase_mix_b(LP, l, last, smem);
    xcd_barrier(xb);
    phase_attn(LP, l, last, smem);
    xcd_barrier(xb);
    phase_out_gemm(LP, l, last, last ? p.out : p.x, last ? p.XC : p.ctx, p.out, p.XC, smem);
    xcd_barrier(xb);
    phase_router(LP, l, p.out, p.XC, last ? T_LAT : TT);
    xcd_barrier(xb);
    phase_topk(LP, last, smem);
    phase_modulate<4>(LP, l, p.out, p.XC, last ? T_LAT : TT, 3, last ? 32 : 64);
    xcd_barrier(xb);
    phase_moe_up(LP, l, last, smem);
    xcd_barrier(xb);
    phase_moe_down(LP, l, last, smem);
    xcd_barrier(xb);
  }
  phase_combine_modulate<true, false>(LP, 1, 1, p.out, p.XC, p.out, p.XC, T_LAT);
#undef LP
}

extern "C" void kernel_launch(void* const* d_in, const int* in_sizes, int n_in, void* d_out, int out_size, void* d_ws,
                              size_t ws_size, hipStream_t stream) {
  static int grid_blocks = 0;
  if (!grid_blocks) {
    int dev = 0, cus = 0, per_cu = 0;
    hipGetDevice(&dev);
    hipDeviceGetAttribute(&cus, hipDeviceAttributeMultiprocessorCount, dev);
    hipOccupancyMaxActiveBlocksPerMultiprocessor(&per_cu, fwd_megakernel, 256, 0);
    if (per_cu > 2) per_cu = 2;
    if (per_cu < 1) per_cu = 1;
    grid_blocks = (cus * per_cu) & ~7;
    if (grid_blocks < 8) grid_blocks = 8;
  }
  Params p{};
  const float* const* in = (const float* const*)d_in;
  p.x = in[0]; p.c = in[1]; p.ctx = in[2]; p.c_ctx = in[3]; p.w_ada = in[4]; p.b_ada = in[5]; p.w_in = in[6];
  p.sgu_norm = in[7]; p.w_sgu = in[8]; p.b_sgu = in[9]; p.q_lora_norm = in[10]; p.w_uq = in[11]; p.kv_lora_norm = in[12];
  p.w_ukv = in[13]; p.q_norm = in[14]; p.k_norm = in[15]; p.w_out = in[16]; p.w_router = in[17]; p.w_gate = in[18];
  p.w_up = in[19]; p.w_down = in[20];
  p.out = (float*)d_out;
  unsigned char* base = (unsigned char*)d_ws;
  size_t off = 0;
  auto alloc = [&](size_t bytes) { void* r = base + off; off += (bytes + 255) & ~(size_t)255; return r; };
  p.bar = (unsigned*)alloc(16384);
  p.mada = (float*)alloc((size_t)2 * 3 * 6144 * 4);
  p.WinT = (u16*)alloc((size_t)2 * 1536 * 1024 * 2);
  p.WuqT = (u16*)alloc((size_t)2 * 768 * 256 * 2);
  p.WukvT = (u16*)alloc((size_t)2 * 1024 * 128 * 2);
  p.WoutT = (u16*)alloc((size_t)2 * 1024 * 1024 * 2);
  p.WguT = (u16*)alloc((size_t)2 * 16 * 1024 * 1024 * 2);
  p.WdT = (u16*)alloc((size_t)2 * 16 * 1024 * 512 * 2);
  p.Wsgu = (u16*)alloc((size_t)2 * 4 * 128 * 128 * 2);
  p.M1 = (u16*)alloc((size_t)128 * 128 * 128 * 2);
  p.M2 = (u16*)alloc((size_t)128 * 256 * 2);
  p.Mc = (u16*)alloc((size_t)256 * 512 * 2);
  p.XC = (float*)alloc((size_t)T_CTX * DM * 4);
  p.AFFT = (float*)alloc((size_t)(32 * SEQ + 32 * CTX) * 4);
  p.GATE = (float*)alloc((size_t)64 * 1024 * 4);
  p.IDXG = (int*)alloc((size_t)64 * 1024 * 4);
  p.INV = (int*)alloc((size_t)TT * 16 * 4);
  p.WR2 = (float*)alloc((size_t)2 * 3 * 16384 * 4);
  p.CE = (float*)alloc((size_t)96 * 4);
  p.GDc = (u16*)alloc((size_t)2 * 2 * CTX * 256 * 2);
  unsigned char* RH = (unsigned char*)alloc((size_t)TT * 1024 * 2);
  p.H = (u16*)RH;
  p.PF = (u16*)RH;
  p.KN = (u16*)(RH + (size_t)2 * 64 * 2 * 128 * 256 * 2);
  p.PX = (u16*)alloc((size_t)TT * 1024 * 2);
  p.YM = (u16*)alloc((size_t)TT * 1024 * 2);
  unsigned char* RA = (unsigned char*)alloc((size_t)2 * 4 * NPOS * 192 * 2);
  unsigned char* RB = (unsigned char*)alloc((size_t)2 * 4 * NPOS * 192 * 2);
  p.GD = (u16*)RA;
  p.Qall = (u16*)RA;
  p.Kb = (u16*)RB;
  p.QR = (u16*)alloc((size_t)TT * 768 * 2);
  p.HID = p.QR;
  p.YB = p.PX;
  p.Vt = (u16*)alloc((size_t)2 * 4 * 128 * NPOS * 2);
  if (off > ws_size) fprintf(stderr, "workspace too small: need %zu have %zu\n", off, ws_size);

  hipMemsetAsync(p.bar, 0, 16384, stream);
  void* args[] = {&p};
  hipError_t e = hipLaunchCooperativeKernel((void*)fwd_megakernel, dim3(grid_blocks), dim3(256), args, 0, stream);
  if (e != hipSuccess) fprintf(stderr, "cooperative launch failed: %s (grid %d)\n", hipGetErrorString(e), grid_blocks);
}
```
